# Optimizing an MI355X kernel written in HIP

```python
import math
import jax, jax.numpy as jnp
from jax import lax
import numpy as np

D_MODEL = 2048
BATCH = 1
SEQ = 8192
DEPTH = 2

HEAD_DIM = 128
A_HEADS = 4
B_HEADS = 6
C_HEADS = 6
C_HALF = HEAD_DIM // 2
IDX_HEADS = 16
IDX_DIM = 64
TOPK_MAX = 256
DILATED_PAIRS = ((128, 1), (512, 4), (2048, 16))
N_BUCKETS = 32
MAX_DISTANCE = 2048
Q_BLOCK = 128
D_FF = 5632
N_EXPERTS = 8
TOP_K_EXPERTS = 2
D_FF_EXPERT = 7168
N_DENSE = (DEPTH + 1) // 2
N_MOE = DEPTH // 2
RMS_EPS = 1e-6
SPLIT_SIZES = (A_HEADS * HEAD_DIM, A_HEADS * HEAD_DIM, A_HEADS * HEAD_DIM,
               IDX_HEADS * IDX_DIM, IDX_DIM, IDX_HEADS,
               B_HEADS * HEAD_DIM, B_HEADS * HEAD_DIM, B_HEADS * HEAD_DIM,
               C_HEADS * HEAD_DIM, C_HEADS * HEAD_DIM, C_HEADS * HEAD_DIM)
N_IN = sum(SPLIT_SIZES)

kernel_name = 'hybrid_dsa_dilated_diff_moe_trunk'


def rms_norm(x, g):
    xf = x.astype(jnp.float32)
    y = xf * lax.rsqrt(jnp.mean(xf * xf, axis=-1, keepdims=True) + RMS_EPS)
    return (y * g.astype(jnp.float32)).astype(x.dtype)


def t5_bucket(dist):
    n = jnp.maximum(dist, 0)
    max_exact = N_BUCKETS // 2
    nf = jnp.maximum(n, 1).astype(jnp.float32)
    large = max_exact + (jnp.log(nf / max_exact) / math.log(MAX_DISTANCE / max_exact)
                         * (N_BUCKETS - max_exact)).astype(jnp.int32)
    return jnp.where(n < max_exact, n, jnp.minimum(large, N_BUCKETS - 1))


def dsa_attention(q, k, v, q_idx, k_idx, w_idx, bias_tab):
    B, S, H, Dh = q.shape
    topk = min(TOPK_MAX, S // 4)
    nblk = S // Q_BLOCK
    pos = jnp.arange(S, dtype=jnp.int32)
    gather = jax.vmap(lambda t, i: t[i])

    def blocks(t):
        return t.reshape(B, nblk, Q_BLOCK, *t.shape[2:]).swapaxes(0, 1)

    def one_block(args):
        qb, qib, wib, t = args
        rel = jax.nn.relu(jnp.einsum('bqhd,bkd->bqhk', qib, k_idx).astype(jnp.float32) * IDX_DIM ** -0.5)
        score = jnp.einsum('bqh,bqhk->bqk', wib.astype(jnp.float32) * IDX_HEADS ** -0.5, rel)
        score = jnp.where(pos[None, None, :] <= t[None, :, None], score, -jnp.inf)
        _, idx = lax.top_k(score, topk)
        valid = idx <= t[None, :, None]
        ks = gather(k, idx)
        vs = gather(v, idx)
        logits = jnp.einsum('bqhd,bqkhd->bhqk', qb, ks).astype(jnp.float32) * Dh ** -0.5
        logits = logits + bias_tab[t5_bucket(t[None, :, None] - idx)].transpose(0, 3, 1, 2)
        logits = jnp.where(valid[:, None], logits, -jnp.inf)
        p = jax.nn.softmax(logits, axis=-1).astype(v.dtype)
        return jnp.einsum('bhqk,bqkhd->bqhd', p, vs)

    out = lax.map(one_block, (blocks(q), blocks(q_idx), blocks(w_idx), pos.reshape(nblk, Q_BLOCK)))
    return out.swapaxes(0, 1).reshape(B, S, H, Dh)


def dilated_branch(q, k, v, bias_tab, window, dil):
    B, S, H, Dh = q.shape
    steps = window // dil
    span = Q_BLOCK * dil
    Sp = -(-S // span) * span
    M = Sp // dil
    nb = M // Q_BLOCK

    def stride_view(t):
        t = jnp.pad(t, ((0, 0), (0, Sp - S), (0, 0), (0, 0)))
        return t.reshape(B, M, dil, H, Dh).transpose(0, 2, 1, 3, 4).reshape(B, dil, nb, Q_BLOCK, H, Dh)

    def with_prev(t):
        prev = jnp.pad(t, ((0, 0), (0, 0), (1, 0), (0, 0), (0, 0), (0, 0)))[:, :, :-1]
        return jnp.concatenate([prev, t], axis=3)

    qs = stride_view(q)
    kk = with_prev(stride_view(k))
    vv = with_prev(stride_view(v))
    logits = jnp.einsum('brnqhd,brnkhd->brnhqk', qs, kk).astype(jnp.float32) * Dh ** -0.5
    qi = jnp.arange(Q_BLOCK, dtype=jnp.int32)[:, None]
    ki = jnp.arange(2 * Q_BLOCK, dtype=jnp.int32)[None, :] - Q_BLOCK
    delta = qi - ki
    blk = jnp.arange(nb, dtype=jnp.int32)
    valid = ((delta >= 0) & (delta <= steps))[None] & ((ki >= 0)[None] | (blk[:, None, None] > 0))
    logits = logits + bias_tab[t5_bucket(delta * dil)].transpose(2, 0, 1)
    logits = jnp.where(valid[None, None, :, None], logits, -jnp.inf)
    lse = jax.nn.logsumexp(logits, axis=-1)
    p = jnp.exp(logits - lse[..., None]).astype(v.dtype)
    o = jnp.einsum('brnhqk,brnkhd->brnqhd', p, vv)
    o = o.reshape(B, dil, M, H, Dh).transpose(0, 2, 1, 3, 4).reshape(B, Sp, H, Dh)[:, :S]
    lse = lse.transpose(0, 1, 2, 4, 3).reshape(B, dil, M, H).transpose(0, 2, 1, 3).reshape(B, Sp, H)[:, :S]
    return o, lse


def dilated_attention(q, k, v, bias_tab):
    outs, lses = [], []
    for window, dil in DILATED_PAIRS:
        o, l = dilated_branch(q, k, v, bias_tab, window, dil)
        outs.append(o.astype(jnp.float32))
        lses.append(l)
    alpha = jax.nn.softmax(jnp.stack(lses, axis=0), axis=0)
    out = jnp.einsum('gbsh,gbshd->bshd', alpha, jnp.stack(outs, axis=0))
    return out.astype(v.dtype)


def diff_attention(q, k, v, bias_tab, lam):
    B, S, H = q.shape[:3]
    nblk = S // Q_BLOCK
    pos = jnp.arange(S, dtype=jnp.int32)

    def one_block(args):
        qb, t = args
        logits = jnp.einsum('bqhcd,bkhcd->bchqk', qb, k).astype(jnp.float32) * C_HALF ** -0.5
        dist = t[:, None] - pos[None, :]
        logits = logits + bias_tab[t5_bucket(dist)].transpose(2, 0, 1)
        logits = jnp.where(dist >= 0, logits, -jnp.inf)
        p = jax.nn.softmax(logits, axis=-1)
        a = (p[:, 0] - lam * p[:, 1]).astype(v.dtype)
        return jnp.einsum('bhqk,bkhd->bqhd', a, v)

    qblocks = q.reshape(B, nblk, Q_BLOCK, H, 2, C_HALF).swapaxes(0, 1)
    out = lax.map(one_block, (qblocks, pos.reshape(nblk, Q_BLOCK)))
    return out.swapaxes(0, 1).reshape(B, S, H, HEAD_DIM)


def swiglu(h, wg, wu, wd):
    a = jax.nn.silu(jnp.einsum('bsd,df->bsf', h, wg)) * jnp.einsum('bsd,df->bsf', h, wu)
    return jnp.einsum('bsf,fd->bsd', a, wd)


def moe_swiglu(h, w_router, wg, wu, wd):
    logits = jnp.einsum('bsd,de->bse', h, w_router).astype(jnp.float32)
    top_vals, top_idx = lax.top_k(logits, TOP_K_EXPERTS)
    gates = jax.nn.softmax(top_vals, axis=-1)
    combine = jnp.sum(jax.nn.one_hot(top_idx, N_EXPERTS, dtype=jnp.float32) * gates[..., None], axis=-2)
    out = jnp.zeros_like(h)
    for e in range(N_EXPERTS):
        out = out + combine[..., e:e + 1].astype(h.dtype) * swiglu(h, wg[e], wu[e], wd[e])
    return out


def setup_inputs(seed: int = 0) -> dict:
    key = jax.random.key(seed)
    ks = jax.random.split(key, 24)
    f32 = jnp.float32

    def nrm(k, shape, scale):
        return jax.random.normal(k, shape, f32) * scale

    def gain(k, shape):
        return 1.0 + 0.02 * jax.random.normal(k, shape, f32)

    return {
        'x': nrm(ks[0], (BATCH, SEQ, D_MODEL), 1.0),
        'w_in': nrm(ks[1], (DEPTH, D_MODEL, N_IN), D_MODEL ** -0.5),
        'w_out': nrm(ks[2], (DEPTH, D_MODEL, D_MODEL), D_MODEL ** -0.5),
        'attn_norm_g': gain(ks[3], (DEPTH, D_MODEL)),
        'ffn_norm_g': gain(ks[4], (DEPTH, D_MODEL)),
        'q_norm_a': gain(ks[5], (DEPTH, HEAD_DIM)),
        'k_norm_a': gain(ks[6], (DEPTH, HEAD_DIM)),
        'q_norm_b': gain(ks[7], (DEPTH, HEAD_DIM)),
        'k_norm_b': gain(ks[8], (DEPTH, HEAD_DIM)),
        'q_norm_c': gain(ks[9], (DEPTH, C_HALF)),
        'k_norm_c': gain(ks[10], (DEPTH, C_HALF)),
        'lambda_q1': nrm(ks[11], (DEPTH, C_HALF), 0.1),
        'lambda_k1': nrm(ks[12], (DEPTH, C_HALF), 0.1),
        'lambda_q2': nrm(ks[13], (DEPTH, C_HALF), 0.1),
        'lambda_k2': nrm(ks[14], (DEPTH, C_HALF), 0.1),
        'diff_subln_g': gain(ks[15], (DEPTH, HEAD_DIM)),
        'rel_bias': nrm(ks[16], (N_BUCKETS, A_HEADS + B_HEADS + C_HEADS), 0.3),
        'w_dense_gate': nrm(ks[17], (N_DENSE, D_MODEL, D_FF), D_MODEL ** -0.5),
        'w_dense_up': nrm(ks[18], (N_DENSE, D_MODEL, D_FF), D_MODEL ** -0.5),
        'w_dense_down': nrm(ks[19], (N_DENSE, D_FF, D_MODEL), D_FF ** -0.5),
        'w_router': nrm(ks[20], (N_MOE, D_MODEL, N_EXPERTS), D_MODEL ** -0.5),
        'w_moe_gate': nrm(ks[21], (N_MOE, N_EXPERTS, D_MODEL, D_FF_EXPERT), D_MODEL ** -0.5),
        'w_moe_up': nrm(ks[22], (N_MOE, N_EXPERTS, D_MODEL, D_FF_EXPERT), D_MODEL ** -0.5),
        'w_moe_down': nrm(ks[23], (N_MOE, N_EXPERTS, D_FF_EXPERT, D_MODEL), D_FF_EXPERT ** -0.5),
    }


def reference(x, w_in, w_out, attn_norm_g, ffn_norm_g, q_norm_a, k_norm_a, q_norm_b, k_norm_b,
              q_norm_c, k_norm_c, lambda_q1, lambda_k1, lambda_q2, lambda_k2, diff_subln_g, rel_bias,
              w_dense_gate, w_dense_up, w_dense_down, w_router, w_moe_gate, w_moe_up, w_moe_down):
    B, S, _ = x.shape
    split_points = np.cumsum(SPLIT_SIZES)[:-1].tolist()
    bias_a = rel_bias[:, :A_HEADS]
    bias_b = rel_bias[:, A_HEADS:A_HEADS + B_HEADS]
    bias_c = rel_bias[:, A_HEADS + B_HEADS:]

    def heads(t, n):
        return t.reshape(B, S, n, HEAD_DIM)

    for layer in range(DEPTH):
        h = rms_norm(x, attn_norm_g[layer])
        proj = jnp.einsum('bsd,dn->bsn', h, w_in[layer])
        qa, ka, va, qi, ki, wi, qb, kb, vb, qc, kc, vc = jnp.split(proj, split_points, axis=-1)

        oa = dsa_attention(rms_norm(heads(qa, A_HEADS), q_norm_a[layer]),
                           rms_norm(heads(ka, A_HEADS), k_norm_a[layer]),
                           heads(va, A_HEADS),
                           qi.reshape(B, S, IDX_HEADS, IDX_DIM), ki, wi, bias_a)

        ob = dilated_attention(rms_norm(heads(qb, B_HEADS), q_norm_b[layer]),
                               rms_norm(heads(kb, B_HEADS), k_norm_b[layer]),
                               heads(vb, B_HEADS), bias_b)

        lam_init = 0.8 - 0.6 * math.exp(-0.3 * layer)
        lam = (jnp.exp(jnp.sum(lambda_q1[layer].astype(jnp.float32) * lambda_k1[layer].astype(jnp.float32)))
               - jnp.exp(jnp.sum(lambda_q2[layer].astype(jnp.float32) * lambda_k2[layer].astype(jnp.float32)))
               + lam_init)
        oc = diff_attention(rms_norm(qc.reshape(B, S, C_HEADS, 2, C_HALF), q_norm_c[layer]),
                            rms_norm(kc.reshape(B, S, C_HEADS, 2, C_HALF), k_norm_c[layer]),
                            heads(vc, C_HEADS), bias_c, lam)
        oc = rms_norm(oc, diff_subln_g[layer]) * (1.0 - lam_init)

        mix = jnp.concatenate([oa.reshape(B, S, -1), ob.reshape(B, S, -1), oc.reshape(B, S, -1)], axis=-1)
        x = x + jnp.einsum('bsm,md->bsd', mix, w_out[layer])

        h = rms_norm(x, ffn_norm_g[layer])
        f = layer // 2
        if layer % 2 == 0:
            x = x + swiglu(h, w_dense_gate[f], w_dense_up[f], w_dense_down[f])
        else:
            x = x + moe_swiglu(h, w_router[f], w_moe_gate[f], w_moe_up[f], w_moe_down[f])
    return x
```

```cpp
#include <hip/hip_runtime.h>
#include <cstdio>
#include <cstdint>
#include <cmath>
namespace pg8 {
#define PG8_LAS __attribute__((address_space(3)))
typedef unsigned short bf16_t;
typedef short bf16x8 __attribute__((ext_vector_type(8)));
typedef float f32x4 __attribute__((ext_vector_type(4)));
typedef unsigned u32x4 __attribute__((ext_vector_type(4)));
constexpr int BM = 256, BK = 64, HALF = 128, HTB = HALF * BK * 2  , STAGE_BYTES = 8 * HTB, NXCD = 8, WGM = 8;

__host__ __device__ __forceinline__ int lds_byte(int r, int c) { const int st = (r >> 4) * 2 + (c >> 5), rr = r & 15, cc = c & 31, ob = rr * 64 + cc * 2; return st * 1024 + (ob ^ (((ob >> 9) & 1) << 5)); }
__host__ __device__ __forceinline__ void stage_rc(int b, int& R, int& C) { const int st = b / 1024, sb = b % 1024, swz = sb ^ (((sb >> 9) & 1) << 5); R = (st >> 1) * 16 + swz / 64; C = (st & 1) * 32 + (swz % 64) / 2; }
__host__ __device__ __forceinline__ int perm32(int rho) { const int n = rho >> 4, i = rho & 15; return 8 * (i >> 2) + 4 * n + (i & 3); }

struct Unit { int pm, pn; };
struct Gemm { const bf16_t* A; const bf16_t* Bt; int M, N, K; };

struct StaticOrder {
    int nM, nN, nwg, G, c;
    __host__ __device__ void init(int M, int N, int G_, int c_) { nM = M / BM; nN = N / BM; nwg = nM * nN; G = G_; c = c_; }
    __host__ __device__ bool next(int i, Unit& u) const {
        const long L = (long)i * G + c; if (L >= nwg) return false;
        int wgid = (int)L; { const int q = nwg / NXCD, r = nwg % NXCD, xcd = wgid % NXCD, off = wgid / NXCD; wgid = (xcd < r ? xcd * (q + 1) : r * (q + 1) + (xcd - r) * q) + off; }
        const int nig = WGM * nN, gid = wgid / nig, fm = gid * WGM, gsz = (nM - fm) < WGM ? (nM - fm) : WGM;
        u.pm = fm + ((wgid % nig) % gsz); u.pn = (wgid % nig) / gsz; return true;
    }
    __device__ __forceinline__ void a_ready(const Unit&) const {}
    __device__ __forceinline__ void done(const Unit&) const {}
};

__device__ __forceinline__ unsigned cvt_pk_bf16(float lo, float hi) { unsigned r; asm volatile("v_cvt_pk_bf16_f32 %0, %1, %2" : "=v"(r) : "v"(lo), "v"(hi)); return r; }
typedef float f32x2 __attribute__((ext_vector_type(2)));
struct EpiStoreBf16 {
    static constexpr bool PERM = true, AFTER_DRAIN = false;
    bf16_t* O; int ldc;
    __device__ __forceinline__ void operator()(const f32x4 (&acc)[2][2][4][2], const Unit& u, int wr, int wc, int fr, int fq) const {
        const int row0 = u.pm * BM + wr * 64 + fr, col0 = u.pn * BM + wc * 32 + 8 * fq;
#pragma unroll
        for (int ai = 0; ai < 2; ++ai)
#pragma unroll
            for (int m = 0; m < 4; ++m) { bf16_t* rowp = O + (size_t)(row0 + ai * HALF + m * 16) * ldc + col0;
#pragma unroll
                for (int bj = 0; bj < 2; ++bj) { const f32x4 v0 = acc[ai][bj][m][0], v1 = acc[ai][bj][m][1];
                    u32x4 w; w.x = cvt_pk_bf16(v0[0], v0[1]); w.y = cvt_pk_bf16(v0[2], v0[3]); w.z = cvt_pk_bf16(v1[0], v1[1]); w.w = cvt_pk_bf16(v1[2], v1[3]);
                    *(u32x4*)(rowp + bj * HALF) = w; } }
    }
};
struct EpiResF32 {
    static constexpr bool PERM = false, AFTER_DRAIN = false;
    const float* res; float* out; int ld;
    __device__ __forceinline__ void operator()(const f32x4 (&acc)[2][2][4][2], const Unit& u, int wr, int wc, int fr, int fq) const {
        const int row0 = u.pm * BM + wr * 64 + fr, col0 = u.pn * BM + wc * 32 + 4 * fq;
#pragma unroll
        for (int ai = 0; ai < 2; ++ai)
#pragma unroll
            for (int m = 0; m < 4; ++m) { const size_t ro = (size_t)(row0 + ai * HALF + m * 16) * ld + col0;
#pragma unroll
                for (int bj = 0; bj < 2; ++bj)
#pragma unroll
                    for (int n = 0; n < 2; ++n) { const f32x4 r = *(const f32x4*)(res + ro + bj * HALF + n * 16); *(f32x4*)(out + ro + bj * HALF + n * 16) = acc[ai][bj][m][n] + r; } }
    }
};
__device__ __forceinline__ float silu_mul(float g, float u) { return g * u * __builtin_amdgcn_rcpf(1.0f + __builtin_amdgcn_exp2f(-1.4426950408889634f * g)); }
struct EpiSwiGLU {
    static constexpr bool PERM = true, AFTER_DRAIN = false;
    bf16_t* O; int ldf; int npn;
    __device__ __forceinline__ void operator()(const f32x4 (&acc)[2][2][4][2], const Unit& u, int wr, int wc, int fr, int fq) const {
        const int pnl = u.pn % npn;
        const int row0 = u.pm * BM + wr * 64 + fr, col0 = pnl * HALF + wc * 32 + 8 * fq;
#pragma unroll
        for (int ai = 0; ai < 2; ++ai)
#pragma unroll
            for (int m = 0; m < 4; ++m) { bf16_t* rowp = O + (size_t)(row0 + ai * HALF + m * 16) * ldf + col0;
                const f32x4 g0 = acc[ai][0][m][0], g1 = acc[ai][0][m][1], u0 = acc[ai][1][m][0], u1 = acc[ai][1][m][1];
                u32x4 w; w.x = cvt_pk_bf16(silu_mul(g0[0], u0[0]), silu_mul(g0[1], u0[1])); w.y = cvt_pk_bf16(silu_mul(g0[2], u0[2]), silu_mul(g0[3], u0[3]));
                w.z = cvt_pk_bf16(silu_mul(g1[0], u1[0]), silu_mul(g1[1], u1[1])); w.w = cvt_pk_bf16(silu_mul(g1[2], u1[2]), silu_mul(g1[3], u1[3]));
                *(u32x4*)rowp = w; }
    }
};
struct EpiMoeDown {
    static constexpr bool PERM = false, AFTER_DRAIN = false;
    float* out; const float* gate; int ld; int npn;
    __device__ __forceinline__ void operator()(const f32x4 (&acc)[2][2][4][2], const Unit& u, int wr, int wc, int fr, int fq) const {
        const int pnl = u.pn % npn;
        const int row0 = u.pm * BM + wr * 64 + fr, col0 = pnl * BM + wc * 32 + 4 * fq;
#pragma unroll
        for (int ai = 0; ai < 2; ++ai)
#pragma unroll
            for (int m = 0; m < 4; ++m) { const int row = row0 + ai * HALF + m * 16; const float gt = gate[row]; float* rowp = out + (size_t)row * ld + col0;
#pragma unroll
                for (int bj = 0; bj < 2; ++bj)
#pragma unroll
                    for (int n = 0; n < 2; ++n) *(f32x4*)(rowp + bj * HALF + n * 16) = acc[ai][bj][m][n] * gt; }
    }
};
struct MoeOrder {
    int rt0[9]; int npn, G, c;
    __device__ __forceinline__ bool next(int i, Unit& u) const {
        const int L = i * G + c; if (L >= rt0[8] * npn) return false;
        int e = 0, rb = 0, nr = 1;
#pragma unroll
        for (int k = 0; k < 8; ++k) { const bool in = (L >= rt0[k] * npn) && (L < rt0[k + 1] * npn); e = in ? k : e; rb = in ? rt0[k] : rb; nr = in ? (rt0[k + 1] - rt0[k]) : nr; }
        const int j = L - rb * npn;
        u.pm = rb + (j % nr); u.pn = e * npn + (j / nr); return true;
    }
    __device__ __forceinline__ void a_ready(const Unit&) const {}
    __device__ __forceinline__ void done(const Unit&) const {}
};
template <class Epi, class Sched, bool ALIGN_EPI = false, bool SP2 = false>
__device__ __forceinline__ void gemm_phase(PG8_LAS unsigned char* lds, const Gemm g, const Sched& S, const Epi& E) {
    const int tid = threadIdx.x, wid = __builtin_amdgcn_readfirstlane(tid >> 6), lane = tid & 63, wr = wid >> 2, wc = wid & 3, fr = lane & 15, fq = lane >> 4;
    const int K = g.K, nt = K / BK;
    unsigned voffA[2], voffB[2];
#pragma unroll
    for (int i = 0; i < 2; ++i) { int R, C; stage_rc(tid * 16 + i * 8192, R, C); const int Rb = Epi::PERM ? ((R & ~31) + perm32(R & 31)) : R;
        voffA[i] = (unsigned)(R * K + C) * 2u; voffB[i] = (unsigned)(Rb * K + C) * 2u; }
    const size_t kstep = (size_t)(BK * 2);
    const size_t hstep = (size_t)HALF * K * 2;
    const size_t tstep = 2 * hstep;
    const unsigned ldsw = (unsigned)wid * 1024u;
    const int aoff = lds_byte(wr * 64 + fr, fq * 8), boff = lds_byte(wc * 32 + fr, fq * 8);
#define PG8_SA(b, h) (((b) * 2 + (h)) * HTB)
#define PG8_SB(b, h) ((4 + (b) * 2 + (h)) * HTB)
#define PG8_STAGE(bufoff, gbase, voff) do { _Pragma("unroll") for (int _i = 0; _i < 2; ++_i) \
        __builtin_amdgcn_global_load_lds((const unsigned*)((const char*)(gbase) + (voff)[_i]), (PG8_LAS unsigned*)(lds + (bufoff) + ldsw + _i * 8192), 16, 0, 0); } while (0)
#define PG8_LDA(dst, b, h) do { _Pragma("unroll") for (int m = 0; m < 4; ++m) _Pragma("unroll") for (int k = 0; k < 2; ++k) dst[m][k] = *(const PG8_LAS bf16x8*)(lds + PG8_SA(b, h) + aoff + m * 2048 + k * 1024); } while (0)
#define PG8_LDB(dst, b, h) do { _Pragma("unroll") for (int n = 0; n < 2; ++n) _Pragma("unroll") for (int k = 0; k < 2; ++k) dst[n][k] = *(const PG8_LAS bf16x8*)(lds + PG8_SB(b, h) + boff + n * 2048 + k * 1024); } while (0)
#define PG8_MMA(ai, bj, At, Bt) do { __builtin_amdgcn_s_setprio(1); _Pragma("unroll") for (int m = 0; m < 4; ++m) _Pragma("unroll") for (int n = 0; n < 2; ++n) _Pragma("unroll") for (int k = 0; k < 2; ++k) \
        acc[ai][bj][m][n] = __builtin_amdgcn_mfma_f32_16x16x32_bf16(Bt[n][k], At[m][k], acc[ai][bj][m][n], 0, 0, 0); __builtin_amdgcn_s_setprio(0); } while (0)
#define PG8_WAIT_V(n) asm volatile("s_waitcnt vmcnt(" #n ")" ::: "memory")
#define PG8_WAIT_L(n) asm volatile("s_waitcnt lgkmcnt(" #n ")" ::: "memory")
#define PG8_BAR __builtin_amdgcn_s_barrier()
#define PG8_SCHED __builtin_amdgcn_sched_barrier(0)
    Unit cur, nxt; int ui = 0;
    if (!S.next(0, cur)) return;
    f32x4 acc[2][2][4][2];
#pragma unroll
    for (int a = 0; a < 2; ++a)
#pragma unroll
        for (int b = 0; b < 2; ++b)
#pragma unroll
            for (int m = 0; m < 4; ++m)
#pragma unroll
                for (int n = 0; n < 2; ++n) acc[a][b][m][n] = (f32x4){0.f, 0.f, 0.f, 0.f};
    bf16x8 At[4][2], B0[2][2], B1[2][2];
    const char* cA = (const char*)g.A + (size_t)cur.pm * tstep; const char* cB = (const char*)g.Bt + (size_t)cur.pn * tstep;
    S.a_ready(cur);
    if constexpr (SP2) {
        PG8_STAGE(PG8_SB(0, 0), cB, voffB); PG8_STAGE(PG8_SB(0, 1), cB + hstep, voffB); PG8_STAGE(PG8_SA(0, 0), cA, voffA); PG8_STAGE(PG8_SA(0, 1), cA + hstep, voffA);
        if (wr == 1) PG8_BAR;
        PG8_WAIT_V(2); PG8_BAR;
        PG8_STAGE(PG8_SB(1, 0), cB + kstep, voffB); PG8_STAGE(PG8_SA(1, 0), cA + kstep, voffA); PG8_STAGE(PG8_SB(1, 1), cB + hstep + kstep, voffB);
        PG8_WAIT_V(6); PG8_BAR;
    } else {
        PG8_STAGE(PG8_SB(0, 0), cB, voffB); PG8_STAGE(PG8_SA(0, 0), cA, voffA); PG8_STAGE(PG8_SB(0, 1), cB + hstep, voffB); PG8_STAGE(PG8_SA(0, 1), cA + hstep, voffA);
        if (wr == 1) PG8_BAR;
        PG8_WAIT_V(4); PG8_BAR;
        PG8_STAGE(PG8_SB(1, 0), cB + kstep, voffB); PG8_STAGE(PG8_SA(1, 0), cA + kstep, voffA); PG8_STAGE(PG8_SB(1, 1), cB + hstep + kstep, voffB);
        PG8_WAIT_V(6); PG8_BAR;
    }
    for (;;) {
        const bool has_next = S.next(ui + 1, nxt);
        const char* nA = has_next ? (const char*)g.A + (size_t)nxt.pm * tstep : cA; const char* nB = has_next ? (const char*)g.Bt + (size_t)nxt.pn * tstep : cB;
        for (int t = 0; t < nt; t += 2) {
            const bool last = (t == nt - 2);
            const char* a1 = cA + (size_t)(t + 1) * kstep;
            const char* a2 = last ? nA : cA + (size_t)(t + 2) * kstep; const char* b2 = last ? nB : cB + (size_t)(t + 2) * kstep;
            const char* a3 = a2 + kstep; const char* b3 = b2 + kstep;
            if (last && has_next) S.a_ready(nxt);
            if constexpr (SP2) {
            PG8_LDB(B0, 0, 0); PG8_LDB(B1, 0, 1); PG8_SCHED; PG8_LDA(At, 0, 0); PG8_STAGE(PG8_SA(1, 1), a1 + hstep, voffA);
            PG8_WAIT_V(8); PG8_WAIT_L(0); PG8_BAR; PG8_MMA(0, 0, At, B0); PG8_MMA(0, 1, At, B1); PG8_BAR; PG8_SCHED;
            PG8_LDA(At, 0, 1); PG8_STAGE(PG8_SB(0, 0), b2, voffB); PG8_STAGE(PG8_SB(0, 1), b2 + hstep, voffB); PG8_STAGE(PG8_SA(0, 0), a2, voffA);
            PG8_WAIT_V(8); PG8_WAIT_L(0); PG8_BAR; PG8_MMA(1, 0, At, B0); PG8_MMA(1, 1, At, B1); PG8_BAR; PG8_SCHED;
            PG8_LDB(B0, 1, 0); PG8_LDB(B1, 1, 1); PG8_SCHED; PG8_LDA(At, 1, 0); PG8_STAGE(PG8_SA(0, 1), a2 + hstep, voffA);
            PG8_WAIT_V(8); PG8_WAIT_L(0); PG8_BAR; PG8_MMA(0, 0, At, B0); PG8_MMA(0, 1, At, B1); PG8_BAR; PG8_SCHED;
            PG8_LDA(At, 1, 1); PG8_STAGE(PG8_SB(1, 0), b3, voffB); PG8_STAGE(PG8_SB(1, 1), b3 + hstep, voffB); PG8_STAGE(PG8_SA(1, 0), a3, voffA);
            PG8_WAIT_V(8); PG8_WAIT_L(0); PG8_BAR; PG8_MMA(1, 0, At, B0); PG8_MMA(1, 1, At, B1); PG8_BAR; PG8_SCHED;
            } else {
            PG8_LDB(B0, 0, 0); PG8_SCHED; PG8_LDA(At, 0, 0); PG8_STAGE(PG8_SA(1, 1), a1 + hstep, voffA);
            PG8_WAIT_L(8); PG8_BAR; PG8_WAIT_L(0); PG8_MMA(0, 0, At, B0); PG8_BAR; PG8_SCHED;
            PG8_LDB(B1, 0, 1); PG8_STAGE(PG8_SB(0, 0), b2, voffB);
            PG8_BAR; PG8_WAIT_L(0); PG8_MMA(0, 1, At, B1); PG8_BAR;
            PG8_LDA(At, 0, 1); PG8_STAGE(PG8_SA(0, 0), a2, voffA);
            PG8_BAR; PG8_WAIT_L(0); PG8_MMA(1, 0, At, B0); PG8_BAR; PG8_SCHED;
            PG8_STAGE(PG8_SB(0, 1), b2 + hstep, voffB);
            PG8_WAIT_V(6); PG8_BAR; PG8_MMA(1, 1, At, B1); PG8_BAR;
            PG8_LDB(B0, 1, 0); PG8_SCHED; PG8_LDA(At, 1, 0); PG8_STAGE(PG8_SA(0, 1), a2 + hstep, voffA);
            PG8_WAIT_L(8); PG8_BAR; PG8_WAIT_L(0); PG8_MMA(0, 0, At, B0); PG8_BAR; PG8_SCHED;
            PG8_LDB(B1, 1, 1); PG8_STAGE(PG8_SB(1, 0), b3, voffB);
            PG8_BAR; PG8_WAIT_L(0); PG8_MMA(0, 1, At, B1); PG8_BAR;
            PG8_LDA(At, 1, 1); PG8_STAGE(PG8_SA(1, 0), a3, voffA);
            PG8_BAR; PG8_WAIT_L(0); PG8_MMA(1, 0, At, B0); PG8_BAR; PG8_SCHED;
            PG8_STAGE(PG8_SB(1, 1), b3 + hstep, voffB);
            PG8_WAIT_V(6); PG8_BAR; PG8_MMA(1, 1, At, B1); PG8_BAR;
            }
        }
        if constexpr (ALIGN_EPI) { if (wr == 0) PG8_BAR; }
        if constexpr (!Epi::AFTER_DRAIN) { E(acc, cur, wr, wc, fr, fq); S.done(cur); }
        if (!has_next) break;
#pragma unroll
        for (int a = 0; a < 2; ++a)
#pragma unroll
            for (int b = 0; b < 2; ++b)
#pragma unroll
                for (int m = 0; m < 4; ++m)
#pragma unroll
                    for (int n = 0; n < 2; ++n) acc[a][b][m][n] = (f32x4){0.f, 0.f, 0.f, 0.f};
        cur = nxt; cA = nA; cB = nB; ++ui;
        if constexpr (ALIGN_EPI) { if (wr == 1) PG8_BAR; }
    }
    PG8_WAIT_V(0);
    if constexpr (!ALIGN_EPI) { if (wr == 0) PG8_BAR; }
    PG8_BAR;
    if constexpr (Epi::AFTER_DRAIN) { E.fused(acc, cur, wr, wc, fr, fq, lds, wid, lane); S.done(cur); }
#undef PG8_SA
#undef PG8_SB
#undef PG8_STAGE
#undef PG8_LDA
#undef PG8_LDB
#undef PG8_MMA
#undef PG8_WAIT_V
#undef PG8_WAIT_L
#undef PG8_BAR
#undef PG8_SCHED
}
}

constexpr int NWAVES = 8;
constexpr int S = 8192, D = 2048, NIN = 7248, NINP = 7424, DFF = 5632, DFFE = 7168, NE = 8, DEPTH = 2;
constexpr int PITCH = NINP;
constexpr int C_QA = 0, C_KA = 512, C_VA = 1024, C_QI = 1536, C_QB = 2560, C_KB = 3328, C_VB = 4096, C_QC = 4864, C_KC = 5632, C_VC = 6400, C_KI = 7168, C_WI = 7232;
constexpr int MAXSLOT = 18432;
constexpr float RMS_EPS = 1e-6f;
constexpr float LOG2E = 1.4426950408889634f;
constexpr int TBL_N = 2304, TBL_OFF = 64;
constexpr int DFAR = 2112;

constexpr size_t MiB = 1u << 20;
constexpr size_t WS_CTL = 0, CTL_ZERO_BYTES = 1 * MiB;
constexpr size_t WS_TBL = 1 * MiB, WS_ROUTE = 2 * MiB;
constexpr size_t WS_WIN = 3 * MiB, WS_WOUT = WS_WIN + 58 * MiB, WS_WGU = WS_WOUT + 16 * MiB, WS_WDN = WS_WGU + 44 * MiB, WS_WMGU = WS_WDN + 22 * MiB, WS_WMDN = WS_WMGU + 448 * MiB;
constexpr size_t WS_H = WS_WMDN + 224 * MiB, WS_P = WS_H + 32 * MiB, WS_SC = WS_P + 116 * MiB, WS_WM = WS_SC + 256 * MiB, WS_MIX = WS_WM + 8 * MiB, WS_XB = WS_MIX + 32 * MiB;
constexpr size_t WS_ACT = WS_XB + 64 * MiB, WS_HS = WS_ACT + 252 * MiB, WS_END = WS_HS + 72 * MiB;
constexpr size_t WS_OUTM = WS_SC;
static_assert((size_t)2 * NINP * D * 2 <= 58 * MiB && (size_t)2 * DFF * D * 2 <= 44 * MiB && (size_t)NE * 2 * DFFE * D * 2 <= 448 * MiB && (size_t)MAXSLOT * DFFE * 2 <= 252 * MiB && (size_t)MAXSLOT * D * 4 <= 256 * MiB, "ws map");
constexpr size_t RT_TOKE = 0, RT_TOKR = 65536, RT_TOKG = 131072, RT_TOKS = 196608, RT_SLOTG = 262144;

constexpr int CW_TMO = 0, CW_CODE = 1, CW_BAR = 4096, CW_CNT = 8192, CW_Q = 12288;

constexpr int RING_OFF = 0, RING_BYTES = 131072;
constexpr int XPOSE_SCR = 64 * 65 * 4;
constexpr int LDSCTL_OFF = 8 * XPOSE_SCR, MISC_OFF = LDSCTL_OFF + 320;
constexpr int LDS_TBL_OFF = 134144;
constexpr int LDS_BYTES = 147456;
static_assert(LDS_TBL_OFF + TBL_N * 4 <= LDS_BYTES && MISC_OFF + 128 <= LDS_TBL_OFF && LDSCTL_OFF >= RING_BYTES && LDS_TBL_OFF % 16 == 0, "LDS map");

#define GAS __attribute__((address_space(1)))
#define LAS __attribute__((address_space(3)))
#define DI __device__ __forceinline__
typedef unsigned short bf16;
typedef unsigned v4u __attribute__((ext_vector_type(4)));
typedef unsigned v2u __attribute__((ext_vector_type(2)));
typedef float f32x4 __attribute__((ext_vector_type(4)));
typedef float f32x16 __attribute__((ext_vector_type(16)));
typedef short bf16x8 __attribute__((ext_vector_type(8)));
typedef short s16x4 __attribute__((ext_vector_type(4)));
typedef GAS unsigned gu32;
#define RLX_AGENT __ATOMIC_RELAXED, __HIP_MEMORY_SCOPE_AGENT
#define LDS_WAIT() asm volatile("s_waitcnt lgkmcnt(0)" ::: "memory")
#define VM_WAIT() asm volatile("s_waitcnt vmcnt(0)" ::: "memory")
DI unsigned f2bf(float f) { unsigned u = __builtin_bit_cast(unsigned, f); return (u + 0x7fffu + ((u >> 16) & 1u)) >> 16; }
DI unsigned pk2(float lo, float hi) { unsigned r; asm volatile("v_cvt_pk_bf16_f32 %0, %1, %2" : "=v"(r) : "v"(lo), "v"(hi)); return r; }
DI float bflo(unsigned w) { return __builtin_bit_cast(float, w << 16); }
DI float bfhi(unsigned w) { return __builtin_bit_cast(float, w & 0xffff0000u); }
DI float wave_sum(float v) {
#pragma unroll
    for (int o = 1; o < 64; o <<= 1) v += __shfl_xor(v, o);
    return v;
}
#define XB_TMO      128
#define XB_XCNT(j)  (256  + 64 * (j))
#define XB_XSUB(j)  (1280 + 64 * (j))
#define XB_XGEN(j)  (2304 + 64 * (j))
#define XB_TOP      3328
#define XB_TOPGEN   3392
#define XCD_BAR_WORDS 3456
#define XB_SPIN_CAP (1u << 18)

__device__ __forceinline__ unsigned xb_ld(unsigned* p)              { return __hip_atomic_load(p, __ATOMIC_RELAXED, __HIP_MEMORY_SCOPE_AGENT); }
__device__ __forceinline__ unsigned xb_add(unsigned* p, unsigned v) { return __hip_atomic_fetch_add(p, v, __ATOMIC_RELAXED, __HIP_MEMORY_SCOPE_AGENT); }
__device__ __forceinline__ unsigned xb_xcc_id() { return (unsigned)__builtin_amdgcn_s_getreg((3 << 11) | 20) & 0xFu; }
#define XB_SPIN(cond, bar) do { unsigned _sp = 0; while (cond) { __builtin_amdgcn_s_sleep(1); \
    if ((++_sp & 255u) == 0u) { if (xb_ld(&(bar)[XB_TMO])) break; if (_sp > XB_SPIN_CAP) { atomicAdd(&(bar)[XB_TMO], 1u); break; } } } } while (0)

struct XcdBarrier {
    unsigned* bar; unsigned x;
    volatile LAS unsigned* st;
};

__device__ __forceinline__ XcdBarrier xcd_barrier_post(unsigned* bar, volatile LAS unsigned* st) {
    XcdBarrier b; b.bar = bar; b.x = xb_xcc_id(); b.st = st;
    if (threadIdx.x == 0) (void)xb_add(&bar[XB_XCNT(b.x)], 1u);
    return b;
}
__device__ __forceinline__ void xcd_barrier_complete(unsigned* bar, unsigned x, unsigned& nloc, unsigned& nx) {
    const unsigned G = gridDim.x * gridDim.y * gridDim.z;
    unsigned sum, cnt, mine, sp = 0u;
    for (;;) {
        sum = 0u; cnt = 0u; mine = 0u;
#pragma unroll
        for (unsigned j = 0; j < 16; ++j) { const unsigned c = xb_ld(&bar[XB_XCNT(j)]); sum += c; cnt += (c > 0u) ? 1u : 0u; mine = (j == x) ? c : mine; }
        if (sum == G) break;
        __builtin_amdgcn_s_sleep(1);
        if ((++sp & 255u) == 0u) { if (xb_ld(&bar[XB_TMO])) break; if (sp > XB_SPIN_CAP) { atomicAdd(&bar[XB_TMO], 1u); break; } }
    }
    nloc = mine > 0u ? mine : 1u; nx = cnt > 0u ? cnt : 1u;
}

__device__ __forceinline__ void xcd_barrier(const XcdBarrier& b) {
    asm volatile("s_waitcnt vmcnt(0)" ::: "memory");
    __syncthreads();
    if (threadIdx.x == 0) {
        unsigned* bar = b.bar;
        __builtin_amdgcn_s_waitcnt(0);
        unsigned nloc = b.st[0], nx = b.st[1];
        if (nloc == 0u) { xcd_barrier_complete(bar, b.x, nloc, nx); b.st[0] = nloc; b.st[1] = nx; }
        const unsigned old = xb_add(&bar[XB_XSUB(b.x)], 1u);
        const unsigned gen = old / nloc;
        if (old + 1u == (gen + 1u) * nloc) {
            __builtin_amdgcn_fence(__ATOMIC_RELEASE, "agent");
            asm volatile("s_waitcnt vmcnt(0)" ::: "memory");
            const unsigned og = xb_add(&bar[XB_TOP], 1u);
            const unsigned tg = og / nx;
            if (og + 1u == (tg + 1u) * nx) xb_add(&bar[XB_TOPGEN], 1u);
            else XB_SPIN(xb_ld(&bar[XB_TOPGEN]) == tg, bar);
            __builtin_amdgcn_fence(__ATOMIC_ACQUIRE, "agent");
            xb_add(&bar[XB_XGEN(b.x)], 1u);
            asm volatile("s_waitcnt vmcnt(0)" ::: "memory");
        } else {
            XB_SPIN(xb_ld(&bar[XB_XGEN(b.x)]) == gen, bar);
            __builtin_amdgcn_fence(__ATOMIC_ACQUIRE, "agent");
            asm volatile("s_waitcnt vmcnt(0)" ::: "memory");
        }
    }
    __syncthreads();
}


struct Args { const float* in[24]; float* out; unsigned char* ws; int ph_lo, ph_hi; };
struct Frame {
    LAS unsigned char* lds;
    volatile LAS unsigned* MISC;
    gu32* ctl;
    unsigned char* ws;
    const Args* a; float* out;
    int tid, lane, wave, vcu, G;
};

DI int rowmap(int map, int n) {
    if (map == 1) return n < 2560 ? n : (n < 2640 ? n + (C_KI - 2560) : n - 80);
    if (map == 2) return ((n >> 7) << 8) + (n & 127);
    if (map == 3) return ((n >> 7) << 8) + 128 + (n & 127);
    return n;
}
DI void xpose_item(const float* __restrict__ W, int K, int N, bf16* __restrict__ WT, int map, LAS float* scr, int item, int lane) {
    const int nblk = (N + 63) >> 6, kb = item / nblk, nb = item - kb * nblk, k0 = kb << 6, n0 = nb << 6;
    const int kk = lane >> 4, nq = (lane & 15) << 2;
    const bool okc = (n0 + nq) < N;
    f32x4 v[16];
#pragma unroll
    for (int i = 0; i < 16; ++i) { v[i] = (f32x4){0.f, 0.f, 0.f, 0.f}; if (okc) v[i] = *(const GAS f32x4*)(W + (size_t)(k0 + 4 * i + kk) * N + n0 + nq); }
#pragma unroll
    for (int i = 0; i < 16; ++i) { LAS float* d = scr + (4 * i + kk) * 65 + nq; d[0] = v[i].x; d[1] = v[i].y; d[2] = v[i].z; d[3] = v[i].w; }
    LDS_WAIT(); asm volatile("" ::: "memory");
    const int c = lane & 7;
#pragma unroll
    for (int j = 0; j < 8; ++j) { const int n = (lane >> 3) + 8 * j; const LAS float* s = scr + (8 * c) * 65 + n;
        v4u o; o.x = pk2(s[0 * 65], s[1 * 65]); o.y = pk2(s[2 * 65], s[3 * 65]); o.z = pk2(s[4 * 65], s[5 * 65]); o.w = pk2(s[6 * 65], s[7 * 65]);
        if (n0 + n < N) *(GAS v4u*)(WT + (size_t)rowmap(map, n0 + n) * K + k0 + 8 * c) = o; }
    LDS_WAIT(); asm volatile("" ::: "memory");
}
DI int t5_bucket(int n) {
    if (n < 16) return n;
    const int large = 16 + (int)(logf((float)n / 16.0f) / 4.852030263919617f * 16.0f);
    return large < 31 ? large : 31;
}
DI void rms_row_to_bf16(const float* xrow, const f32x4 (&g)[8], bf16* orow, int lane) {
    const GAS f32x4* xr = (const GAS f32x4*)xrow + lane;
    f32x4 v[8]; float s = 0.f;
#pragma unroll
    for (int j = 0; j < 8; ++j) { v[j] = xr[64 * j]; s += (v[j].x * v[j].x + v[j].y * v[j].y) + (v[j].z * v[j].z + v[j].w * v[j].w); }
    const float rstd = 1.0f / sqrtf(wave_sum(s) * (1.0f / D) + RMS_EPS);
    GAS v2u* o8 = (GAS v2u*)orow + lane;
#pragma unroll
    for (int j = 0; j < 8; ++j) { v2u o; o.x = pk2(v[j].x * rstd * g[j].x, v[j].y * rstd * g[j].y); o.y = pk2(v[j].z * rstd * g[j].z, v[j].w * rstd * g[j].w); o8[64 * j] = o; }
}
DI void rms_phase(Frame& F, const float* x, const float* gvec, bf16* H) {
    const int gw = F.vcu * NWAVES + F.wave, NGW = F.G * NWAVES;
    f32x4 g[8];
#pragma unroll
    for (int j = 0; j < 8; ++j) g[j] = ((const GAS f32x4*)gvec)[F.lane + 64 * j];
    for (int m = gw; m < S; m += NGW) rms_row_to_bf16(x + (size_t)m * D, g, H + (size_t)m * D, F.lane);
}
DI void p0_prologue(Frame& F) {
    LAS float* scr = (LAS float*)(F.lds + F.wave * XPOSE_SCR);
    const int gw = F.vcu * NWAVES + F.wave, NGW = F.G * NWAVES;
    constexpr int I_IN = (D / 64) * ((NIN + 63) / 64), I_OUT = (D / 64) * (D / 64), I_G = (D / 64) * (DFF / 64), I_DN = (DFF / 64) * (D / 64), I_MG = (D / 64) * (DFFE / 64), I_MD = (DFFE / 64) * (D / 64);
    constexpr int NITEMS = 2 * I_IN + 2 * I_OUT + 2 * I_G + I_DN + 16 * I_MG + 8 * I_MD;
    bf16* WIN = (bf16*)(F.ws + WS_WIN); bf16* WOUT = (bf16*)(F.ws + WS_WOUT); bf16* WGU = (bf16*)(F.ws + WS_WGU); bf16* WDN = (bf16*)(F.ws + WS_WDN);
    bf16* WMGU = (bf16*)(F.ws + WS_WMGU); bf16* WMDN = (bf16*)(F.ws + WS_WMDN);
    for (int it = gw; it < NITEMS; it += NGW) {
        int r = it;
        if (r < 2 * I_IN) { const int l = r / I_IN; xpose_item(F.a->in[1] + (size_t)l * D * NIN, D, NIN, WIN + (size_t)l * NINP * D, 1, scr, r - l * I_IN, F.lane); continue; } r -= 2 * I_IN;
        if (r < 2 * I_OUT) { const int l = r / I_OUT; xpose_item(F.a->in[2] + (size_t)l * D * D, D, D, WOUT + (size_t)l * D * D, 0, scr, r - l * I_OUT, F.lane); continue; } r -= 2 * I_OUT;
        if (r < I_G) { xpose_item(F.a->in[17], D, DFF, WGU, 2, scr, r, F.lane); continue; } r -= I_G;
        if (r < I_G) { xpose_item(F.a->in[18], D, DFF, WGU, 3, scr, r, F.lane); continue; } r -= I_G;
        if (r < I_DN) { xpose_item(F.a->in[19], DFF, D, WDN, 0, scr, r, F.lane); continue; } r -= I_DN;
        if (r < 8 * I_MG) { const int e = r / I_MG; xpose_item(F.a->in[21] + (size_t)e * D * DFFE, D, DFFE, WMGU + (size_t)e * 2 * DFFE * D, 2, scr, r - e * I_MG, F.lane); continue; } r -= 8 * I_MG;
        if (r < 8 * I_MG) { const int e = r / I_MG; xpose_item(F.a->in[22] + (size_t)e * D * DFFE, D, DFFE, WMGU + (size_t)e * 2 * DFFE * D, 3, scr, r - e * I_MG, F.lane); continue; } r -= 8 * I_MG;
        { const int e = r / I_MD; xpose_item(F.a->in[23] + (size_t)e * DFFE * D, DFFE, D, WMDN + (size_t)e * D * DFFE, 0, scr, r - e * I_MD, F.lane); }
    }
    { const int gt = (F.vcu * NWAVES + F.wave) * 64 + F.lane, NGT = F.G * NWAVES * 64; constexpr int PADV = (NINP - NIN) * D / 8;
      for (int i = gt; i < 2 * PADV; i += NGT) { const int l = i / PADV, j = i - l * PADV; *((GAS v4u*)(WIN + (size_t)l * NINP * D + (size_t)NIN * D) + j) = (v4u){0u, 0u, 0u, 0u}; }
      float* TBL = (float*)(F.ws + WS_TBL); const float* rel_bias = F.a->in[16];
      for (int i = gt; i < 16 * TBL_N; i += NGT) { const int hd = i / TBL_N, d = (i - hd * TBL_N) - TBL_OFF; float v = 0.f;
          if (d >= 0) { const float e = __expf(rel_bias[t5_bucket(d) * 16 + hd]);
              if (hd >= 4 && hd < 10) { const int mult = (d <= 128 ? 1 : 0) + (((d & 3) == 0 && d <= 512) ? 1 : 0) + (((d & 15) == 0 && d <= 2048) ? 1 : 0); v = e * (float)mult; }
              else v = e; }
          TBL[i] = v; } }
    rms_phase(F, F.a->in[0], F.a->in[3], (bf16*)(F.ws + WS_H));
}

DI void pn_phase(Frame& F, int layer) {
    const int gw = F.vcu * NWAVES + F.wave, NGW = F.G * NWAVES, lane = F.lane;
    bf16* P = (bf16*)(F.ws + WS_P);
    float gs[8][8];
#pragma unroll
    for (int j = 0; j < 8; ++j) {
        const int cc = lane + 64 * j; int col, gi; const float* gv; float sc = 1.0f;
        if (j < 2) { col = 8 * cc; gi = col & 127; if (col < C_KA) { gv = F.a->in[5] + layer * 128; sc = 0.08838834764831845f * LOG2E; } else gv = F.a->in[6] + layer * 128; }
        else if (j < 5) { col = C_QB + 8 * (cc - 128); gi = (col - C_QB) & 127; if (col < C_KB) { gv = F.a->in[7] + layer * 128; sc = 0.08838834764831845f * LOG2E; } else gv = F.a->in[8] + layer * 128; }
        else { col = C_QC + 8 * (cc - 320); gi = (col - C_QC) & 63; if (col < C_KC) { gv = F.a->in[9] + layer * 64; sc = 0.125f * LOG2E; } else gv = F.a->in[10] + layer * 64; }
#pragma unroll
        for (int e = 0; e < 8; ++e) gs[j][e] = gv[gi + e] * sc;
    }
    for (int m = gw; m < S; m += NGW) {
        bf16* row = P + (size_t)m * PITCH;
        v4u raw[8];
#pragma unroll
        for (int j = 0; j < 8; ++j) { const int cc = lane + 64 * j; const int col = j < 2 ? 8 * cc : (j < 5 ? C_QB + 8 * (cc - 128) : C_QC + 8 * (cc - 320)); raw[j] = *(const GAS v4u*)(row + col); }
#pragma unroll
        for (int j = 0; j < 8; ++j) { const int cc = lane + 64 * j; const int col = j < 2 ? 8 * cc : (j < 5 ? C_QB + 8 * (cc - 128) : C_QC + 8 * (cc - 320));
            float x[8]; x[0] = bflo(raw[j].x); x[1] = bfhi(raw[j].x); x[2] = bflo(raw[j].y); x[3] = bfhi(raw[j].y); x[4] = bflo(raw[j].z); x[5] = bfhi(raw[j].z); x[6] = bflo(raw[j].w); x[7] = bfhi(raw[j].w);
            float ss = 0.f;
#pragma unroll
            for (int e = 0; e < 8; ++e) ss += x[e] * x[e];
            ss += __shfl_xor(ss, 1); ss += __shfl_xor(ss, 2); ss += __shfl_xor(ss, 4);
            float rstd;
            if (j < 5) { ss += __shfl_xor(ss, 8); rstd = 1.0f / sqrtf(ss * (1.0f / 128.0f) + RMS_EPS); } else rstd = 1.0f / sqrtf(ss * (1.0f / 64.0f) + RMS_EPS);
            v4u o; o.x = pk2(x[0] * rstd * gs[j][0], x[1] * rstd * gs[j][1]); o.y = pk2(x[2] * rstd * gs[j][2], x[3] * rstd * gs[j][3]);
            o.z = pk2(x[4] * rstd * gs[j][4], x[5] * rstd * gs[j][5]); o.w = pk2(x[6] * rstd * gs[j][6], x[7] * rstd * gs[j][7]);
            *(GAS v4u*)(row + col) = o; }
    }
}

DI void rms_router_phase(Frame& F, const float* x, const float* gvec, const float* wr  , bf16* H) {
    const int gw = F.vcu * NWAVES + F.wave, NGW = F.G * NWAVES, lane = F.lane;
    LAS float* wrT = (LAS float*)(F.lds + RING_OFF);
    for (int i = F.tid; i < D * 8; i += NWAVES * 64) wrT[(i & 7) * D + (i >> 3)] = wr[i];
    __syncthreads();
    f32x4 g[8];
#pragma unroll
    for (int j = 0; j < 8; ++j) g[j] = ((const GAS f32x4*)gvec)[lane + 64 * j];
    int* tok_e = (int*)(F.ws + WS_ROUTE + RT_TOKE); int* tok_r = (int*)(F.ws + WS_ROUTE + RT_TOKR); float* tok_g = (float*)(F.ws + WS_ROUTE + RT_TOKG);
    for (int m = gw; m < S; m += NGW) {
        const GAS f32x4* xr = (const GAS f32x4*)(x + (size_t)m * D) + lane;
        f32x4 v[8]; float s = 0.f;
#pragma unroll
        for (int j = 0; j < 8; ++j) { v[j] = xr[64 * j]; s += (v[j].x * v[j].x + v[j].y * v[j].y) + (v[j].z * v[j].z + v[j].w * v[j].w); }
        const float rstd = 1.0f / sqrtf(wave_sum(s) * (1.0f / D) + RMS_EPS);
        GAS v2u* o8 = (GAS v2u*)(H + (size_t)m * D) + lane;
        float lg[8];
#pragma unroll
        for (int e = 0; e < 8; ++e) lg[e] = 0.f;
#pragma unroll
        for (int j = 0; j < 8; ++j) { v[j].x *= rstd * g[j].x; v[j].y *= rstd * g[j].y; v[j].z *= rstd * g[j].z; v[j].w *= rstd * g[j].w;
            v2u o; o.x = pk2(v[j].x, v[j].y); o.y = pk2(v[j].z, v[j].w); o8[64 * j] = o;
#pragma unroll
            for (int e = 0; e < 8; ++e) { const f32x4 w = *(const LAS f32x4*)(wrT + e * D + 4 * (lane + 64 * j)); lg[e] += (v[j].x * w.x + v[j].y * w.y) + (v[j].z * w.z + v[j].w * w.w); } }
#pragma unroll
        for (int e = 0; e < 8; ++e) lg[e] = wave_sum(lg[e]);
        int e1 = 0; float v1 = lg[0];
#pragma unroll
        for (int e = 1; e < 8; ++e) if (lg[e] > v1) { v1 = lg[e]; e1 = e; }
        int e2 = -1; float v2 = 0.f;
#pragma unroll
        for (int e = 0; e < 8; ++e) if (e != e1 && (e2 < 0 || lg[e] > v2)) { v2 = lg[e]; e2 = e; }
        if (lane == 0) {
            const float ex = __expf(v2 - v1), g1 = 1.0f / (1.0f + ex), g2 = ex * g1;
            const unsigned r1 = __hip_atomic_fetch_add((unsigned*)(F.ctl + CW_CNT + 64 * e1), 1u, RLX_AGENT);
            const unsigned r2 = __hip_atomic_fetch_add((unsigned*)(F.ctl + CW_CNT + 64 * e2), 1u, RLX_AGENT);
            tok_e[2 * m] = e1; tok_e[2 * m + 1] = e2; tok_r[2 * m] = (int)r1; tok_r[2 * m + 1] = (int)r2; tok_g[2 * m] = g1; tok_g[2 * m + 1] = g2;
        }
    }
    __syncthreads();
}
DI void moe_offsets(Frame& F, int (&off)[9]) {
    int acc = 0;
#pragma unroll
    for (int e = 0; e < 8; ++e) { off[e] = acc; const int c = (int)__hip_atomic_load((unsigned*)(F.ctl + CW_CNT + 64 * e), RLX_AGENT); acc += (c + 255) & ~255; }
    off[8] = acc;
}
DI void gather_phase(Frame& F) {
    const int gw = F.vcu * NWAVES + F.wave, NGW = F.G * NWAVES, lane = F.lane;
    int off[9]; moe_offsets(F, off);
    const int* tok_e = (const int*)(F.ws + WS_ROUTE + RT_TOKE); const int* tok_r = (const int*)(F.ws + WS_ROUTE + RT_TOKR); const float* tok_g = (const float*)(F.ws + WS_ROUTE + RT_TOKG);
    int* tok_s = (int*)(F.ws + WS_ROUTE + RT_TOKS); float* slot_g = (float*)(F.ws + WS_ROUTE + RT_SLOTG);
    const bf16* H = (const bf16*)(F.ws + WS_H); bf16* HS = (bf16*)(F.ws + WS_HS);
    for (int m = gw; m < S; m += NGW) {
        const int e1 = tok_e[2 * m], e2 = tok_e[2 * m + 1];
        int o1 = 0, o2 = 0;
#pragma unroll
        for (int e = 0; e < 8; ++e) { o1 = (e == e1) ? off[e] : o1; o2 = (e == e2) ? off[e] : o2; }
        const int s1 = o1 + tok_r[2 * m], s2 = o2 + tok_r[2 * m + 1];
        const GAS v4u* src = (const GAS v4u*)(H + (size_t)m * D) + lane; GAS v4u* d1 = (GAS v4u*)(HS + (size_t)s1 * D) + lane; GAS v4u* d2 = (GAS v4u*)(HS + (size_t)s2 * D) + lane;
#pragma unroll
        for (int j = 0; j < 4; ++j) { const v4u v = src[64 * j]; d1[64 * j] = v; d2[64 * j] = v; }
        if (lane == 0) { tok_s[2 * m] = s1; tok_s[2 * m + 1] = s2; slot_g[s1] = tok_g[2 * m]; slot_g[s2] = tok_g[2 * m + 1]; }
    }
    for (int p = gw; p < off[8]; p += NGW) {
        int e = 0;
#pragma unroll
        for (int k = 1; k < 8; ++k) e += (p >= off[k]) ? 1 : 0;
        int oe = 0;
#pragma unroll
        for (int k = 0; k < 8; ++k) oe = (k == e) ? off[k] : oe;
        const int c = (int)__hip_atomic_load((unsigned*)(F.ctl + CW_CNT + 64 * e), RLX_AGENT);
        if (p >= oe + c) { GAS v4u* d = (GAS v4u*)(HS + (size_t)p * D) + lane;
#pragma unroll
            for (int j = 0; j < 4; ++j) d[64 * j] = (v4u){0u, 0u, 0u, 0u};
            if (lane == 0) slot_g[p] = 0.f; }
    }
}
DI void combine_phase(Frame& F) {
    const int gw = F.vcu * NWAVES + F.wave, NGW = F.G * NWAVES, lane = F.lane;
    const int* tok_s = (const int*)(F.ws + WS_ROUTE + RT_TOKS); const float* XB = (const float*)(F.ws + WS_XB); const float* OUTM = (const float*)(F.ws + WS_OUTM);
    for (int m = gw; m < S; m += NGW) {
        const int s1 = tok_s[2 * m], s2 = tok_s[2 * m + 1];
        const GAS f32x4* a = (const GAS f32x4*)(XB + (size_t)m * D) + lane; const GAS f32x4* b = (const GAS f32x4*)(OUTM + (size_t)s1 * D) + lane; const GAS f32x4* c = (const GAS f32x4*)(OUTM + (size_t)s2 * D) + lane;
        GAS f32x4* o = (GAS f32x4*)(F.out + (size_t)m * D) + lane;
#pragma unroll
        for (int j = 0; j < 8; ++j) o[64 * j] = (a[64 * j] + b[64 * j]) + c[64 * j];
    }
}

DI void i1_phase(Frame& F) {
    const int lane = F.lane, r = lane & 31, hf = lane >> 5;
    const bf16* P = (const bf16*)(F.ws + WS_P); float* SC = (float*)(F.ws + WS_SC);
    const int rank = F.wave < 4 ? F.wave : 11 - F.wave;
    const int aq = (r >> 2) & 1, ah = ((r >> 3) << 2) | (r & 3);
    for (int u = rank * F.G + F.vcu; u < S / 4; u += F.G * NWAVES) {
        const int t0 = 4 * u;
        bf16x8 af[2][4]; float wv[2][16];
#pragma unroll
        for (int mb = 0; mb < 2; ++mb) {
#pragma unroll
            for (int s = 0; s < 4; ++s) af[mb][s] = *(const GAS bf16x8*)(P + (size_t)(t0 + 2 * mb + aq) * PITCH + C_QI + ah * 64 + 16 * s + 8 * hf);
            const GAS v4u* wp = (const GAS v4u*)(P + (size_t)(t0 + 2 * mb + hf) * PITCH + C_WI); const v4u w0 = wp[0], w1 = wp[1];
            wv[mb][0] = bflo(w0.x); wv[mb][1] = bfhi(w0.x); wv[mb][2] = bflo(w0.y); wv[mb][3] = bfhi(w0.y); wv[mb][4] = bflo(w0.z); wv[mb][5] = bfhi(w0.z); wv[mb][6] = bflo(w0.w); wv[mb][7] = bfhi(w0.w);
            wv[mb][8] = bflo(w1.x); wv[mb][9] = bfhi(w1.x); wv[mb][10] = bflo(w1.y); wv[mb][11] = bfhi(w1.y); wv[mb][12] = bflo(w1.z); wv[mb][13] = bfhi(w1.z); wv[mb][14] = bflo(w1.w); wv[mb][15] = bfhi(w1.w);
#pragma unroll
            for (int i = 0; i < 16; ++i) wv[mb][i] *= 0.03125f;
        }
        const int nkb = (t0 + 3) / 32 + 1;
        bf16x8 bc[4], bn[4];
#pragma unroll
        for (int s = 0; s < 4; ++s) bc[s] = *(const GAS bf16x8*)(P + (size_t)r * PITCH + C_KI + 16 * s + 8 * hf);
        for (int kb = 0; kb < nkb; ++kb) {
            const int kn = (kb + 1 < nkb) ? kb + 1 : kb;
#pragma unroll
            for (int s = 0; s < 4; ++s) bn[s] = *(const GAS bf16x8*)(P + (size_t)(32 * kn + r) * PITCH + C_KI + 16 * s + 8 * hf);
#pragma unroll
            for (int mb = 0; mb < 2; ++mb) {
                f32x16 acc;
#pragma unroll
                for (int i = 0; i < 16; ++i) acc[i] = 0.f;
#pragma unroll
                for (int s = 0; s < 4; ++s) acc = __builtin_amdgcn_mfma_f32_32x32x16_bf16(af[mb][s], bc[s], acc, 0, 0, 0);
                float sc = 0.f;
#pragma unroll
                for (int i = 0; i < 16; ++i) sc += wv[mb][i] * fmaxf(acc[i], 0.f);
                SC[(size_t)(t0 + 2 * mb + hf) * S + 32 * kb + r] = sc;
            }
#pragma unroll
            for (int s = 0; s < 4; ++s) bc[s] = bn[s];
        }
    }
}

DI int wave_sum_i(int v) {
#pragma unroll
    for (int o = 1; o < 64; o <<= 1) v += __shfl_xor(v, o);
    return v;
}
#define WRITELANE(x, v, L) asm volatile("s_nop 4\n\tv_writelane_b32 %0, %1, %2" : "+v"(x) : "s"(v), "n"(L))
template <int NREG>
DI void i2_select(const float* srow, unsigned* wrow, int t, int lane) {
    unsigned key[NREG];
    const GAS float* sp = (const GAS float*)srow + lane;
    const int ti = t >> 6; const bool lastok = lane <= (t & 63);
#pragma unroll
    for (int i = 0; i < NREG; ++i) { const unsigned u = __builtin_bit_cast(unsigned, sp[64 * i]); const unsigned k = (u & 0x80000000u) ? ~u : (u | 0x80000000u); key[i] = (i < ti || (i == ti && lastok)) ? k : 0u; }
    unsigned T = 0u;
    for (int bit = 31; bit >= 0; --bit) {
        const unsigned cand = T | (1u << bit);
        int c = 0;
#pragma unroll
        for (int i = 0; i < NREG; ++i) c += (key[i] >= cand) ? 1 : 0;
        if (wave_sum_i(c) >= 256) T = cand;
    }
    int cg = 0;
#pragma unroll
    for (int i = 0; i < NREG; ++i) cg += (key[i] > T) ? 1 : 0;
    const int need = 256 - wave_sum_i(cg);
    int running = 0; unsigned lo0 = 0u, hi0 = 0u, lo1 = 0u, hi1 = 0u;
#pragma unroll
    for (int i = 0; i < NREG; ++i) {
        const bool nz = key[i] != 0u;
        const bool eq = nz && (key[i] == T);
        const unsigned long long eqm = __ballot(eq);
        const int myrank = running + (int)__builtin_amdgcn_mbcnt_hi((unsigned)(eqm >> 32), __builtin_amdgcn_mbcnt_lo((unsigned)eqm, 0u));
        const bool sel = nz && ((key[i] > T) || (eq && myrank < need));
        const unsigned long long sm = __ballot(sel);
        running += __popcll(eqm);
        if (i < 64) { WRITELANE(lo0, (unsigned)sm, i & 63); WRITELANE(hi0, (unsigned)(sm >> 32), i & 63); }
        else { WRITELANE(lo1, (unsigned)sm, i & 63); WRITELANE(hi1, (unsigned)(sm >> 32), i & 63); }
    }
    if (NREG <= 64) { if (lane < NREG) *(GAS v2u*)(wrow + 2 * lane) = (v2u){lo0, hi0}; }
    else { *(GAS v2u*)(wrow + 2 * lane) = (v2u){lo0, hi0}; if (lane < NREG - 64) *(GAS v2u*)(wrow + 128 + 2 * lane) = (v2u){lo1, hi1}; }
}
DI void i2_phase(Frame& F) {
    const int gw = F.vcu * NWAVES + F.wave, NGW = F.G * NWAVES;
    const float* SC = (const float*)(F.ws + WS_SC); unsigned* WM = (unsigned*)(F.ws + WS_WM);
    for (int t = gw; t < 2048; t += NGW) i2_select<32>(SC + (size_t)t * S, WM + (size_t)t * 256, t, F.lane);
    for (int t = 2048 + gw; t < 4096; t += NGW) i2_select<64>(SC + (size_t)t * S, WM + (size_t)t * 256, t, F.lane);
    for (int t = 4096 + gw; t < 6144; t += NGW) i2_select<96>(SC + (size_t)t * S, WM + (size_t)t * 256, t, F.lane);
    for (int t = 6144 + gw; t < 8192; t += NGW) i2_select<128>(SC + (size_t)t * S, WM + (size_t)t * 256, t, F.lane);
}

typedef __bf16 bf16x2_t __attribute__((ext_vector_type(2)));
typedef float f32x2_t __attribute__((ext_vector_type(2)));
typedef short v4i16_t __attribute__((ext_vector_type(4)));
DI unsigned cvtpk_s(float lo, float hi) { f32x2_t v = {lo, hi}; bf16x2_t b = __builtin_convertvector(v, bf16x2_t); return __builtin_bit_cast(unsigned, b); }
DI s16x4 vtr(const LAS unsigned char* p) { return __builtin_bit_cast(s16x4, __builtin_amdgcn_ds_read_tr16_b64_v4i16((LAS v4i16_t*)p)); }
DI unsigned off_a(unsigned row, unsigned ch) { return 2048u * (row >> 3) + 512u * (ch >> 2) + 64u * (row & 7) + 16u * ((ch & 3) ^ ((row >> 2) & 3)); }

#ifndef DBG_NOMASK
#define DBG_NOMASK 0
#endif
DI float and_mask_f(float v, int m) { return __builtin_bit_cast(float, __builtin_bit_cast(int, v) & m); }
constexpr int AT_SLOT = 32768, AT_BUF = 65536;

struct AttnShared { float m2[3]; float lam; float post; };

template <int KIND>
DI void attn_unit(Frame& F, int layer, int head, int qb, const AttnShared& sh) {
    const int tid = F.tid, lane = F.lane, w = F.wave, g = w >> 2, wq = w & 3, r = lane & 31, hf = lane >> 5;
    const bf16* P = (const bf16*)(F.ws + WS_P);
    const int colQ = (KIND == 0 ? C_QA : (KIND == 1 ? C_QB : C_QC)) + 128 * head;
    const int colK = (KIND == 0 ? C_KA : (KIND == 1 ? C_KB : C_KC)) + 128 * head;
    const int colV = (KIND == 0 ? C_VA : (KIND == 1 ? C_VB : C_VC)) + 128 * head;
    const int outc = (KIND == 0 ? 0 : (KIND == 1 ? 512 : 1280)) + 128 * head;
    const int tblh = (KIND == 0 ? 0 : (KIND == 1 ? 4 : 10)) + head;
    const int q0 = 128 * qb, kbeg = (KIND == 1) ? (q0 > 2048 ? q0 - 2048 : 0) : 0, nss = (q0 + 128 - kbeg) >> 7;
    const int qrow0 = q0 + 32 * wq, myq = qrow0 + r;
    constexpr int NQS = (KIND == 2) ? 4 : 8;
    LAS unsigned char* ring = F.lds + RING_OFF;
    LAS float* tblL = (LAS float*)(F.lds + LDS_TBL_OFF);
    { const float* TB = (const float*)(F.ws + WS_TBL) + tblh * TBL_N; for (int i = tid; i < TBL_N; i += NWAVES * 64) tblL[i] = TB[i]; }
    const float c31 = ((const float*)(F.ws + WS_TBL))[tblh * TBL_N + TBL_N - 1];
    bf16x8 qf[NQS];
#pragma unroll
    for (int s = 0; s < NQS; ++s) qf[s] = *(const GAS bf16x8*)(P + (size_t)myq * PITCH + colQ + (KIND == 2 ? 64 * g : 0) + 16 * s + 8 * hf);
    v4u st[8];
    const int ld_ch = tid & 15, ld_row = (tid >> 4) & 31;
#define AT_ISSUE(ss) do { _Pragma("unroll") for (int i_ = 0; i_ < 8; ++i_) { const int key_ = kbeg + 128 * (ss) + 64 * (i_ >> 2) + ld_row + 32 * (i_ & 1); \
        st[i_] = *(const GAS v4u*)(P + (size_t)key_ * PITCH + (((i_ >> 1) & 1) ? colV : colK) + 8 * ld_ch); } } while (0)
#define AT_WRITE(b) do { _Pragma("unroll") for (int i_ = 0; i_ < 8; ++i_) \
        *(LAS v4u*)(ring + (b) * AT_BUF + (i_ >> 2) * AT_SLOT + ((i_ >> 1) & 1) * 16384 + (i_ & 1) * 8192 + off_a(ld_row, ld_ch)) = st[i_]; } while (0)
    AT_ISSUE(0);
    const unsigned* WM = (const unsigned*)(F.ws + WS_WM);
    v2u mw = (v2u){0u, 0u}, mwn = (v2u){0u, 0u};
    if (KIND == 0) mw = *(const GAS v2u*)(WM + (size_t)myq * 256 + (2 * g));
    AT_WRITE(0);
    __syncthreads();
    const unsigned kbase_e = 2048u * (r >> 3) + 64u * (r & 7) + 16u * ((unsigned)hf ^ ((r >> 2) & 3)) + (KIND == 2 ? 1024u * g : 0u);
    const unsigned kbase_o = 2048u * (r >> 3) + 64u * (r & 7) + 16u * ((2u + hf) ^ ((r >> 2) & 3)) + (KIND == 2 ? 1024u * g : 0u);
    const unsigned i16 = lane & 15, tq = i16 >> 2, tp = i16 & 3, blk = (lane >> 4) & 1;
    const unsigned vbase0 = 64u * (4 * hf + tq) + 16u * ((2 * blk + (tp >> 1)) ^ (unsigned)hf) + 8u * (tp & 1);
    const unsigned vbase1 = 64u * (4 * hf + tq) + 16u * ((2 * blk + (tp >> 1)) ^ (2u + hf)) + 8u * (tp & 1);
    f32x16 O[4];
#pragma unroll
    for (int b = 0; b < 4; ++b)
#pragma unroll
        for (int i = 0; i < 16; ++i) O[b][i] = 0.f;
    float lsum = 0.f;
    const float sinit = -sh.m2[KIND];

#define AT_BLOCK(Kimg, Vimg, k0_, mword) do { \
        const int k0 = (k0_); \
        if (k0 <= qrow0 + 31 && !(KIND == 1 && qrow0 - (k0 + 31) > 2048)) { \
            f32x16 Sx; _Pragma("unroll") for (int i = 0; i < 16; ++i) Sx[i] = sinit; \
            _Pragma("unroll") for (int s = 0; s < NQS; ++s) { const bf16x8 kf = *(const LAS bf16x8*)((Kimg) + ((s & 1) ? kbase_o : kbase_e) + 512 * (s >> 1)); \
                Sx = __builtin_amdgcn_mfma_f32_32x32x16_bf16(kf, qf[s], Sx, 0, 0, 0); } \
            if (KIND != 1 && qrow0 - (k0 + 31) >= DFAR) { \
                _Pragma("unroll") for (int i = 0; i < 16; ++i) Sx[i] = __builtin_amdgcn_exp2f(Sx[i]) * c31; \
            } else { \
                const LAS float* tp_ = tblL + (myq - k0 - 4 * hf + TBL_OFF - 27); \
                _Pragma("unroll") for (int i = 0; i < 16; ++i) Sx[i] = __builtin_amdgcn_exp2f(Sx[i]) * tp_[27 - ((i & 3) + 8 * (i >> 2))]; \
            } \
            if (KIND == 0 && !DBG_NOMASK) { const int mm = (int)((mword) >> (4 * hf)); \
                _Pragma("unroll") for (int i = 0; i < 16; ++i) { const float pv_ = Sx[i]; Sx[i] = and_mask_f(pv_, __builtin_amdgcn_sbfe(mm, (i & 3) + 8 * (i >> 2), 1)); } } \
            _Pragma("unroll") for (int i = 0; i < 16; ++i) lsum += Sx[i]; \
            bf16x8 pb[2]; \
            _Pragma("unroll") for (int s2 = 0; s2 < 2; ++s2) { v4u pw; pw.x = cvtpk_s(Sx[8 * s2], Sx[8 * s2 + 1]); pw.y = cvtpk_s(Sx[8 * s2 + 2], Sx[8 * s2 + 3]); \
                pw.z = cvtpk_s(Sx[8 * s2 + 4], Sx[8 * s2 + 5]); pw.w = cvtpk_s(Sx[8 * s2 + 6], Sx[8 * s2 + 7]); pb[s2] = __builtin_bit_cast(bf16x8, pw); } \
            _Pragma("unroll") for (int b = 0; b < 4; ++b) \
                _Pragma("unroll") for (int s2 = 0; s2 < 2; ++s2) { \
                    const s16x4 lo = vtr((Vimg) + vbase0 + 2048 * (2 * s2) + 512 * b), hi = vtr((Vimg) + vbase1 + 2048 * (2 * s2 + 1) + 512 * b); \
                    const bf16x8 vf = __builtin_shufflevector(lo, hi, 0, 1, 2, 3, 4, 5, 6, 7); \
                    O[b] = __builtin_amdgcn_mfma_f32_32x32x16_bf16(vf, pb[s2], O[b], 0, 0, 0); } \
        } } while (0)

    for (int ss = 0; ss < nss; ++ss) {
        const int b = ss & 1; const bool more = (ss + 1 < nss);
        if (more) { AT_ISSUE(ss + 1); if (KIND == 0) mwn = *(const GAS v2u*)(WM + (size_t)myq * 256 + (4 * (ss + 1) + 2 * g)); }
        LAS unsigned char* base = ring + b * AT_BUF;
        const int kss = kbeg + 128 * ss;
        if (KIND != 2) {
            AT_BLOCK(base + g * AT_SLOT, base + g * AT_SLOT + 16384, kss + 64 * g, mw.x);
            AT_BLOCK(base + g * AT_SLOT + 8192, base + g * AT_SLOT + 16384 + 8192, kss + 64 * g + 32, mw.y);
        } else {
            AT_BLOCK(base, base + 16384, kss, 0u);
            AT_BLOCK(base + 8192, base + 16384 + 8192, kss + 32, 0u);
            AT_BLOCK(base + AT_SLOT, base + AT_SLOT + 16384, kss + 64, 0u);
            AT_BLOCK(base + AT_SLOT + 8192, base + AT_SLOT + 16384 + 8192, kss + 96, 0u);
        }
        if (more) { AT_WRITE(b ^ 1); mw = mwn; }
        __syncthreads();
    }
#undef AT_BLOCK
#undef AT_ISSUE
#undef AT_WRITE
    LAS float* stg = (LAS float*)ring;
    float ltot = lsum + __shfl_xor(lsum, 32);
    if (g == 1) {
        const float sc = (KIND == 2) ? 1.0f / ltot : 1.0f;
#pragma unroll
        for (int b = 0; b < 4; ++b)
#pragma unroll
            for (int i = 0; i < 16; ++i) stg[((wq * 64) + (b * 16 + i)) * 64 + lane] = O[b][i] * sc;
        stg[16384 + wq * 64 + lane] = ltot;
    }
    __syncthreads();
    if (g == 0) {
        bf16* MIX = (bf16*)(F.ws + WS_MIX);
        if (KIND != 2) {
            ltot += stg[16384 + wq * 64 + lane];
            const float inv = 1.0f / ltot;
#pragma unroll
            for (int b = 0; b < 4; ++b)
#pragma unroll
                for (int i = 0; i < 16; ++i) O[b][i] = (O[b][i] + stg[((wq * 64) + (b * 16 + i)) * 64 + lane]) * inv;
        } else {
            const float inv = 1.0f / ltot; float ss2 = 0.f;
#pragma unroll
            for (int b = 0; b < 4; ++b)
#pragma unroll
                for (int i = 0; i < 16; ++i) { const float o = O[b][i] * inv - sh.lam * stg[((wq * 64) + (b * 16 + i)) * 64 + lane]; O[b][i] = o; ss2 += o * o; }
            ss2 += __shfl_xor(ss2, 32);
            const float rstd = sh.post / sqrtf(ss2 * (1.0f / 128.0f) + RMS_EPS);
            const float* gsub = F.a->in[15] + layer * 128;
#pragma unroll
            for (int b = 0; b < 4; ++b)
#pragma unroll
                for (int i4 = 0; i4 < 4; ++i4) { const f32x4 gv = *(const GAS f32x4*)(gsub + 32 * b + 8 * i4 + 4 * hf);
                    O[b][4 * i4] *= rstd * gv.x; O[b][4 * i4 + 1] *= rstd * gv.y; O[b][4 * i4 + 2] *= rstd * gv.z; O[b][4 * i4 + 3] *= rstd * gv.w; }
        }
#ifdef DBG_ZERO_KIND
        if (KIND == DBG_ZERO_KIND) {
#pragma unroll
            for (int b = 0; b < 4; ++b)
#pragma unroll
                for (int i = 0; i < 16; ++i) O[b][i] = 0.f; }
#endif
        bf16* orow = MIX + (size_t)myq * D + outc + 4 * hf;
#pragma unroll
        for (int b = 0; b < 4; ++b)
#pragma unroll
            for (int i4 = 0; i4 < 4; ++i4) { v2u o; o.x = cvtpk_s(O[b][4 * i4], O[b][4 * i4 + 1]); o.y = cvtpk_s(O[b][4 * i4 + 2], O[b][4 * i4 + 3]); *(GAS v2u*)(orow + 32 * b + 8 * i4) = o; }
    }
    __syncthreads();
}

DI void attn_setup(Frame& F, int layer, AttnShared& sh) {
    if (F.wave == 0) {
        const int lane = F.lane;
        float ga = fmaxf(fabsf(F.a->in[5][layer * 128 + lane]), fabsf(F.a->in[5][layer * 128 + 64 + lane])), gb = fmaxf(fabsf(F.a->in[6][layer * 128 + lane]), fabsf(F.a->in[6][layer * 128 + 64 + lane]));
        float gc = fmaxf(fabsf(F.a->in[7][layer * 128 + lane]), fabsf(F.a->in[7][layer * 128 + 64 + lane])), gd = fmaxf(fabsf(F.a->in[8][layer * 128 + lane]), fabsf(F.a->in[8][layer * 128 + 64 + lane]));
        float ge = fabsf(F.a->in[9][layer * 64 + lane]), gf = fabsf(F.a->in[10][layer * 64 + lane]);
        float l1 = F.a->in[11][layer * 64 + lane] * F.a->in[12][layer * 64 + lane], l2 = F.a->in[13][layer * 64 + lane] * F.a->in[14][layer * 64 + lane];
#pragma unroll
        for (int o = 1; o < 64; o <<= 1) { ga = fmaxf(ga, __shfl_xor(ga, o)); gb = fmaxf(gb, __shfl_xor(gb, o)); gc = fmaxf(gc, __shfl_xor(gc, o)); gd = fmaxf(gd, __shfl_xor(gd, o));
            ge = fmaxf(ge, __shfl_xor(ge, o)); gf = fmaxf(gf, __shfl_xor(gf, o)); l1 += __shfl_xor(l1, o); l2 += __shfl_xor(l2, o); }
        if (lane == 0) {
            const float lam_init = 0.8f - 0.6f * expf(-0.3f * (float)layer);
            volatile LAS float* mf = (volatile LAS float*)(F.MISC + 16);
            mf[0] = 1.02f * 11.313708499f * LOG2E * ga * gb + 0.5f;
            mf[1] = 1.02f * 11.313708499f * LOG2E * gc * gd + 0.5f;
            mf[2] = 1.02f * 8.0f * LOG2E * ge * gf + 0.5f;
            mf[3] = expf(l1) - expf(l2) + lam_init;
            mf[4] = 1.0f - lam_init;
        }
    }
    __syncthreads();
    { volatile LAS float* mf = (volatile LAS float*)(F.MISC + 16); sh.m2[0] = mf[0]; sh.m2[1] = mf[1]; sh.m2[2] = mf[2]; sh.lam = mf[3]; sh.post = mf[4]; }
}
template <int KIND, int NHEAD>
DI void attn_queue(Frame& F, int layer, const AttnShared& sh) {
    for (;;) {
        if (F.tid == 0) F.MISC[0] = __hip_atomic_fetch_add((unsigned*)(F.ctl + CW_Q + 64 * (layer * 4 + KIND)), 1u, RLX_AGENT);
        __syncthreads();
        const int u = (int)F.MISC[0];
        __syncthreads();
        if (u >= 64 * NHEAD) break;
        const int qb = 63 - u / NHEAD, hd = u % NHEAD;
        attn_unit<KIND>(F, layer, hd, qb, sh);
    }
}
DI void attn_phase(Frame& F, int layer) {
    AttnShared sh; attn_setup(F, layer, sh);
    attn_queue<2, 6>(F, layer, sh);
    attn_queue<0, 4>(F, layer, sh);
    attn_queue<1, 6>(F, layer, sh);
}
#ifdef DBG_CHECKS
constexpr size_t WS_DBG = WS_CTL + 512 * 1024;
__global__ void dbg_check_indexer(unsigned char* ws) {
    const int t = blockIdx.x * 4 + (threadIdx.x >> 6), lane = threadIdx.x & 63;
    const float* SC = (const float*)(ws + WS_SC); const unsigned* WM = (const unsigned*)(ws + WS_WM); const bf16* P = (const bf16*)(ws + WS_P);
    unsigned* flags = (unsigned*)(ws + WS_DBG);
    int pc = 0; float mins = 3.0e38f, maxu = -3.0e38f; int above = 0;
    for (int s = lane; s < S; s += 64) {
        const unsigned w = WM[(size_t)t * 256 + (s >> 5)]; const int bit = (w >> (s & 31)) & 1;
        if (s <= t) { const float v = SC[(size_t)t * S + s]; if (bit) { pc++; mins = fminf(mins, v); } else maxu = fmaxf(maxu, v); }
        else if (bit && s < ((t >> 11) + 1) * 2048) above++;
    }
    for (int o = 1; o < 64; o <<= 1) { pc += __shfl_xor(pc, o); above += __shfl_xor(above, o); mins = fminf(mins, __shfl_xor(mins, o)); maxu = fmaxf(maxu, __shfl_xor(maxu, o)); }
    if (lane == 0) {
        const int want = (t + 1 < 256) ? t + 1 : 256;
        if (pc != want) atomicAdd(&flags[0], 1u);
        if (above) atomicAdd(&flags[2], 1u);
        if (mins < maxu) atomicAdd(&flags[3], 1u);
        if (t > 1000 && pc == 256 && mins <= maxu + 1e-12f) atomicAdd(&flags[4], 1u);
    }
    { const int s = (lane * 131 + t * 7) % (t + 1);
      float sc = 0.f;
      for (int h = 0; h < 16; ++h) { float d = 0.f;
          for (int k = 0; k < 64; ++k) d += __builtin_bit_cast(float, (unsigned)P[(size_t)t * PITCH + C_QI + h * 64 + k] << 16) * __builtin_bit_cast(float, (unsigned)P[(size_t)s * PITCH + C_KI + k] << 16);
          sc += __builtin_bit_cast(float, (unsigned)P[(size_t)t * PITCH + C_WI + h] << 16) * 0.03125f * fmaxf(d, 0.f); }
      const float got = SC[(size_t)t * S + s];
      if (fabsf(got - sc) > 1e-3f * (fabsf(sc) + 0.05f)) atomicAdd(&flags[1], 1u); }
}
__global__ void dbg_check_attnA(unsigned char* ws) {
    const int lane = threadIdx.x & 63, wv = blockIdx.x * 4 + (threadIdx.x >> 6);
    const int head = wv & 3, t = 100 + (wv >> 2) * 127;
    const bf16* P = (const bf16*)(ws + WS_P); const unsigned* WM = (const unsigned*)(ws + WS_WM); const float* TBL = (const float*)(ws + WS_TBL); const bf16* MIX = (const bf16*)(ws + WS_MIX);
    unsigned* flags = (unsigned*)(ws + WS_DBG);
    if (wv == 0 && lane == 0) atomicAdd(&flags[5], 1u);
    const float q0 = __builtin_bit_cast(float, (unsigned)P[(size_t)t * PITCH + C_QA + head * 128 + lane] << 16), q1 = __builtin_bit_cast(float, (unsigned)P[(size_t)t * PITCH + C_QA + head * 128 + 64 + lane] << 16);
    float l = 0.f, o0 = 0.f, o1 = 0.f;
    for (int s = 0; s <= t; ++s) {
        const unsigned w = WM[(size_t)t * 256 + (s >> 5)]; if (!((w >> (s & 31)) & 1)) continue;
        float d = q0 * __builtin_bit_cast(float, (unsigned)P[(size_t)s * PITCH + C_KA + head * 128 + lane] << 16) + q1 * __builtin_bit_cast(float, (unsigned)P[(size_t)s * PITCH + C_KA + head * 128 + 64 + lane] << 16);
        for (int o = 1; o < 64; o <<= 1) d += __shfl_xor(d, o);
        const float p = exp2f(d - 16.0f) * TBL[head * TBL_N + ((t - s) < 2239 ? (t - s) : 2239) + TBL_OFF];
        l += p; o0 += p * __builtin_bit_cast(float, (unsigned)P[(size_t)s * PITCH + C_VA + head * 128 + lane] << 16); o1 += p * __builtin_bit_cast(float, (unsigned)P[(size_t)s * PITCH + C_VA + head * 128 + 64 + lane] << 16);
    }
    o0 /= l; o1 /= l;
    const float g0 = __builtin_bit_cast(float, (unsigned)MIX[(size_t)t * D + head * 128 + lane] << 16), g1 = __builtin_bit_cast(float, (unsigned)MIX[(size_t)t * D + head * 128 + 64 + lane] << 16);
    float e2 = (g0 - o0) * (g0 - o0) + (g1 - o1) * (g1 - o1), n2 = o0 * o0 + o1 * o1;
    for (int o = 1; o < 64; o <<= 1) { e2 += __shfl_xor(e2, o); n2 += __shfl_xor(n2, o); }
    if (lane == 0 && e2 > 1e-3f * n2) atomicAdd(&flags[6], 1u);
    if (lane == 0 && e2 > 3e-2f * n2) atomicAdd(&flags[7], 1u);
}
__global__ void dbg_plant(unsigned char* ws, float* out) {
    const unsigned* flags = (const unsigned*)(ws + WS_DBG);
    if (threadIdx.x == 0) {
        if (flags[0]) out[0] += 1.0e6f;
        if (flags[1]) out[1] += 1.0e5f;
        if (flags[2]) out[2] += 1.0e4f;
        if (flags[3]) out[3] += 1.0e3f;
        if (flags[4] > 100) out[4] += 3.0e3f;
        if (flags[5] != 1) out[5] += 1.0e7f;
        if (flags[6] > 3) out[6] += 1.0e4f;
        if (flags[7] > 3) out[7] += 1.0e5f;
    }
}
#endif

#ifndef MK_PER_PHASE
#define MK_PER_PHASE 1
#endif
constexpr int NPH = 20;
#ifndef PH_MASK
#define PH_MASK 0xFFFFFu
#endif
#define IN(k) ((((PH_MASK) >> (k)) & 1u) && lo <= (k) && (k) < hi)
#define SEAM(k) do { if (IN(k) && IN((k) + 1)) xcd_barrier(bar); } while (0)
template <int LAYER>
DI void layer_phases(Frame& F, const int lo, const int hi, const XcdBarrier& bar) {
    bf16* H = (bf16*)(F.ws + WS_H); bf16* P = (bf16*)(F.ws + WS_P); bf16* MIX = (bf16*)(F.ws + WS_MIX); float* XB = (float*)(F.ws + WS_XB);
    bf16* ACT = (bf16*)(F.ws + WS_ACT); bf16* HS = (bf16*)(F.ws + WS_HS);
    const int bid = (int)blockIdx.x;
        constexpr int layer = LAYER; constexpr int pb = LAYER ? 10 : 1;
        if (IN(pb)) {
            pg8::Gemm g{H, (const bf16*)(F.ws + WS_WIN) + (size_t)layer * NINP * D, S, NINP, D}; pg8::StaticOrder So; So.init(S, NINP, F.G, bid);
            pg8::EpiStoreBf16 E{P, PITCH};
            pg8::gemm_phase<pg8::EpiStoreBf16, pg8::StaticOrder, true, true>(F.lds + RING_OFF, g, So, E);
        } SEAM(pb);
        if (IN(pb + 1)) { pn_phase(F, layer); i1_phase(F); } SEAM(pb + 1);
        if (IN(pb + 2)) { i2_phase(F); } SEAM(pb + 2);
        if (IN(pb + 3)) { attn_phase(F, layer); } SEAM(pb + 3);
        if (IN(pb + 4)) {
            pg8::Gemm g{MIX, (const bf16*)(F.ws + WS_WOUT) + (size_t)layer * D * D, S, D, D}; pg8::StaticOrder So; So.init(S, D, F.G, bid);
            pg8::EpiResF32 E{layer == 0 ? F.a->in[0] : (const float*)XB, XB, D};
            pg8::gemm_phase<pg8::EpiResF32, pg8::StaticOrder, true, true>(F.lds + RING_OFF, g, So, E);
        } SEAM(pb + 4);
        if (layer == 0) {
            if (IN(6)) { rms_phase(F, XB, F.a->in[4], H); } SEAM(6);
            if (IN(7)) {
                pg8::Gemm g{H, (const bf16*)(F.ws + WS_WGU), S, 2 * DFF, D}; pg8::StaticOrder So; So.init(S, 2 * DFF, F.G, bid);
                pg8::EpiSwiGLU E{ACT, DFF, 2 * DFF / 256};
                pg8::gemm_phase<pg8::EpiSwiGLU, pg8::StaticOrder, true, true>(F.lds + RING_OFF, g, So, E);
            } SEAM(7);
            if (IN(8)) {
                pg8::Gemm g{ACT, (const bf16*)(F.ws + WS_WDN), S, D, DFF}; pg8::StaticOrder So; So.init(S, D, F.G, bid);
                pg8::EpiResF32 E{XB, XB, D};
                pg8::gemm_phase<pg8::EpiResF32, pg8::StaticOrder, true, true>(F.lds + RING_OFF, g, So, E);
            } SEAM(8);
            if (IN(9)) { rms_phase(F, XB, F.a->in[3] + D, H); } SEAM(9);
        } else {
            if (IN(15)) { rms_router_phase(F, XB, F.a->in[4] + D, F.a->in[20], H); } SEAM(15);
            if (IN(16)) { gather_phase(F); } SEAM(16);
            if (IN(17)) {
                int off[9]; moe_offsets(F, off);
                pg8::MoeOrder Mo;
_Pragma("unroll")
                for (int e = 0; e < 9; ++e) Mo.rt0[e] = off[e] >> 8; Mo.npn = 2 * DFFE / 256; Mo.G = F.G; Mo.c = bid;
                pg8::Gemm g{HS, (const bf16*)(F.ws + WS_WMGU), MAXSLOT, NE * 2 * DFFE, D};
                pg8::EpiSwiGLU E{ACT, DFFE, 2 * DFFE / 256};
                pg8::gemm_phase<pg8::EpiSwiGLU, pg8::MoeOrder, true, true>(F.lds + RING_OFF, g, Mo, E);
            } SEAM(17);
            if (IN(18)) {
                int off[9]; moe_offsets(F, off);
                pg8::MoeOrder Mo;
_Pragma("unroll")
                for (int e = 0; e < 9; ++e) Mo.rt0[e] = off[e] >> 8; Mo.npn = D / 256; Mo.G = F.G; Mo.c = bid;
                pg8::Gemm g{ACT, (const bf16*)(F.ws + WS_WMDN), MAXSLOT, NE * D, DFFE};
                pg8::EpiMoeDown E{(float*)(F.ws + WS_OUTM), (const float*)(F.ws + WS_ROUTE + RT_SLOTG), D, D / 256};
                pg8::gemm_phase<pg8::EpiMoeDown, pg8::MoeOrder, true, true>(F.lds + RING_OFF, g, Mo, E);
            } SEAM(18);
            if (IN(19)) { combine_phase(F); }
        }
    }
__global__ void __launch_bounds__(NWAVES * 64, 2) trunk_fwd(Args args) {
    extern __shared__ __attribute__((aligned(16))) unsigned char lds[];
    Frame F;
    F.lds = (LAS unsigned char*)lds;
    F.MISC = (volatile LAS unsigned*)(F.lds + MISC_OFF);
    F.tid = threadIdx.x; F.lane = F.tid & 63; F.wave = __builtin_amdgcn_readfirstlane(F.tid >> 6);
    F.G = gridDim.x; { const int bx = blockIdx.x; F.vcu = (F.G % 8 == 0) ? (bx % 8) * (F.G / 8) + bx / 8 : bx; }
    F.ws = args.ws; F.ctl = (gu32*)(args.ws + WS_CTL); F.out = args.out;
    F.a = &args;
    for (int u = F.tid; u < (LDS_TBL_OFF - LDSCTL_OFF) / 4; u += NWAVES * 64) ((LAS unsigned*)(F.lds + LDSCTL_OFF))[u] = 0u;
    __syncthreads();
    const int lo = args.ph_lo, hi = args.ph_hi;
    XcdBarrier bar; bar.bar = (unsigned*)(F.ctl + CW_BAR); bar.x = 0; bar.st = nullptr;
    if (hi - lo > 1) bar = xcd_barrier_post((unsigned*)(F.ctl + CW_BAR), F.MISC + 8);

    if (IN(0)) { p0_prologue(F); } SEAM(0);

    layer_phases<0>(F, lo, hi, bar);
    layer_phases<1>(F, lo, hi, bar);
#undef IN
#undef SEAM
}

extern "C" void kernel_launch(void* const* d_in, const int* in_sizes, int n_in, void* d_out, int out_size, void* d_ws, size_t ws_size, hipStream_t stream) {
    static int grid = 0;
    if (grid == 0) {
        if (n_in != 24 || in_sizes[0] != S * D || out_size != S * D || ws_size < WS_END) { fprintf(stderr, "kernel_launch: unexpected shapes (n_in %d, x %d, out %d, ws %zu < %zu); nothing launched\n", n_in, n_in > 0 ? in_sizes[0] : -1, out_size, ws_size, (size_t)WS_END); grid = -1; return; }
        int dev = 0, cus = 0, per_cu = 0;
        if (hipGetDevice(&dev) != hipSuccess || hipDeviceGetAttribute(&cus, hipDeviceAttributeMultiprocessorCount, dev) != hipSuccess) { grid = -1; return; }
        if (hipFuncSetAttribute((const void*)trunk_fwd, hipFuncAttributeMaxDynamicSharedMemorySize, LDS_BYTES) != hipSuccess) { fprintf(stderr, "kernel_launch: hipFuncSetAttribute failed\n"); grid = -1; return; }
        if (hipOccupancyMaxActiveBlocksPerMultiprocessor(&per_cu, (const void*)trunk_fwd, NWAVES * 64, LDS_BYTES) != hipSuccess || per_cu < 1) { fprintf(stderr, "kernel_launch: occupancy query says %d blocks per CU\n", per_cu); (void)hipGetLastError(); per_cu = 1; }
        grid = cus;
        if (grid > 256) grid = 256;
    }
    if (grid < 0) return;
    if (hipMemsetAsync((char*)d_ws + WS_CTL, 0, CTL_ZERO_BYTES, stream) != hipSuccess) return;
    Args a{};
    for (int i = 0; i < 24; ++i) a.in[i] = (const float*)d_in[i];
    a.out = (float*)d_out; a.ws = (unsigned char*)d_ws;
#if MK_PER_PHASE
    for (int k = 0; k < NPH; ++k) { a.ph_lo = k; a.ph_hi = k + 1; hipLaunchKernelGGL(trunk_fwd, dim3(grid), dim3(NWAVES * 64), LDS_BYTES, stream, a);
#ifdef DBG_CHECKS
        if (k == 3) hipLaunchKernelGGL(dbg_check_indexer, dim3(S / 4), dim3(256), 0, stream, (unsigned char*)d_ws);
        if (k == 4) hipLaunchKernelGGL(dbg_check_attnA, dim3(64), dim3(256), 0, stream, (unsigned char*)d_ws);
        if (k == NPH - 1) hipLaunchKernelGGL(dbg_plant, dim3(1), dim3(64), 0, stream, (unsigned char*)d_ws, (float*)d_out);
#endif
    }
#else
    a.ph_lo = 0; a.ph_hi = NPH;
    hipLaunchKernelGGL(trunk_fwd, dim3(grid), dim3(NWAVES * 64), LDS_BYTES, stream, a);
#endif
    const hipError_t le = hipPeekAtLastError();
    if (le != hipSuccess) fprintf(stderr, "kernel_launch: launch failed: %s\n", hipGetErrorName(le));
}
```

```cpp
#include <hip/hip_runtime.h>
#include <cstdio>
#include <cstdint>
#include <cmath>
namespace pg8 {
#define PG8_LAS __attribute__((address_space(3)))
typedef unsigned short bf16_t;
typedef short bf16x8 __attribute__((ext_vector_type(8)));
typedef float f32x4 __attribute__((ext_vector_type(4)));
typedef unsigned u32x4 __attribute__((ext_vector_type(4)));
constexpr int BM = 256, BK = 64, HALF = 128, HTB = HALF * BK * 2  , STAGE_BYTES = 8 * HTB, NXCD = 8, WGM = 8;

__host__ __device__ __forceinline__ int lds_byte(int r, int c) { const int st = (r >> 4) * 2 + (c >> 5), rr = r & 15, cc = c & 31, ob = rr * 64 + cc * 2; return st * 1024 + (ob ^ (((ob >> 9) & 1) << 5)); }
__host__ __device__ __forceinline__ void stage_rc(int b, int& R, int& C) { const int st = b / 1024, sb = b % 1024, swz = sb ^ (((sb >> 9) & 1) << 5); R = (st >> 1) * 16 + swz / 64; C = (st & 1) * 32 + (swz % 64) / 2; }
__host__ __device__ __forceinline__ int perm32(int rho) { const int n = rho >> 4, i = rho & 15; return 8 * (i >> 2) + 4 * n + (i & 3); }

struct Unit { int pm, pn; };
struct Gemm { const bf16_t* A; const bf16_t* Bt; int M, N, K; };

struct StaticOrder {
    int nM, nN, nwg, G, c;
    __host__ __device__ void init(int M, int N, int G_, int c_) { nM = M / BM; nN = N / BM; nwg = nM * nN; G = G_; c = c_; }
    __host__ __device__ bool next(int i, Unit& u) const {
        const long L = (long)i * G + c; if (L >= nwg) return false;
        int wgid = (int)L; { const int q = nwg / NXCD, r = nwg % NXCD, xcd = wgid % NXCD, off = wgid / NXCD; wgid = (xcd < r ? xcd * (q + 1) : r * (q + 1) + (xcd - r) * q) + off; }
        const int nig = WGM * nN, gid = wgid / nig, fm = gid * WGM, gsz = (nM - fm) < WGM ? (nM - fm) : WGM;
        u.pm = fm + ((wgid % nig) % gsz); u.pn = (wgid % nig) / gsz; return true;
    }
    __device__ __forceinline__ void a_ready(const Unit&) const {}
    __device__ __forceinline__ void done(const Unit&) const {}
};

__device__ __forceinline__ unsigned cvt_pk_bf16(float lo, float hi) { unsigned r; asm volatile("v_cvt_pk_bf16_f32 %0, %1, %2" : "=v"(r) : "v"(lo), "v"(hi)); return r; }
typedef float f32x2 __attribute__((ext_vector_type(2)));
struct EpiStoreBf16 {
    static constexpr bool PERM = true, AFTER_DRAIN = false;
    bf16_t* O; int ldc;
    __device__ __forceinline__ void operator()(const f32x4 (&acc)[2][2][4][2], const Unit& u, int wr, int wc, int fr, int fq) const {
        const int row0 = u.pm * BM + wr * 64 + fr, col0 = u.pn * BM + wc * 32 + 8 * fq;
#pragma unroll
        for (int ai = 0; ai < 2; ++ai)
#pragma unroll
            for (int m = 0; m < 4; ++m) { bf16_t* rowp = O + (size_t)(row0 + ai * HALF + m * 16) * ldc + col0;
#pragma unroll
                for (int bj = 0; bj < 2; ++bj) { const f32x4 v0 = acc[ai][bj][m][0], v1 = acc[ai][bj][m][1];
                    u32x4 w; w.x = cvt_pk_bf16(v0[0], v0[1]); w.y = cvt_pk_bf16(v0[2], v0[3]); w.z = cvt_pk_bf16(v1[0], v1[1]); w.w = cvt_pk_bf16(v1[2], v1[3]);
                    *(u32x4*)(rowp + bj * HALF) = w; } }
    }
};
struct EpiResF32 {
    static constexpr bool PERM = false, AFTER_DRAIN = false;
    const float* res; float* out; int ld;
    __device__ __forceinline__ void operator()(const f32x4 (&acc)[2][2][4][2], const Unit& u, int wr, int wc, int fr, int fq) const {
        const int row0 = u.pm * BM + wr * 64 + fr, col0 = u.pn * BM + wc * 32 + 4 * fq;
#pragma unroll
        for (int ai = 0; ai < 2; ++ai)
#pragma unroll
            for (int m = 0; m < 4; ++m) { const size_t ro = (size_t)(row0 + ai * HALF + m * 16) * ld + col0;
#pragma unroll
                for (int bj = 0; bj < 2; ++bj)
#pragma unroll
                    for (int n = 0; n < 2; ++n) { const f32x4 r = *(const f32x4*)(res + ro + bj * HALF + n * 16); *(f32x4*)(out + ro + bj * HALF + n * 16) = acc[ai][bj][m][n] + r; } }
    }
};
__device__ __forceinline__ float silu_mul(float g, float u) { return g * u * __builtin_amdgcn_rcpf(1.0f + __builtin_amdgcn_exp2f(-1.4426950408889634f * g)); }
struct EpiSwiGLU {
    static constexpr bool PERM = true, AFTER_DRAIN = false;
    bf16_t* O; int ldf; int npn;
    __device__ __forceinline__ void operator()(const f32x4 (&acc)[2][2][4][2], const Unit& u, int wr, int wc, int fr, int fq) const {
        const int pnl = u.pn % npn;
        const int row0 = u.pm * BM + wr * 64 + fr, col0 = pnl * HALF + wc * 32 + 8 * fq;
#pragma unroll
        for (int ai = 0; ai < 2; ++ai)
#pragma unroll
            for (int m = 0; m < 4; ++m) { bf16_t* rowp = O + (size_t)(row0 + ai * HALF + m * 16) * ldf + col0;
                const f32x4 g0 = acc[ai][0][m][0], g1 = acc[ai][0][m][1], u0 = acc[ai][1][m][0], u1 = acc[ai][1][m][1];
                u32x4 w; w.x = cvt_pk_bf16(silu_mul(g0[0], u0[0]), silu_mul(g0[1], u0[1])); w.y = cvt_pk_bf16(silu_mul(g0[2], u0[2]), silu_mul(g0[3], u0[3]));
                w.z = cvt_pk_bf16(silu_mul(g1[0], u1[0]), silu_mul(g1[1], u1[1])); w.w = cvt_pk_bf16(silu_mul(g1[2], u1[2]), silu_mul(g1[3], u1[3]));
                *(u32x4*)rowp = w; }
    }
};
struct EpiMoeDown {
    static constexpr bool PERM = false, AFTER_DRAIN = false;
    float* out; const float* gate; int ld; int npn;
    __device__ __forceinline__ void operator()(const f32x4 (&acc)[2][2][4][2], const Unit& u, int wr, int wc, int fr, int fq) const {
        const int pnl = u.pn % npn;
        const int row0 = u.pm * BM + wr * 64 + fr, col0 = pnl * BM + wc * 32 + 4 * fq;
#pragma unroll
        for (int ai = 0; ai < 2; ++ai)
#pragma unroll
            for (int m = 0; m < 4; ++m) { const int row = row0 + ai * HALF + m * 16; const float gt = gate[row]; float* rowp = out + (size_t)row * ld + col0;
#pragma unroll
                for (int bj = 0; bj < 2; ++bj)
#pragma unroll
                    for (int n = 0; n < 2; ++n) *(f32x4*)(rowp + bj * HALF + n * 16) = acc[ai][bj][m][n] * gt; }
    }
};
struct MoeOrder {
    int rt0[9]; int npn, G, c;
    __device__ __forceinline__ bool next(int i, Unit& u) const {
        const int L = i * G + c; if (L >= rt0[8] * npn) return false;
        int e = 0, rb = 0, nr = 1;
#pragma unroll
        for (int k = 0; k < 8; ++k) { const bool in = (L >= rt0[k] * npn) && (L < rt0[k + 1] * npn); e = in ? k : e; rb = in ? rt0[k] : rb; nr = in ? (rt0[k + 1] - rt0[k]) : nr; }
        const int j = L - rb * npn;
        u.pm = rb + (j % nr); u.pn = e * npn + (j / nr); return true;
    }
    __device__ __forceinline__ void a_ready(const Unit&) const {}
    __device__ __forceinline__ void done(const Unit&) const {}
};
template <class Epi, class Sched, bool ALIGN_EPI = false, bool SP2 = false>
__device__ __forceinline__ void gemm_phase(PG8_LAS unsigned char* lds, const Gemm g, const Sched& S, const Epi& E) {
    const int tid = threadIdx.x, wid = __builtin_amdgcn_readfirstlane(tid >> 6), lane = tid & 63, wr = wid >> 2, wc = wid & 3, fr = lane & 15, fq = lane >> 4;
    const int K = g.K, nt = K / BK;
    unsigned voffA[2], voffB[2];
#pragma unroll
    for (int i = 0; i < 2; ++i) { int R, C; stage_rc(tid * 16 + i * 8192, R, C); const int Rb = Epi::PERM ? ((R & ~31) + perm32(R & 31)) : R;
        voffA[i] = (unsigned)(R * K + C) * 2u; voffB[i] = (unsigned)(Rb * K + C) * 2u; }
    const size_t kstep = (size_t)(BK * 2);
    const size_t hstep = (size_t)HALF * K * 2;
    const size_t tstep = 2 * hstep;
    const unsigned ldsw = (unsigned)wid * 1024u;
    const int aoff = lds_byte(wr * 64 + fr, fq * 8), boff = lds_byte(wc * 32 + fr, fq * 8);
#define PG8_SA(b, h) (((b) * 2 + (h)) * HTB)
#define PG8_SB(b, h) ((4 + (b) * 2 + (h)) * HTB)
#define PG8_STAGE(bufoff, gbase, voff) do { _Pragma("unroll") for (int _i = 0; _i < 2; ++_i) \
        __builtin_amdgcn_global_load_lds((const unsigned*)((const char*)(gbase) + (voff)[_i]), (PG8_LAS unsigned*)(lds + (bufoff) + ldsw + _i * 8192), 16, 0, 0); } while (0)
#define PG8_LDA(dst, b, h) do { _Pragma("unroll") for (int m = 0; m < 4; ++m) _Pragma("unroll") for (int k = 0; k < 2; ++k) dst[m][k] = *(const PG8_LAS bf16x8*)(lds + PG8_SA(b, h) + aoff + m * 2048 + k * 1024); } while (0)
#define PG8_LDB(dst, b, h) do { _Pragma("unroll") for (int n = 0; n < 2; ++n) _Pragma("unroll") for (int k = 0; k < 2; ++k) dst[n][k] = *(const PG8_LAS bf16x8*)(lds + PG8_SB(b, h) + boff + n * 2048 + k * 1024); } while (0)
#define PG8_MMA(ai, bj, At, Bt) do { __builtin_amdgcn_s_setprio(1); _Pragma("unroll") for (int m = 0; m < 4; ++m) _Pragma("unroll") for (int n = 0; n < 2; ++n) _Pragma("unroll") for (int k = 0; k < 2; ++k) \
        acc[ai][bj][m][n] = __builtin_amdgcn_mfma_f32_16x16x32_bf16(Bt[n][k], At[m][k], acc[ai][bj][m][n], 0, 0, 0); __builtin_amdgcn_s_setprio(0); } while (0)
#define PG8_WAIT_V(n) asm volatile("s_waitcnt vmcnt(" #n ")" ::: "memory")
#define PG8_WAIT_L(n) asm volatile("s_waitcnt lgkmcnt(" #n ")" ::: "memory")
#define PG8_BAR __builtin_amdgcn_s_barrier()
#define PG8_SCHED __builtin_amdgcn_sched_barrier(0)
    Unit cur, nxt; int ui = 0;
    if (!S.next(0, cur)) return;
    f32x4 acc[2][2][4][2];
#pragma unroll
    for (int a = 0; a < 2; ++a)
#pragma unroll
        for (int b = 0; b < 2; ++b)
#pragma unroll
            for (int m = 0; m < 4; ++m)
#pragma unroll
                for (int n = 0; n < 2; ++n) acc[a][b][m][n] = (f32x4){0.f, 0.f, 0.f, 0.f};
    bf16x8 At[4][2], B0[2][2], B1[2][2];
    const char* cA = (const char*)g.A + (size_t)cur.pm * tstep; const char* cB = (const char*)g.Bt + (size_t)cur.pn * tstep;
    S.a_ready(cur);
    if constexpr (SP2) {
        PG8_STAGE(PG8_SB(0, 0), cB, voffB); PG8_STAGE(PG8_SB(0, 1), cB + hstep, voffB); PG8_STAGE(PG8_SA(0, 0), cA, voffA); PG8_STAGE(PG8_SA(0, 1), cA + hstep, voffA);
        if (wr == 1) PG8_BAR;
        PG8_WAIT_V(2); PG8_BAR;
        PG8_STAGE(PG8_SB(1, 0), cB + kstep, voffB); PG8_STAGE(PG8_SA(1, 0), cA + kstep, voffA); PG8_STAGE(PG8_SB(1, 1), cB + hstep + kstep, voffB);
        PG8_WAIT_V(6); PG8_BAR;
    } else {
        PG8_STAGE(PG8_SB(0, 0), cB, voffB); PG8_STAGE(PG8_SA(0, 0), cA, voffA); PG8_STAGE(PG8_SB(0, 1), cB + hstep, voffB); PG8_STAGE(PG8_SA(0, 1), cA + hstep, voffA);
        if (wr == 1) PG8_BAR;
        PG8_WAIT_V(4); PG8_BAR;
        PG8_STAGE(PG8_SB(1, 0), cB + kstep, voffB); PG8_STAGE(PG8_SA(1, 0), cA + kstep, voffA); PG8_STAGE(PG8_SB(1, 1), cB + hstep + kstep, voffB);
        PG8_WAIT_V(6); PG8_BAR;
    }
    for (;;) {
        const bool has_next = S.next(ui + 1, nxt);
        const char* nA = has_next ? (const char*)g.A + (size_t)nxt.pm * tstep : cA; const char* nB = has_next ? (const char*)g.Bt + (size_t)nxt.pn * tstep : cB;
        for (int t = 0; t < nt; t += 2) {
            const bool last = (t == nt - 2);
            const char* a1 = cA + (size_t)(t + 1) * kstep;
            const char* a2 = last ? nA : cA + (size_t)(t + 2) * kstep; const char* b2 = last ? nB : cB + (size_t)(t + 2) * kstep;
            const char* a3 = a2 + kstep; const char* b3 = b2 + kstep;
            if (last && has_next) S.a_ready(nxt);
            if constexpr (SP2) {
            PG8_LDB(B0, 0, 0); PG8_LDB(B1, 0, 1); PG8_SCHED; PG8_LDA(At, 0, 0); PG8_STAGE(PG8_SA(1, 1), a1 + hstep, voffA);
            PG8_WAIT_V(8); PG8_WAIT_L(0); PG8_BAR; PG8_MMA(0, 0, At, B0); PG8_MMA(0, 1, At, B1); PG8_BAR; PG8_SCHED;
            PG8_LDA(At, 0, 1); PG8_STAGE(PG8_SB(0, 0), b2, voffB); PG8_STAGE(PG8_SB(0, 1), b2 + hstep, voffB); PG8_STAGE(PG8_SA(0, 0), a2, voffA);
            PG8_WAIT_V(8); PG8_WAIT_L(0); PG8_BAR; PG8_MMA(1, 0, At, B0); PG8_MMA(1, 1, At, B1); PG8_BAR; PG8_SCHED;
            PG8_LDB(B0, 1, 0); PG8_LDB(B1, 1, 1); PG8_SCHED; PG8_LDA(At, 1, 0); PG8_STAGE(PG8_SA(0, 1), a2 + hstep, voffA);
            PG8_WAIT_V(8); PG8_WAIT_L(0); PG8_BAR; PG8_MMA(0, 0, At, B0); PG8_MMA(0, 1, At, B1); PG8_BAR; PG8_SCHED;
            PG8_LDA(At, 1, 1); PG8_STAGE(PG8_SB(1, 0), b3, voffB); PG8_STAGE(PG8_SB(1, 1), b3 + hstep, voffB); PG8_STAGE(PG8_SA(1, 0), a3, voffA);
            PG8_WAIT_V(8); PG8_WAIT_L(0); PG8_BAR; PG8_MMA(1, 0, At, B0); PG8_MMA(1, 1, At, B1); PG8_BAR; PG8_SCHED;
            } else {
            PG8_LDB(B0, 0, 0); PG8_SCHED; PG8_LDA(At, 0, 0); PG8_STAGE(PG8_SA(1, 1), a1 + hstep, voffA);
            PG8_WAIT_L(8); PG8_BAR; PG8_WAIT_L(0); PG8_MMA(0, 0, At, B0); PG8_BAR; PG8_SCHED;
            PG8_LDB(B1, 0, 1); PG8_STAGE(PG8_SB(0, 0), b2, voffB);
            PG8_BAR; PG8_WAIT_L(0); PG8_MMA(0, 1, At, B1); PG8_BAR;
            PG8_LDA(At, 0, 1); PG8_STAGE(PG8_SA(0, 0), a2, voffA);
            PG8_BAR; PG8_WAIT_L(0); PG8_MMA(1, 0, At, B0); PG8_BAR; PG8_SCHED;
            PG8_STAGE(PG8_SB(0, 1), b2 + hstep, voffB);
            PG8_WAIT_V(6); PG8_BAR; PG8_MMA(1, 1, At, B1); PG8_BAR;
            PG8_LDB(B0, 1, 0); PG8_SCHED; PG8_LDA(At, 1, 0); PG8_STAGE(PG8_SA(0, 1), a2 + hstep, voffA);
            PG8_WAIT_L(8); PG8_BAR; PG8_WAIT_L(0); PG8_MMA(0, 0, At, B0); PG8_BAR; PG8_SCHED;
            PG8_LDB(B1, 1, 1); PG8_STAGE(PG8_SB(1, 0), b3, voffB);
            PG8_BAR; PG8_WAIT_L(0); PG8_MMA(0, 1, At, B1); PG8_BAR;
            PG8_LDA(At, 1, 1); PG8_STAGE(PG8_SA(1, 0), a3, voffA);
            PG8_BAR; PG8_WAIT_L(0); PG8_MMA(1, 0, At, B0); PG8_BAR; PG8_SCHED;
            PG8_STAGE(PG8_SB(1, 1), b3 + hstep, voffB);
            PG8_WAIT_V(6); PG8_BAR; PG8_MMA(1, 1, At, B1); PG8_BAR;
            }
        }
        if constexpr (ALIGN_EPI) { if (wr == 0) PG8_BAR; }
        if constexpr (!Epi::AFTER_DRAIN) { E(acc, cur, wr, wc, fr, fq); S.done(cur); }
        if (!has_next) break;
#pragma unroll
        for (int a = 0; a < 2; ++a)
#pragma unroll
            for (int b = 0; b < 2; ++b)
#pragma unroll
                for (int m = 0; m < 4; ++m)
#pragma unroll
                    for (int n = 0; n < 2; ++n) acc[a][b][m][n] = (f32x4){0.f, 0.f, 0.f, 0.f};
        cur = nxt; cA = nA; cB = nB; ++ui;
        if constexpr (ALIGN_EPI) { if (wr == 1) PG8_BAR; }
    }
    PG8_WAIT_V(0);
    if constexpr (!ALIGN_EPI) { if (wr == 0) PG8_BAR; }
    PG8_BAR;
    if constexpr (Epi::AFTER_DRAIN) { E.fused(acc, cur, wr, wc, fr, fq, lds, wid, lane); S.done(cur); }
#undef PG8_SA
#undef PG8_SB
#undef PG8_STAGE
#undef PG8_LDA
#undef PG8_LDB
#undef PG8_MMA
#undef PG8_WAIT_V
#undef PG8_WAIT_L
#undef PG8_BAR
#undef PG8_SCHED
}
}

constexpr int NWAVES = 8;
constexpr int S = 8192, D = 2048, NIN = 7248, NINP = 7424, DFF = 5632, DFFE = 7168, NE = 8, DEPTH = 2;
constexpr int PITCH = NINP;
constexpr int C_QA = 0, C_KA = 512, C_VA = 1024, C_QI = 1536, C_QB = 2560, C_KB = 3328, C_VB = 4096, C_QC = 4864, C_KC = 5632, C_VC = 6400, C_KI = 7168, C_WI = 7232;
constexpr int MAXSLOT = 18432;
constexpr float RMS_EPS = 1e-6f;
constexpr float LOG2E = 1.4426950408889634f;
constexpr int TBL_N = 2304, TBL_OFF = 64;
constexpr int DFAR = 2112;

constexpr size_t MiB = 1u << 20;
constexpr size_t WS_CTL = 0, CTL_ZERO_BYTES = 1 * MiB;
constexpr size_t WS_TBL = 1 * MiB, WS_ROUTE = 2 * MiB;
constexpr size_t WS_WIN = 3 * MiB, WS_WOUT = WS_WIN + 58 * MiB, WS_WGU = WS_WOUT + 16 * MiB, WS_WDN = WS_WGU + 44 * MiB, WS_WMGU = WS_WDN + 22 * MiB, WS_WMDN = WS_WMGU + 448 * MiB;
constexpr size_t WS_H = WS_WMDN + 224 * MiB, WS_P = WS_H + 32 * MiB, WS_SC = WS_P + 116 * MiB, WS_WM = WS_SC + 256 * MiB, WS_MIX = WS_WM + 8 * MiB, WS_XB = WS_MIX + 32 * MiB;
constexpr size_t WS_ACT = WS_XB + 64 * MiB, WS_HS = WS_ACT + 252 * MiB, WS_END = WS_HS + 72 * MiB;
constexpr size_t WS_OUTM = WS_SC;
static_assert((size_t)2 * NINP * D * 2 <= 58 * MiB && (size_t)2 * DFF * D * 2 <= 44 * MiB && (size_t)NE * 2 * DFFE * D * 2 <= 448 * MiB && (size_t)MAXSLOT * DFFE * 2 <= 252 * MiB && (size_t)MAXSLOT * D * 4 <= 256 * MiB, "ws map");
constexpr size_t RT_TOKE = 0, RT_TOKR = 65536, RT_TOKG = 131072, RT_TOKS = 196608, RT_SLOTG = 262144;

constexpr int CW_TMO = 0, CW_CODE = 1, CW_BAR = 4096, CW_CNT = 8192, CW_Q = 12288;

constexpr int RING_OFF = 0, RING_BYTES = 131072;
constexpr int XPOSE_SCR = 64 * 65 * 4;
constexpr int LDSCTL_OFF = 8 * XPOSE_SCR, MISC_OFF = LDSCTL_OFF + 320;
constexpr int LDS_TBL_OFF = 134144;
constexpr int LDS_BYTES = 147456;
static_assert(LDS_TBL_OFF + TBL_N * 4 <= LDS_BYTES && MISC_OFF + 128 <= LDS_TBL_OFF && LDSCTL_OFF >= RING_BYTES && LDS_TBL_OFF % 16 == 0, "LDS map");

#define GAS __attribute__((address_space(1)))
#define LAS __attribute__((address_space(3)))
#define DI __device__ __forceinline__
typedef unsigned short bf16;
typedef unsigned v4u __attribute__((ext_vector_type(4)));
typedef unsigned v2u __attribute__((ext_vector_type(2)));
typedef float f32x4 __attribute__((ext_vector_type(4)));
typedef float f32x16 __attribute__((ext_vector_type(16)));
typedef short bf16x8 __attribute__((ext_vector_type(8)));
typedef short s16x4 __attribute__((ext_vector_type(4)));
typedef GAS unsigned gu32;
#define RLX_AGENT __ATOMIC_RELAXED, __HIP_MEMORY_SCOPE_AGENT
#define LDS_WAIT() asm volatile("s_waitcnt lgkmcnt(0)" ::: "memory")
#define VM_WAIT() asm volatile("s_waitcnt vmcnt(0)" ::: "memory")
DI unsigned f2bf(float f) { unsigned u = __builtin_bit_cast(unsigned, f); return (u + 0x7fffu + ((u >> 16) & 1u)) >> 16; }
DI unsigned pk2(float lo, float hi) { unsigned r; asm volatile("v_cvt_pk_bf16_f32 %0, %1, %2" : "=v"(r) : "v"(lo), "v"(hi)); return r; }
DI float bflo(unsigned w) { return __builtin_bit_cast(float, w << 16); }
DI float bfhi(unsigned w) { return __builtin_bit_cast(float, w & 0xffff0000u); }
DI float wave_sum(float v) {
#pragma unroll
    for (int o = 1; o < 64; o <<= 1) v += __shfl_xor(v, o);
    return v;
}
#define XB_TMO      128
#define XB_XCNT(j)  (256  + 64 * (j))
#define XB_XSUB(j)  (1280 + 64 * (j))
#define XB_XGEN(j)  (2304 + 64 * (j))
#define XB_TOP      3328
#define XB_TOPGEN   3392
#define XCD_BAR_WORDS 3456
#define XB_SPIN_CAP (1u << 18)

__device__ __forceinline__ unsigned xb_ld(unsigned* p)              { return __hip_atomic_load(p, __ATOMIC_RELAXED, __HIP_MEMORY_SCOPE_AGENT); }
__device__ __forceinline__ unsigned xb_add(unsigned* p, unsigned v) { return __hip_atomic_fetch_add(p, v, __ATOMIC_RELAXED, __HIP_MEMORY_SCOPE_AGENT); }
__device__ __forceinline__ unsigned xb_xcc_id() { return (unsigned)__builtin_amdgcn_s_getreg((3 << 11) | 20) & 0xFu; }
#define XB_SPIN(cond, bar) do { unsigned _sp = 0; while (cond) { __builtin_amdgcn_s_sleep(1); \
    if ((++_sp & 255u) == 0u) { if (xb_ld(&(bar)[XB_TMO])) break; if (_sp > XB_SPIN_CAP) { atomicAdd(&(bar)[XB_TMO], 1u); break; } } } } while (0)

struct XcdBarrier {
    unsigned* bar; unsigned x;
    volatile LAS unsigned* st;
};

__device__ __forceinline__ XcdBarrier xcd_barrier_post(unsigned* bar, volatile LAS unsigned* st) {
    XcdBarrier b; b.bar = bar; b.x = xb_xcc_id(); b.st = st;
    if (threadIdx.x == 0) (void)xb_add(&bar[XB_XCNT(b.x)], 1u);
    return b;
}
__device__ __forceinline__ void xcd_barrier_complete(unsigned* bar, unsigned x, unsigned& nloc, unsigned& nx) {
    const unsigned G = gridDim.x * gridDim.y * gridDim.z;
    unsigned sum, cnt, mine, sp = 0u;
    for (;;) {
        sum = 0u; cnt = 0u; mine = 0u;
#pragma unroll
        for (unsigned j = 0; j < 16; ++j) { const unsigned c = xb_ld(&bar[XB_XCNT(j)]); sum += c; cnt += (c > 0u) ? 1u : 0u; mine = (j == x) ? c : mine; }
        if (sum == G) break;
        __builtin_amdgcn_s_sleep(1);
        if ((++sp & 255u) == 0u) { if (xb_ld(&bar[XB_TMO])) break; if (sp > XB_SPIN_CAP) { atomicAdd(&bar[XB_TMO], 1u); break; } }
    }
    nloc = mine > 0u ? mine : 1u; nx = cnt > 0u ? cnt : 1u;
}

__device__ __forceinline__ void xcd_barrier(const XcdBarrier& b) {
    asm volatile("s_waitcnt vmcnt(0)" ::: "memory");
    __syncthreads();
    if (threadIdx.x == 0) {
        unsigned* bar = b.bar;
        __builtin_amdgcn_s_waitcnt(0);
        unsigned nloc = b.st[0], nx = b.st[1];
        if (nloc == 0u) { xcd_barrier_complete(bar, b.x, nloc, nx); b.st[0] = nloc; b.st[1] = nx; }
        const unsigned old = xb_add(&bar[XB_XSUB(b.x)], 1u);
        const unsigned gen = old / nloc;
        if (old + 1u == (gen + 1u) * nloc) {
            __builtin_amdgcn_fence(__ATOMIC_RELEASE, "agent");
            asm volatile("s_waitcnt vmcnt(0)" ::: "memory");
            const unsigned og = xb_add(&bar[XB_TOP], 1u);
            const unsigned tg = og / nx;
            if (og + 1u == (tg + 1u) * nx) xb_add(&bar[XB_TOPGEN], 1u);
            else XB_SPIN(xb_ld(&bar[XB_TOPGEN]) == tg, bar);
            __builtin_amdgcn_fence(__ATOMIC_ACQUIRE, "agent");
            xb_add(&bar[XB_XGEN(b.x)], 1u);
            asm volatile("s_waitcnt vmcnt(0)" ::: "memory");
        } else {
            XB_SPIN(xb_ld(&bar[XB_XGEN(b.x)]) == gen, bar);
            __builtin_amdgcn_fence(__ATOMIC_ACQUIRE, "agent");
            asm volatile("s_waitcnt vmcnt(0)" ::: "memory");
        }
    }
    __syncthreads();
}


struct Args { const float* in[24]; float* out; unsigned char* ws; int ph_lo, ph_hi; };
struct Frame {
    LAS unsigned char* lds;
    volatile LAS unsigned* MISC;
    gu32* ctl;
    unsigned char* ws;
    const Args* a; float* out;
    int tid, lane, wave, vcu, G;
};

DI int rowmap(int map, int n) {
    if (map == 1) return n < 2560 ? n : (n < 2640 ? n + (C_KI - 2560) : n - 80);
    if (map == 2) return ((n >> 7) << 8) + (n & 127);
    if (map == 3) return ((n >> 7) << 8) + 128 + (n & 127);
    return n;
}
DI void xpose_item(const float* __restrict__ W, int K, int N, bf16* __restrict__ WT, int map, LAS float* scr, int item, int lane) {
    const int nblk = (N + 63) >> 6, kb = item / nblk, nb = item - kb * nblk, k0 = kb << 6, n0 = nb << 6;
    const int kk = lane >> 4, nq = (lane & 15) << 2;
    const bool okc = (n0 + nq) < N;
    f32x4 v[16];
#pragma unroll
    for (int i = 0; i < 16; ++i) { v[i] = (f32x4){0.f, 0.f, 0.f, 0.f}; if (okc) v[i] = *(const GAS f32x4*)(W + (size_t)(k0 + 4 * i + kk) * N + n0 + nq); }
#pragma unroll
    for (int i = 0; i < 16; ++i) { LAS float* d = scr + (4 * i + kk) * 65 + nq; d[0] = v[i].x; d[1] = v[i].y; d[2] = v[i].z; d[3] = v[i].w; }
    LDS_WAIT(); asm volatile("" ::: "memory");
    const int c = lane & 7;
#pragma unroll
    for (int j = 0; j < 8; ++j) { const int n = (lane >> 3) + 8 * j; const LAS float* s = scr + (8 * c) * 65 + n;
        v4u o; o.x = pk2(s[0 * 65], s[1 * 65]); o.y = pk2(s[2 * 65], s[3 * 65]); o.z = pk2(s[4 * 65], s[5 * 65]); o.w = pk2(s[6 * 65], s[7 * 65]);
        if (n0 + n < N) *(GAS v4u*)(WT + (size_t)rowmap(map, n0 + n) * K + k0 + 8 * c) = o; }
    LDS_WAIT(); asm volatile("" ::: "memory");
}
DI int t5_bucket(int n) {
    if (n < 16) return n;
    const int large = 16 + (int)(logf((float)n / 16.0f) / 4.852030263919617f * 16.0f);
    return large < 31 ? large : 31;
}
DI void rms_row_to_bf16(const float* xrow, const f32x4 (&g)[8], bf16* orow, int lane) {
    const GAS f32x4* xr = (const GAS f32x4*)xrow + lane;
    f32x4 v[8]; float s = 0.f;
#pragma unroll
    for (int j = 0; j < 8; ++j) { v[j] = xr[64 * j]; s += (v[j].x * v[j].x + v[j].y * v[j].y) + (v[j].z * v[j].z + v[j].w * v[j].w); }
    const float rstd = 1.0f / sqrtf(wave_sum(s) * (1.0f / D) + RMS_EPS);
    GAS v2u* o8 = (GAS v2u*)orow + lane;
#pragma unroll
    for (int j = 0; j < 8; ++j) { v2u o; o.x = pk2(v[j].x * rstd * g[j].x, v[j].y * rstd * g[j].y); o.y = pk2(v[j].z * rstd * g[j].z, v[j].w * rstd * g[j].w); o8[64 * j] = o; }
}
DI void rms_phase(Frame& F, const float* x, const float* gvec, bf16* H) {
    const int gw = F.vcu * NWAVES + F.wave, NGW = F.G * NWAVES;
    f32x4 g[8];
#pragma unroll
    for (int j = 0; j < 8; ++j) g[j] = ((const GAS f32x4*)gvec)[F.lane + 64 * j];
    for (int m = gw; m < S; m += NGW) rms_row_to_bf16(x + (size_t)m * D, g, H + (size_t)m * D, F.lane);
}
DI void p0_prologue(Frame& F) {
    LAS float* scr = (LAS float*)(F.lds + F.wave * XPOSE_SCR);
    const int gw = F.vcu * NWAVES + F.wave, NGW = F.G * NWAVES;
    constexpr int I_IN = (D / 64) * ((NIN + 63) / 64), I_OUT = (D / 64) * (D / 64), I_G = (D / 64) * (DFF / 64), I_DN = (DFF / 64) * (D / 64), I_MG = (D / 64) * (DFFE / 64), I_MD = (DFFE / 64) * (D / 64);
    constexpr int NITEMS = 2 * I_IN + 2 * I_OUT + 2 * I_G + I_DN + 16 * I_MG + 8 * I_MD;
    bf16* WIN = (bf16*)(F.ws + WS_WIN); bf16* WOUT = (bf16*)(F.ws + WS_WOUT); bf16* WGU = (bf16*)(F.ws + WS_WGU); bf16* WDN = (bf16*)(F.ws + WS_WDN);
    bf16* WMGU = (bf16*)(F.ws + WS_WMGU); bf16* WMDN = (bf16*)(F.ws + WS_WMDN);
    for (int it = gw; it < NITEMS; it += NGW) {
        int r = it;
        if (r < 2 * I_IN) { const int l = r / I_IN; xpose_item(F.a->in[1] + (size_t)l * D * NIN, D, NIN, WIN + (size_t)l * NINP * D, 1, scr, r - l * I_IN, F.lane); continue; } r -= 2 * I_IN;
        if (r < 2 * I_OUT) { const int l = r / I_OUT; xpose_item(F.a->in[2] + (size_t)l * D * D, D, D, WOUT + (size_t)l * D * D, 0, scr, r - l * I_OUT, F.lane); continue; } r -= 2 * I_OUT;
        if (r < I_G) { xpose_item(F.a->in[17], D, DFF, WGU, 2, scr, r, F.lane); continue; } r -= I_G;
        if (r < I_G) { xpose_item(F.a->in[18], D, DFF, WGU, 3, scr, r, F.lane); continue; } r -= I_G;
        if (r < I_DN) { xpose_item(F.a->in[19], DFF, D, WDN, 0, scr, r, F.lane); continue; } r -= I_DN;
        if (r < 8 * I_MG) { const int e = r / I_MG; xpose_item(F.a->in[21] + (size_t)e * D * DFFE, D, DFFE, WMGU + (size_t)e * 2 * DFFE * D, 2, scr, r - e * I_MG, F.lane); continue; } r -= 8 * I_MG;
        if (r < 8 * I_MG) { const int e = r / I_MG; xpose_item(F.a->in[22] + (size_t)e * D * DFFE, D, DFFE, WMGU + (size_t)e * 2 * DFFE * D, 3, scr, r - e * I_MG, F.lane); continue; } r -= 8 * I_MG;
        { const int e = r / I_MD; xpose_item(F.a->in[23] + (size_t)e * DFFE * D, DFFE, D, WMDN + (size_t)e * D * DFFE, 0, scr, r - e * I_MD, F.lane); }
    }
    { const int gt = (F.vcu * NWAVES + F.wave) * 64 + F.lane, NGT = F.G * NWAVES * 64; constexpr int PADV = (NINP - NIN) * D / 8;
      for (int i = gt; i < 2 * PADV; i += NGT) { const int l = i / PADV, j = i - l * PADV; *((GAS v4u*)(WIN + (size_t)l * NINP * D + (size_t)NIN * D) + j) = (v4u){0u, 0u, 0u, 0u}; }
      float* TBL = (float*)(F.ws + WS_TBL); const float* rel_bias = F.a->in[16];
      for (int i = gt; i < 16 * TBL_N; i += NGT) { const int hd = i / TBL_N, d = (i - hd * TBL_N) - TBL_OFF; float v = 0.f;
          if (d >= 0) { const float e = __expf(rel_bias[t5_bucket(d) * 16 + hd]);
              if (hd >= 4 && hd < 10) { const int mult = (d <= 128 ? 1 : 0) + (((d & 3) == 0 && d <= 512) ? 1 : 0) + (((d & 15) == 0 && d <= 2048) ? 1 : 0); v = e * (float)mult; }
              else v = e; }
          TBL[i] = v; } }
    rms_phase(F, F.a->in[0], F.a->in[3], (bf16*)(F.ws + WS_H));
}

DI void pn_phase(Frame& F, int layer) {
    const int gw = F.vcu * NWAVES + F.wave, NGW = F.G * NWAVES, lane = F.lane;
    bf16* P = (bf16*)(F.ws + WS_P);
    float gs[8][8];
#pragma unroll
    for (int j = 0; j < 8; ++j) {
        const int cc = lane + 64 * j; int col, gi; const float* gv; float sc = 1.0f;
        if (j < 2) { col = 8 * cc; gi = col & 127; if (col < C_KA) { gv = F.a->in[5] + layer * 128; sc = 0.08838834764831845f * LOG2E; } else gv = F.a->in[6] + layer * 128; }
        else if (j < 5) { col = C_QB + 8 * (cc - 128); gi = (col - C_QB) & 127; if (col < C_KB) { gv = F.a->in[7] + layer * 128; sc = 0.08838834764831845f * LOG2E; } else gv = F.a->in[8] + layer * 128; }
        else { col = C_QC + 8 * (cc - 320); gi = (col - C_QC) & 63; if (col < C_KC) { gv = F.a->in[9] + layer * 64; sc = 0.125f * LOG2E; } else gv = F.a->in[10] + layer * 64; }
#pragma unroll
        for (int e = 0; e < 8; ++e) gs[j][e] = gv[gi + e] * sc;
    }
    for (int m = gw; m < S; m += NGW) {
        bf16* row = P + (size_t)m * PITCH;
        v4u raw[8];
#pragma unroll
        for (int j = 0; j < 8; ++j) { const int cc = lane + 64 * j; const int col = j < 2 ? 8 * cc : (j < 5 ? C_QB + 8 * (cc - 128) : C_QC + 8 * (cc - 320)); raw[j] = *(const GAS v4u*)(row + col); }
#pragma unroll
        for (int j = 0; j < 8; ++j) { const int cc = lane + 64 * j; const int col = j < 2 ? 8 * cc : (j < 5 ? C_QB + 8 * (cc - 128) : C_QC + 8 * (cc - 320));
            float x[8]; x[0] = bflo(raw[j].x); x[1] = bfhi(raw[j].x); x[2] = bflo(raw[j].y); x[3] = bfhi(raw[j].y); x[4] = bflo(raw[j].z); x[5] = bfhi(raw[j].z); x[6] = bflo(raw[j].w); x[7] = bfhi(raw[j].w);
            float ss = 0.f;
#pragma unroll
            for (int e = 0; e < 8; ++e) ss += x[e] * x[e];
            ss += __shfl_xor(ss, 1); ss += __shfl_xor(ss, 2); ss += __shfl_xor(ss, 4);
            float rstd;
            if (j < 5) { ss += __shfl_xor(ss, 8); rstd = 1.0f / sqrtf(ss * (1.0f / 128.0f) + RMS_EPS); } else rstd = 1.0f / sqrtf(ss * (1.0f / 64.0f) + RMS_EPS);
            v4u o; o.x = pk2(x[0] * rstd * gs[j][0], x[1] * rstd * gs[j][1]); o.y = pk2(x[2] * rstd * gs[j][2], x[3] * rstd * gs[j][3]);
            o.z = pk2(x[4] * rstd * gs[j][4], x[5] * rstd * gs[j][5]); o.w = pk2(x[6] * rstd * gs[j][6], x[7] * rstd * gs[j][7]);
            *(GAS v4u*)(row + col) = o; }
    }
}

DI void rms_router_phase(Frame& F, const float* x, const float* gvec, const float* wr  , bf16* H) {
    const int gw = F.vcu * NWAVES + F.wave, NGW = F.G * NWAVES, lane = F.lane;
    LAS float* wrT = (LAS float*)(F.lds + RING_OFF);
    for (int i = F.tid; i < D * 8; i += NWAVES * 64) wrT[(i & 7) * D + (i >> 3)] = wr[i];
    __syncthreads();
    f32x4 g[8];
#pragma unroll
    for (int j = 0; j < 8; ++j) g[j] = ((const GAS f32x4*)gvec)[lane + 64 * j];
    int* tok_e = (int*)(F.ws + WS_ROUTE + RT_TOKE); int* tok_r = (int*)(F.ws + WS_ROUTE + RT_TOKR); float* tok_g = (float*)(F.ws + WS_ROUTE + RT_TOKG);
    for (int m = gw; m < S; m += NGW) {
        const GAS f32x4* xr = (const GAS f32x4*)(x + (size_t)m * D) + lane;
        f32x4 v[8]; float s = 0.f;
#pragma unroll
        for (int j = 0; j < 8; ++j) { v[j] = xr[64 * j]; s += (v[j].x * v[j].x + v[j].y * v[j].y) + (v[j].z * v[j].z + v[j].w * v[j].w); }
        const float rstd = 1.0f / sqrtf(wave_sum(s) * (1.0f / D) + RMS_EPS);
        GAS v2u* o8 = (GAS v2u*)(H + (size_t)m * D) + lane;
        float lg[8];
#pragma unroll
        for (int e = 0; e < 8; ++e) lg[e] = 0.f;
#pragma unroll
        for (int j = 0; j < 8; ++j) { v[j].x *= rstd * g[j].x; v[j].y *= rstd * g[j].y; v[j].z *= rstd * g[j].z; v[j].w *= rstd * g[j].w;
            v2u o; o.x = pk2(v[j].x, v[j].y); o.y = pk2(v[j].z, v[j].w); o8[64 * j] = o;
#pragma unroll
            for (int e = 0; e < 8; ++e) { const f32x4 w = *(const LAS f32x4*)(wrT + e * D + 4 * (lane + 64 * j)); lg[e] += (v[j].x * w.x + v[j].y * w.y) + (v[j].z * w.z + v[j].w * w.w); } }
#pragma unroll
        for (int e = 0; e < 8; ++e) lg[e] = wave_sum(lg[e]);
        int e1 = 0; float v1 = lg[0];
#pragma unroll
        for (int e = 1; e < 8; ++e) if (lg[e] > v1) { v1 = lg[e]; e1 = e; }
        int e2 = -1; float v2 = 0.f;
#pragma unroll
        for (int e = 0; e < 8; ++e) if (e != e1 && (e2 < 0 || lg[e] > v2)) { v2 = lg[e]; e2 = e; }
        if (lane == 0) {
            const float ex = __expf(v2 - v1), g1 = 1.0f / (1.0f + ex), g2 = ex * g1;
            const unsigned r1 = __hip_atomic_fetch_add((unsigned*)(F.ctl + CW_CNT + 64 * e1), 1u, RLX_AGENT);
            const unsigned r2 = __hip_atomic_fetch_add((unsigned*)(F.ctl + CW_CNT + 64 * e2), 1u, RLX_AGENT);
            tok_e[2 * m] = e1; tok_e[2 * m + 1] = e2; tok_r[2 * m] = (int)r1; tok_r[2 * m + 1] = (int)r2; tok_g[2 * m] = g1; tok_g[2 * m + 1] = g2;
        }
    }
    __syncthreads();
}
DI void moe_offsets(Frame& F, int (&off)[9]) {
    int acc = 0;
#pragma unroll
    for (int e = 0; e < 8; ++e) { off[e] = acc; const int c = (int)__hip_atomic_load((unsigned*)(F.ctl + CW_CNT + 64 * e), RLX_AGENT); acc += (c + 255) & ~255; }
    off[8] = acc;
}
DI void gather_phase(Frame& F) {
    const int gw = F.vcu * NWAVES + F.wave, NGW = F.G * NWAVES, lane = F.lane;
    int off[9]; moe_offsets(F, off);
    const int* tok_e = (const int*)(F.ws + WS_ROUTE + RT_TOKE); const int* tok_r = (const int*)(F.ws + WS_ROUTE + RT_TOKR); const float* tok_g = (const float*)(F.ws + WS_ROUTE + RT_TOKG);
    int* tok_s = (int*)(F.ws + WS_ROUTE + RT_TOKS); float* slot_g = (float*)(F.ws + WS_ROUTE + RT_SLOTG);
    const bf16* H = (const bf16*)(F.ws + WS_H); bf16* HS = (bf16*)(F.ws + WS_HS);
    for (int m = gw; m < S; m += NGW) {
        const int e1 = tok_e[2 * m], e2 = tok_e[2 * m + 1];
        int o1 = 0, o2 = 0;
#pragma unroll
        for (int e = 0; e < 8; ++e) { o1 = (e == e1) ? off[e] : o1; o2 = (e == e2) ? off[e] : o2; }
        const int s1 = o1 + tok_r[2 * m], s2 = o2 + tok_r[2 * m + 1];
        const GAS v4u* src = (const GAS v4u*)(H + (size_t)m * D) + lane; GAS v4u* d1 = (GAS v4u*)(HS + (size_t)s1 * D) + lane; GAS v4u* d2 = (GAS v4u*)(HS + (size_t)s2 * D) + lane;
#pragma unroll
        for (int j = 0; j < 4; ++j) { const v4u v = src[64 * j]; d1[64 * j] = v; d2[64 * j] = v; }
        if (lane == 0) { tok_s[2 * m] = s1; tok_s[2 * m + 1] = s2; slot_g[s1] = tok_g[2 * m]; slot_g[s2] = tok_g[2 * m + 1]; }
    }
    for (int p = gw; p < off[8]; p += NGW) {
        int e = 0;
#pragma unroll
        for (int k = 1; k < 8; ++k) e += (p >= off[k]) ? 1 : 0;
        int oe = 0;
#pragma unroll
        for (int k = 0; k < 8; ++k) oe = (k == e) ? off[k] : oe;
        const int c = (int)__hip_atomic_load((unsigned*)(F.ctl + CW_CNT + 64 * e), RLX_AGENT);
        if (p >= oe + c) { GAS v4u* d = (GAS v4u*)(HS + (size_t)p * D) + lane;
#pragma unroll
            for (int j = 0; j < 4; ++j) d[64 * j] = (v4u){0u, 0u, 0u, 0u};
            if (lane == 0) slot_g[p] = 0.f; }
    }
}
DI void combine_phase(Frame& F) {
    const int gw = F.vcu * NWAVES + F.wave, NGW = F.G * NWAVES, lane = F.lane;
    const int* tok_s = (const int*)(F.ws + WS_ROUTE + RT_TOKS); const float* XB = (const float*)(F.ws + WS_XB); const float* OUTM = (const float*)(F.ws + WS_OUTM);
    for (int m = gw; m < S; m += NGW) {
        const int s1 = tok_s[2 * m], s2 = tok_s[2 * m + 1];
        const GAS f32x4* a = (const GAS f32x4*)(XB + (size_t)m * D) + lane; const GAS f32x4* b = (const GAS f32x4*)(OUTM + (size_t)s1 * D) + lane; const GAS f32x4* c = (const GAS f32x4*)(OUTM + (size_t)s2 * D) + lane;
        GAS f32x4* o = (GAS f32x4*)(F.out + (size_t)m * D) + lane;
#pragma unroll
        for (int j = 0; j < 8; ++j) o[64 * j] = (a[64 * j] + b[64 * j]) + c[64 * j];
    }
}

DI void i1_phase(Frame& F) {
    const int lane = F.lane, r = lane & 31, hf = lane >> 5;
    const bf16* P = (const bf16*)(F.ws + WS_P); float* SC = (float*)(F.ws + WS_SC);
    const int rank = F.wave < 4 ? F.wave : 11 - F.wave;
    const int aq = (r >> 2) & 1, ah = ((r >> 3) << 2) | (r & 3);
    for (int u = rank * F.G + F.vcu; u < S / 4; u += F.G * NWAVES) {
        const int t0 = 4 * u;
        bf16x8 af[2][4]; float wv[2][16];
#pragma unroll
        for (int mb = 0; mb < 2; ++mb) {
#pragma unroll
            for (int s = 0; s < 4; ++s) af[mb][s] = *(const GAS bf16x8*)(P + (size_t)(t0 + 2 * mb + aq) * PITCH + C_QI + ah * 64 + 16 * s + 8 * hf);
            const GAS v4u* wp = (const GAS v4u*)(P + (size_t)(t0 + 2 * mb + hf) * PITCH + C_WI); const v4u w0 = wp[0], w1 = wp[1];
            wv[mb][0] = bflo(w0.x); wv[mb][1] = bfhi(w0.x); wv[mb][2] = bflo(w0.y); wv[mb][3] = bfhi(w0.y); wv[mb][4] = bflo(w0.z); wv[mb][5] = bfhi(w0.z); wv[mb][6] = bflo(w0.w); wv[mb][7] = bfhi(w0.w);
            wv[mb][8] = bflo(w1.x); wv[mb][9] = bfhi(w1.x); wv[mb][10] = bflo(w1.y); wv[mb][11] = bfhi(w1.y); wv[mb][12] = bflo(w1.z); wv[mb][13] = bfhi(w1.z); wv[mb][14] = bflo(w1.w); wv[mb][15] = bfhi(w1.w);
#pragma unroll
            for (int i = 0; i < 16; ++i) wv[mb][i] *= 0.03125f;
        }
        const int nkb = (t0 + 3) / 32 + 1;
        bf16x8 bc[4], bn[4];
#pragma unroll
        for (int s = 0; s < 4; ++s) bc[s] = *(const GAS bf16x8*)(P + (size_t)r * PITCH + C_KI + 16 * s + 8 * hf);
        for (int kb = 0; kb < nkb; ++kb) {
            const int kn = (kb + 1 < nkb) ? kb + 1 : kb;
#pragma unroll
            for (int s = 0; s < 4; ++s) bn[s] = *(const GAS bf16x8*)(P + (size_t)(32 * kn + r) * PITCH + C_KI + 16 * s + 8 * hf);
#pragma unroll
            for (int mb = 0; mb < 2; ++mb) {
                f32x16 acc;
#pragma unroll
                for (int i = 0; i < 16; ++i) acc[i] = 0.f;
#pragma unroll
                for (int s = 0; s < 4; ++s) acc = __builtin_amdgcn_mfma_f32_32x32x16_bf16(af[mb][s], bc[s], acc, 0, 0, 0);
                float sc = 0.f;
#pragma unroll
                for (int i = 0; i < 16; ++i) sc += wv[mb][i] * fmaxf(acc[i], 0.f);
                SC[(size_t)(t0 + 2 * mb + hf) * S + 32 * kb + r] = sc;
            }
#pragma unroll
            for (int s = 0; s < 4; ++s) bc[s] = bn[s];
        }
    }
}

DI int wave_sum_i(int v) {
#pragma unroll
    for (int o = 1; o < 64; o <<= 1) v += __shfl_xor(v, o);
    return v;
}
#define WRITELANE(x, v, L) asm volatile("s_nop 4\n\tv_writelane_b32 %0, %1, %2" : "+v"(x) : "s"(v), "n"(L))
template <int NREG>
DI void i2_select(const float* srow, unsigned* wrow, int t, int lane) {
    unsigned key[NREG];
    const GAS float* sp = (const GAS float*)srow + lane;
    const int ti = t >> 6; const bool lastok = lane <= (t & 63);
#pragma unroll
    for (int i = 0; i < NREG; ++i) { const unsigned u = __builtin_bit_cast(unsigned, sp[64 * i]); const unsigned k = (u & 0x80000000u) ? ~u : (u | 0x80000000u); key[i] = (i < ti || (i == ti && lastok)) ? k : 0u; }
    unsigned T = 0u;
    for (int bit = 31; bit >= 0; --bit) {
        const unsigned cand = T | (1u << bit);
        int c = 0;
#pragma unroll
        for (int i = 0; i < NREG; ++i) c += (key[i] >= cand) ? 1 : 0;
        if (wave_sum_i(c) >= 256) T = cand;
    }
    int cg = 0;
#pragma unroll
    for (int i = 0; i < NREG; ++i) cg += (key[i] > T) ? 1 : 0;
    const int need = 256 - wave_sum_i(cg);
    int running = 0; unsigned lo0 = 0u, hi0 = 0u, lo1 = 0u, hi1 = 0u;
#pragma unroll
    for (int i = 0; i < NREG; ++i) {
        const bool nz = key[i] != 0u;
        const bool eq = nz && (key[i] == T);
        const unsigned long long eqm = __ballot(eq);
        const int myrank = running + (int)__builtin_amdgcn_mbcnt_hi((unsigned)(eqm >> 32), __builtin_amdgcn_mbcnt_lo((unsigned)eqm, 0u));
        const bool sel = nz && ((key[i] > T) || (eq && myrank < need));
        const unsigned long long sm = __ballot(sel);
        running += __popcll(eqm);
        if (i < 64) { WRITELANE(lo0, (unsigned)sm, i & 63); WRITELANE(hi0, (unsigned)(sm >> 32), i & 63); }
        else { WRITELANE(lo1, (unsigned)sm, i & 63); WRITELANE(hi1, (unsigned)(sm >> 32), i & 63); }
    }
    if (NREG <= 64) { if (lane < NREG) *(GAS v2u*)(wrow + 2 * lane) = (v2u){lo0, hi0}; }
    else { *(GAS v2u*)(wrow + 2 * lane) = (v2u){lo0, hi0}; if (lane < NREG - 64) *(GAS v2u*)(wrow + 128 + 2 * lane) = (v2u){lo1, hi1}; }
}
DI void i2_phase(Frame& F) {
    const int gw = F.vcu * NWAVES + F.wave, NGW = F.G * NWAVES;
    const float* SC = (const float*)(F.ws + WS_SC); unsigned* WM = (unsigned*)(F.ws + WS_WM);
    for (int t = gw; t < 2048; t += NGW) i2_select<32>(SC + (size_t)t * S, WM + (size_t)t * 256, t, F.lane);
    for (int t = 2048 + gw; t < 4096; t += NGW) i2_select<64>(SC + (size_t)t * S, WM + (size_t)t * 256, t, F.lane);
    for (int t = 4096 + gw; t < 6144; t += NGW) i2_select<96>(SC + (size_t)t * S, WM + (size_t)t * 256, t, F.lane);
    for (int t = 6144 + gw; t < 8192; t += NGW) i2_select<128>(SC + (size_t)t * S, WM + (size_t)t * 256, t, F.lane);
}

typedef __bf16 bf16x2_t __attribute__((ext_vector_type(2)));
typedef float f32x2_t __attribute__((ext_vector_type(2)));
typedef short v4i16_t __attribute__((ext_vector_type(4)));
DI unsigned cvtpk_s(float lo, float hi) { f32x2_t v = {lo, hi}; bf16x2_t b = __builtin_convertvector(v, bf16x2_t); return __builtin_bit_cast(unsigned, b); }
DI s16x4 vtr(const LAS unsigned char* p) { return __builtin_bit_cast(s16x4, __builtin_amdgcn_ds_read_tr16_b64_v4i16((LAS v4i16_t*)p)); }
DI unsigned off_a(unsigned row, unsigned ch) { return 2048u * (row >> 3) + 512u * (ch >> 2) + 64u * (row & 7) + 16u * ((ch & 3) ^ ((row >> 2) & 3)); }

#ifndef DBG_NOMASK
#define DBG_NOMASK 0
#endif
DI float and_mask_f(float v, int m) { return __builtin_bit_cast(float, __builtin_bit_cast(int, v) & m); }
constexpr int AT_SLOT = 32768, AT_BUF = 65536;

struct AttnShared { float m2[3]; float lam; float post; };

template <int KIND>
DI void attn_unit(Frame& F, int layer, int head, int qb, const AttnShared& sh) {
    const int tid = F.tid, lane = F.lane, w = F.wave, g = w >> 2, wq = w & 3, r = lane & 31, hf = lane >> 5;
    const bf16* P = (const bf16*)(F.ws + WS_P);
    const int colQ = (KIND == 0 ? C_QA : (KIND == 1 ? C_QB : C_QC)) + 128 * head;
    const int colK = (KIND == 0 ? C_KA : (KIND == 1 ? C_KB : C_KC)) + 128 * head;
    const int colV = (KIND == 0 ? C_VA : (KIND == 1 ? C_VB : C_VC)) + 128 * head;
    const int outc = (KIND == 0 ? 0 : (KIND == 1 ? 512 : 1280)) + 128 * head;
    const int tblh = (KIND == 0 ? 0 : (KIND == 1 ? 4 : 10)) + head;
    const int q0 = 128 * qb, kbeg = (KIND == 1) ? (q0 > 2048 ? q0 - 2048 : 0) : 0, nss = (q0 + 128 - kbeg) >> 7;
    const int qrow0 = q0 + 32 * wq, myq = qrow0 + r;
    constexpr int NQS = (KIND == 2) ? 4 : 8;
    LAS unsigned char* ring = F.lds + RING_OFF;
    LAS float* tblL = (LAS float*)(F.lds + LDS_TBL_OFF);
    { const float* TB = (const float*)(F.ws + WS_TBL) + tblh * TBL_N; for (int i = tid; i < TBL_N; i += NWAVES * 64) tblL[i] = TB[i]; }
    const float c31 = ((const float*)(F.ws + WS_TBL))[tblh * TBL_N + TBL_N - 1];
    bf16x8 qf[NQS];
#pragma unroll
    for (int s = 0; s < NQS; ++s) qf[s] = *(const GAS bf16x8*)(P + (size_t)myq * PITCH + colQ + (KIND == 2 ? 64 * g : 0) + 16 * s + 8 * hf);
    v4u st[8];
    const int ld_ch = tid & 15, ld_row = (tid >> 4) & 31;
#define AT_ISSUE(ss) do { _Pragma("unroll") for (int i_ = 0; i_ < 8; ++i_) { const int key_ = kbeg + 128 * (ss) + 64 * (i_ >> 2) + ld_row + 32 * (i_ & 1); \
        st[i_] = *(const GAS v4u*)(P + (size_t)key_ * PITCH + (((i_ >> 1) & 1) ? colV : colK) + 8 * ld_ch); } } while (0)
#define AT_WRITE(b) do { _Pragma("unroll") for (int i_ = 0; i_ < 8; ++i_) \
        *(LAS v4u*)(ring + (b) * AT_BUF + (i_ >> 2) * AT_SLOT + ((i_ >> 1) & 1) * 16384 + (i_ & 1) * 8192 + off_a(ld_row, ld_ch)) = st[i_]; } while (0)
    AT_ISSUE(0);
    const unsigned* WM = (const unsigned*)(F.ws + WS_WM);
    v2u mw = (v2u){0u, 0u}, mwn = (v2u){0u, 0u};
    if (KIND == 0) mw = *(const GAS v2u*)(WM + (size_t)myq * 256 + (2 * g));
    AT_WRITE(0);
    __syncthreads();
    const unsigned kbase_e = 2048u * (r >> 3) + 64u * (r & 7) + 16u * ((unsigned)hf ^ ((r >> 2) & 3)) + (KIND == 2 ? 1024u * g : 0u);
    const unsigned kbase_o = 2048u * (r >> 3) + 64u * (r & 7) + 16u * ((2u + hf) ^ ((r >> 2) & 3)) + (KIND == 2 ? 1024u * g : 0u);
    const unsigned i16 = lane & 15, tq = i16 >> 2, tp = i16 & 3, blk = (lane >> 4) & 1;
    const unsigned vbase0 = 64u * (4 * hf + tq) + 16u * ((2 * blk + (tp >> 1)) ^ (unsigned)hf) + 8u * (tp & 1);
    const unsigned vbase1 = 64u * (4 * hf + tq) + 16u * ((2 * blk + (tp >> 1)) ^ (2u + hf)) + 8u * (tp & 1);
    f32x16 O[4];
#pragma unroll
    for (int b = 0; b < 4; ++b)
#pragma unroll
        for (int i = 0; i < 16; ++i) O[b][i] = 0.f;
    float lsum = 0.f;
    const float sinit = -sh.m2[KIND];

#define AT_BLOCK(Kimg, Vimg, k0_, mword) do { \
        const int k0 = (k0_); \
        if (k0 <= qrow0 + 31 && !(KIND == 1 && qrow0 - (k0 + 31) > 2048)) { \
            f32x16 Sx; _Pragma("unroll") for (int i = 0; i < 16; ++i) Sx[i] = sinit; \
            _Pragma("unroll") for (int s = 0; s < NQS; ++s) { const bf16x8 kf = *(const LAS bf16x8*)((Kimg) + ((s & 1) ? kbase_o : kbase_e) + 512 * (s >> 1)); \
                Sx = __builtin_amdgcn_mfma_f32_32x32x16_bf16(kf, qf[s], Sx, 0, 0, 0); } \
            if (KIND != 1 && qrow0 - (k0 + 31) >= DFAR) { \
                _Pragma("unroll") for (int i = 0; i < 16; ++i) Sx[i] = __builtin_amdgcn_exp2f(Sx[i]) * c31; \
            } else { \
                const LAS float* tp_ = tblL + (myq - k0 - 4 * hf + TBL_OFF - 27); \
                _Pragma("unroll") for (int i = 0; i < 16; ++i) Sx[i] = __builtin_amdgcn_exp2f(Sx[i]) * tp_[27 - ((i & 3) + 8 * (i >> 2))]; \
            } \
            if (KIND == 0 && !DBG_NOMASK) { const int mm = (int)((mword) >> (4 * hf)); \
                _Pragma("unroll") for (int i = 0; i < 16; ++i) { const float pv_ = Sx[i]; Sx[i] = and_mask_f(pv_, __builtin_amdgcn_sbfe(mm, (i & 3) + 8 * (i >> 2), 1)); } } \
            _Pragma("unroll") for (int i = 0; i < 16; ++i) lsum += Sx[i]; \
            bf16x8 pb[2]; \
            _Pragma("unroll") for (int s2 = 0; s2 < 2; ++s2) { v4u pw; pw.x = cvtpk_s(Sx[8 * s2], Sx[8 * s2 + 1]); pw.y = cvtpk_s(Sx[8 * s2 + 2], Sx[8 * s2 + 3]); \
                pw.z = cvtpk_s(Sx[8 * s2 + 4], Sx[8 * s2 + 5]); pw.w = cvtpk_s(Sx[8 * s2 + 6], Sx[8 * s2 + 7]); pb[s2] = __builtin_bit_cast(bf16x8, pw); } \
            _Pragma("unroll") for (int b = 0; b < 4; ++b) \
                _Pragma("unroll") for (int s2 = 0; s2 < 2; ++s2) { \
                    const s16x4 lo = vtr((Vimg) + vbase0 + 2048 * (2 * s2) + 512 * b), hi = vtr((Vimg) + vbase1 + 2048 * (2 * s2 + 1) + 512 * b); \
                    const bf16x8 vf = __builtin_shufflevector(lo, hi, 0, 1, 2, 3, 4, 5, 6, 7); \
                    O[b] = __builtin_amdgcn_mfma_f32_32x32x16_bf16(vf, pb[s2], O[b], 0, 0, 0); } \
        } } while (0)

    for (int ss = 0; ss < nss; ++ss) {
        const int b = ss & 1; const bool more = (ss + 1 < nss);
        if (more) { AT_ISSUE(ss + 1); if (KIND == 0) mwn = *(const GAS v2u*)(WM + (size_t)myq * 256 + (4 * (ss + 1) + 2 * g)); }
        LAS unsigned char* base = ring + b * AT_BUF;
        const int kss = kbeg + 128 * ss;
        if (KIND != 2) {
            AT_BLOCK(base + g * AT_SLOT, base + g * AT_SLOT + 16384, kss + 64 * g, mw.x);
            AT_BLOCK(base + g * AT_SLOT + 8192, base + g * AT_SLOT + 16384 + 8192, kss + 64 * g + 32, mw.y);
        } else {
            AT_BLOCK(base, base + 16384, kss, 0u);
            AT_BLOCK(base + 8192, base + 16384 + 8192, kss + 32, 0u);
            AT_BLOCK(base + AT_SLOT, base + AT_SLOT + 16384, kss + 64, 0u);
            AT_BLOCK(base + AT_SLOT + 8192, base + AT_SLOT + 16384 + 8192, kss + 96, 0u);
        }
        if (more) { AT_WRITE(b ^ 1); mw = mwn; }
        __syncthreads();
    }
#undef AT_BLOCK
#undef AT_ISSUE
#undef AT_WRITE
    LAS float* stg = (LAS float*)ring;
    float ltot = lsum + __shfl_xor(lsum, 32);
    if (g == 1) {
        const float sc = (KIND == 2) ? 1.0f / ltot : 1.0f;
#pragma unroll
        for (int b = 0; b < 4; ++b)
#pragma unroll
            for (int i = 0; i < 16; ++i) stg[((wq * 64) + (b * 16 + i)) * 64 + lane] = O[b][i] * sc;
        stg[16384 + wq * 64 + lane] = ltot;
    }
    __syncthreads();
    if (g == 0) {
        bf16* MIX = (bf16*)(F.ws + WS_MIX);
        if (KIND != 2) {
            ltot += stg[16384 + wq * 64 + lane];
            const float inv = 1.0f / ltot;
#pragma unroll
            for (int b = 0; b < 4; ++b)
#pragma unroll
                for (int i = 0; i < 16; ++i) O[b][i] = (O[b][i] + stg[((wq * 64) + (b * 16 + i)) * 64 + lane]) * inv;
        } else {
            const float inv = 1.0f / ltot; float ss2 = 0.f;
#pragma unroll
            for (int b = 0; b < 4; ++b)
#pragma unroll
                for (int i = 0; i < 16; ++i) { const float o = O[b][i] * inv - sh.lam * stg[((wq * 64) + (b * 16 + i)) * 64 + lane]; O[b][i] = o; ss2 += o * o; }
            ss2 += __shfl_xor(ss2, 32);
            const float rstd = sh.post / sqrtf(ss2 * (1.0f / 128.0f) + RMS_EPS);
            const float* gsub = F.a->in[15] + layer * 128;
#pragma unroll
            for (int b = 0; b < 4; ++b)
#pragma unroll
                for (int i4 = 0; i4 < 4; ++i4) { const f32x4 gv = *(const GAS f32x4*)(gsub + 32 * b + 8 * i4 + 4 * hf);
                    O[b][4 * i4] *= rstd * gv.x; O[b][4 * i4 + 1] *= rstd * gv.y; O[b][4 * i4 + 2] *= rstd * gv.z; O[b][4 * i4 + 3] *= rstd * gv.w; }
        }
#ifdef DBG_ZERO_KIND
        if (KIND == DBG_ZERO_KIND) {
#pragma unroll
            for (int b = 0; b < 4; ++b)
#pragma unroll
                for (int i = 0; i < 16; ++i) O[b][i] = 0.f; }
#endif
        bf16* orow = MIX + (size_t)myq * D + outc + 4 * hf;
#pragma unroll
        for (int b = 0; b < 4; ++b)
#pragma unroll
            for (int i4 = 0; i4 < 4; ++i4) { v2u o; o.x = cvtpk_s(O[b][4 * i4], O[b][4 * i4 + 1]); o.y = cvtpk_s(O[b][4 * i4 + 2], O[b][4 * i4 + 3]); *(GAS v2u*)(orow + 32 * b + 8 * i4) = o; }
    }
    __syncthreads();
}

DI void attn_setup(Frame& F, int layer, AttnShared& sh) {
    if (F.wave == 0) {
        const int lane = F.lane;
        float ga = fmaxf(fabsf(F.a->in[5][layer * 128 + lane]), fabsf(F.a->in[5][layer * 128 + 64 + lane])), gb = fmaxf(fabsf(F.a->in[6][layer * 128 + lane]), fabsf(F.a->in[6][layer * 128 + 64 + lane]));
        float gc = fmaxf(fabsf(F.a->in[7][layer * 128 + lane]), fabsf(F.a->in[7][layer * 128 + 64 + lane])), gd = fmaxf(fabsf(F.a->in[8][layer * 128 + lane]), fabsf(F.a->in[8][layer * 128 + 64 + lane]));
        float ge = fabsf(F.a->in[9][layer * 64 + lane]), gf = fabsf(F.a->in[10][layer * 64 + lane]);
        float l1 = F.a->in[11][layer * 64 + lane] * F.a->in[12][layer * 64 + lane], l2 = F.a->in[13][layer * 64 + lane] * F.a->in[14][layer * 64 + lane];
#pragma unroll
        for (int o = 1; o < 64; o <<= 1) { ga = fmaxf(ga, __shfl_xor(ga, o)); gb = fmaxf(gb, __shfl_xor(gb, o)); gc = fmaxf(gc, __shfl_xor(gc, o)); gd = fmaxf(gd, __shfl_xor(gd, o));
            ge = fmaxf(ge, __shfl_xor(ge, o)); gf = fmaxf(gf, __shfl_xor(gf, o)); l1 += __shfl_xor(l1, o); l2 += __shfl_xor(l2, o); }
        if (lane == 0) {
            const float lam_init = 0.8f - 0.6f * expf(-0.3f * (float)layer);
            volatile LAS float* mf = (volatile LAS float*)(F.MISC + 16);
            mf[0] = 1.02f * 11.313708499f * LOG2E * ga * gb + 0.5f;
            mf[1] = 1.02f * 11.313708499f * LOG2E * gc * gd + 0.5f;
            mf[2] = 1.02f * 8.0f * LOG2E * ge * gf + 0.5f;
            mf[3] = expf(l1) - expf(l2) + lam_init;
            mf[4] = 1.0f - lam_init;
        }
    }
    __syncthreads();
    { volatile LAS float* mf = (volatile LAS float*)(F.MISC + 16); sh.m2[0] = mf[0]; sh.m2[1] = mf[1]; sh.m2[2] = mf[2]; sh.lam = mf[3]; sh.post = mf[4]; }
}
template <int KIND, int NHEAD>
DI void attn_queue(Frame& F, int layer, const AttnShared& sh) {
    for (;;) {
        if (F.tid == 0) F.MISC[0] = __hip_atomic_fetch_add((unsigned*)(F.ctl + CW_Q + 64 * (layer * 4 + KIND)), 1u, RLX_AGENT);
        __syncthreads();
        const int u = (int)F.MISC[0];
        __syncthreads();
        if (u >= 64 * NHEAD) break;
        const int qb = 63 - u / NHEAD, hd = u % NHEAD;
        attn_unit<KIND>(F, layer, hd, qb, sh);
    }
}
DI void attn_phase(Frame& F, int layer) {
    AttnShared sh; attn_setup(F, layer, sh);
    attn_queue<2, 6>(F, layer, sh);
    attn_queue<0, 4>(F, layer, sh);
    attn_queue<1, 6>(F, layer, sh);
}
#ifdef DBG_CHECKS
constexpr size_t WS_DBG = WS_CTL + 512 * 1024;
__global__ void dbg_check_indexer(unsigned char* ws) {
    const int t = blockIdx.x * 4 + (threadIdx.x >> 6), lane = threadIdx.x & 63;
    const float* SC = (const float*)(ws + WS_SC); const unsigned* WM = (const unsigned*)(ws + WS_WM); const bf16* P = (const bf16*)(ws + WS_P);
    unsigned* flags = (unsigned*)(ws + WS_DBG);
    int pc = 0; float mins = 3.0e38f, maxu = -3.0e38f; int above = 0;
    for (int s = lane; s < S; s += 64) {
        const unsigned w = WM[(size_t)t * 256 + (s >> 5)]; const int bit = (w >> (s & 31)) & 1;
        if (s <= t) { const float v = SC[(size_t)t * S + s]; if (bit) { pc++; mins = fminf(mins, v); } else maxu = fmaxf(maxu, v); }
        else if (bit && s < ((t >> 11) + 1) * 2048) above++;
    }
    for (int o = 1; o < 64; o <<= 1) { pc += __shfl_xor(pc, o); above += __shfl_xor(above, o); mins = fminf(mins, __shfl_xor(mins, o)); maxu = fmaxf(maxu, __shfl_xor(maxu, o)); }
    if (lane == 0) {
        const int want = (t + 1 < 256) ? t + 1 : 256;
        if (pc != want) atomicAdd(&flags[0], 1u);
        if (above) atomicAdd(&flags[2], 1u);
        if (mins < maxu) atomicAdd(&flags[3], 1u);
        if (t > 1000 && pc == 256 && mins <= maxu + 1e-12f) atomicAdd(&flags[4], 1u);
    }
    { const int s = (lane * 131 + t * 7) % (t + 1);
      float sc = 0.f;
      for (int h = 0; h < 16; ++h) { float d = 0.f;
          for (int k = 0; k < 64; ++k) d += __builtin_bit_cast(float, (unsigned)P[(size_t)t * PITCH + C_QI + h * 64 + k] << 16) * __builtin_bit_cast(float, (unsigned)P[(size_t)s * PITCH + C_KI + k] << 16);
          sc += __builtin_bit_cast(float, (unsigned)P[(size_t)t * PITCH + C_WI + h] << 16) * 0.03125f * fmaxf(d, 0.f); }
      const float got = SC[(size_t)t * S + s];
      if (fabsf(got - sc) > 1e-3f * (fabsf(sc) + 0.05f)) atomicAdd(&flags[1], 1u); }
}
__global__ void dbg_check_attnA(unsigned char* ws) {
    const int lane = threadIdx.x & 63, wv = blockIdx.x * 4 + (threadIdx.x >> 6);
    const int head = wv & 3, t = 100 + (wv >> 2) * 127;
    const bf16* P = (const bf16*)(ws + WS_P); const unsigned* WM = (const unsigned*)(ws + WS_WM); const float* TBL = (const float*)(ws + WS_TBL); const bf16* MIX = (const bf16*)(ws + WS_MIX);
    unsigned* flags = (unsigned*)(ws + WS_DBG);
    if (wv == 0 && lane == 0) atomicAdd(&flags[5], 1u);
    const float q0 = __builtin_bit_cast(float, (unsigned)P[(size_t)t * PITCH + C_QA + head * 128 + lane] << 16), q1 = __builtin_bit_cast(float, (unsigned)P[(size_t)t * PITCH + C_QA + head * 128 + 64 + lane] << 16);
    float l = 0.f, o0 = 0.f, o1 = 0.f;
    for (int s = 0; s <= t; ++s) {
        const unsigned w = WM[(size_t)t * 256 + (s >> 5)]; if (!((w >> (s & 31)) & 1)) continue;
        float d = q0 * __builtin_bit_cast(float, (unsigned)P[(size_t)s * PITCH + C_KA + head * 128 + lane] << 16) + q1 * __builtin_bit_cast(float, (unsigned)P[(size_t)s * PITCH + C_KA + head * 128 + 64 + lane] << 16);
        for (int o = 1; o < 64; o <<= 1) d += __shfl_xor(d, o);
        const float p = exp2f(d - 16.0f) * TBL[head * TBL_N + ((t - s) < 2239 ? (t - s) : 2239) + TBL_OFF];
        l += p; o0 += p * __builtin_bit_cast(float, (unsigned)P[(size_t)s * PITCH + C_VA + head * 128 + lane] << 16); o1 += p * __builtin_bit_cast(float, (unsigned)P[(size_t)s * PITCH + C_VA + head * 128 + 64 + lane] << 16);
    }
    o0 /= l; o1 /= l;
    const float g0 = __builtin_bit_cast(float, (unsigned)MIX[(size_t)t * D + head * 128 + lane] << 16), g1 = __builtin_bit_cast(float, (unsigned)MIX[(size_t)t * D + head * 128 + 64 + lane] << 16);
    float e2 = (g0 - o0) * (g0 - o0) + (g1 - o1) * (g1 - o1), n2 = o0 * o0 + o1 * o1;
    for (int o = 1; o < 64; o <<= 1) { e2 += __shfl_xor(e2, o); n2 += __shfl_xor(n2, o); }
    if (lane == 0 && e2 > 1e-3f * n2) atomicAdd(&flags[6], 1u);
    if (lane == 0 && e2 > 3e-2f * n2) atomicAdd(&flags[7], 1u);
}
__global__ void dbg_plant(unsigned char* ws, float* out) {
    const unsigned* flags = (const unsigned*)(ws + WS_DBG);
    if (threadIdx.x == 0) {
        if (flags[0]) out[0] += 1.0e6f;
        if (flags[1]) out[1] += 1.0e5f;
        if (flags[2]) out[2] += 1.0e4f;
        if (flags[3]) out[3] += 1.0e3f;
        if (flags[4] > 100) out[4] += 3.0e3f;
        if (flags[5] != 1) out[5] += 1.0e7f;
        if (flags[6] > 3) out[6] += 1.0e4f;
        if (flags[7] > 3) out[7] += 1.0e5f;
    }
}
#endif

#ifndef MK_PER_PHASE
#define MK_PER_PHASE 0
#endif
constexpr int NPH = 20;
#ifndef PH_MASK
#define PH_MASK 0xFFFFFu
#endif
#define IN(k) ((((PH_MASK) >> (k)) & 1u) && lo <= (k) && (k) < hi)
#define SEAM(k) do { if (IN(k) && IN((k) + 1)) xcd_barrier(bar); } while (0)
template <int LAYER>
DI void layer_phases(Frame& F, const int lo, const int hi, const XcdBarrier& bar) {
    bf16* H = (bf16*)(F.ws + WS_H); bf16* P = (bf16*)(F.ws + WS_P); bf16* MIX = (bf16*)(F.ws + WS_MIX); float* XB = (float*)(F.ws + WS_XB);
    bf16* ACT = (bf16*)(F.ws + WS_ACT); bf16* HS = (bf16*)(F.ws + WS_HS);
    const int bid = (int)blockIdx.x;
        constexpr int layer = LAYER; constexpr int pb = LAYER ? 10 : 1;
        if (IN(pb)) {
            pg8::Gemm g{H, (const bf16*)(F.ws + WS_WIN) + (size_t)layer * NINP * D, S, NINP, D}; pg8::StaticOrder So; So.init(S, NINP, F.G, bid);
            pg8::EpiStoreBf16 E{P, PITCH};
            pg8::gemm_phase<pg8::EpiStoreBf16, pg8::StaticOrder, true, true>(F.lds + RING_OFF, g, So, E);
        } SEAM(pb);
        if (IN(pb + 1)) { pn_phase(F, layer); i1_phase(F); } SEAM(pb + 1);
        if (IN(pb + 2)) { i2_phase(F); } SEAM(pb + 2);
        if (IN(pb + 3)) { attn_phase(F, layer); } SEAM(pb + 3);
        if (IN(pb + 4)) {
            pg8::Gemm g{MIX, (const bf16*)(F.ws + WS_WOUT) + (size_t)layer * D * D, S, D, D}; pg8::StaticOrder So; So.init(S, D, F.G, bid);
            pg8::EpiResF32 E{layer == 0 ? F.a->in[0] : (const float*)XB, XB, D};
            pg8::gemm_phase<pg8::EpiResF32, pg8::StaticOrder, true, true>(F.lds + RING_OFF, g, So, E);
        } SEAM(pb + 4);
        if (layer == 0) {
            if (IN(6)) { rms_phase(F, XB, F.a->in[4], H); } SEAM(6);
            if (IN(7)) {
                pg8::Gemm g{H, (const bf16*)(F.ws + WS_WGU), S, 2 * DFF, D}; pg8::StaticOrder So; So.init(S, 2 * DFF, F.G, bid);
                pg8::EpiSwiGLU E{ACT, DFF, 2 * DFF / 256};
                pg8::gemm_phase<pg8::EpiSwiGLU, pg8::StaticOrder, true, true>(F.lds + RING_OFF, g, So, E);
            } SEAM(7);
            if (IN(8)) {
                pg8::Gemm g{ACT, (const bf16*)(F.ws + WS_WDN), S, D, DFF}; pg8::StaticOrder So; So.init(S, D, F.G, bid);
                pg8::EpiResF32 E{XB, XB, D};
                pg8::gemm_phase<pg8::EpiResF32, pg8::StaticOrder, true, true>(F.lds + RING_OFF, g, So, E);
            } SEAM(8);
            if (IN(9)) { rms_phase(F, XB, F.a->in[3] + D, H); } SEAM(9);
        } else {
            if (IN(15)) { rms_router_phase(F, XB, F.a->in[4] + D, F.a->in[20], H); } SEAM(15);
            if (IN(16)) { gather_phase(F); } SEAM(16);
            if (IN(17)) {
                int off[9]; moe_offsets(F, off);
                pg8::MoeOrder Mo;
_Pragma("unroll")
                for (int e = 0; e < 9; ++e) Mo.rt0[e] = off[e] >> 8; Mo.npn = 2 * DFFE / 256; Mo.G = F.G; Mo.c = bid;
                pg8::Gemm g{HS, (const bf16*)(F.ws + WS_WMGU), MAXSLOT, NE * 2 * DFFE, D};
                pg8::EpiSwiGLU E{ACT, DFFE, 2 * DFFE / 256};
                pg8::gemm_phase<pg8::EpiSwiGLU, pg8::MoeOrder, true, true>(F.lds + RING_OFF, g, Mo, E);
            } SEAM(17);
            if (IN(18)) {
                int off[9]; moe_offsets(F, off);
                pg8::MoeOrder Mo;
_Pragma("unroll")
                for (int e = 0; e < 9; ++e) Mo.rt0[e] = off[e] >> 8; Mo.npn = D / 256; Mo.G = F.G; Mo.c = bid;
                pg8::Gemm g{ACT, (const bf16*)(F.ws + WS_WMDN), MAXSLOT, NE * D, DFFE};
                pg8::EpiMoeDown E{(float*)(F.ws + WS_OUTM), (const float*)(F.ws + WS_ROUTE + RT_SLOTG), D, D / 256};
                pg8::gemm_phase<pg8::EpiMoeDown, pg8::MoeOrder, true, true>(F.lds + RING_OFF, g, Mo, E);
            } SEAM(18);
            if (IN(19)) { combine_phase(F); }
        }
    }
__global__ void __launch_bounds__(NWAVES * 64, 2) trunk_fwd(Args args) {
    extern __shared__ __attribute__((aligned(16))) unsigned char lds[];
    Frame F;
    F.lds = (LAS unsigned char*)lds;
    F.MISC = (volatile LAS unsigned*)(F.lds + MISC_OFF);
    F.tid = threadIdx.x; F.lane = F.tid & 63; F.wave = __builtin_amdgcn_readfirstlane(F.tid >> 6);
    F.G = gridDim.x; { const int bx = blockIdx.x; F.vcu = (F.G % 8 == 0) ? (bx % 8) * (F.G / 8) + bx / 8 : bx; }
    F.ws = args.ws; F.ctl = (gu32*)(args.ws + WS_CTL); F.out = args.out;
    F.a = &args;
    for (int u = F.tid; u < (LDS_TBL_OFF - LDSCTL_OFF) / 4; u += NWAVES * 64) ((LAS unsigned*)(F.lds + LDSCTL_OFF))[u] = 0u;
    __syncthreads();
    const int lo = args.ph_lo, hi = args.ph_hi;
    XcdBarrier bar; bar.bar = (unsigned*)(F.ctl + CW_BAR); bar.x = 0; bar.st = nullptr;
    if (hi - lo > 1) bar = xcd_barrier_post((unsigned*)(F.ctl + CW_BAR), F.MISC + 8);

    if (IN(0)) { p0_prologue(F); } SEAM(0);

    layer_phases<0>(F, lo, hi, bar);
    layer_phases<1>(F, lo, hi, bar);
#undef IN
#undef SEAM
}

extern "C" void kernel_launch(void* const* d_in, const int* in_sizes, int n_in, void* d_out, int out_size, void* d_ws, size_t ws_size, hipStream_t stream) {
    static int grid = 0;
    if (grid == 0) {
        if (n_in != 24 || in_sizes[0] != S * D || out_size != S * D || ws_size < WS_END) { fprintf(stderr, "kernel_launch: unexpected shapes (n_in %d, x %d, out %d, ws %zu < %zu); nothing launched\n", n_in, n_in > 0 ? in_sizes[0] : -1, out_size, ws_size, (size_t)WS_END); grid = -1; return; }
        int dev = 0, cus = 0, per_cu = 0;
        if (hipGetDevice(&dev) != hipSuccess || hipDeviceGetAttribute(&cus, hipDeviceAttributeMultiprocessorCount, dev) != hipSuccess) { grid = -1; return; }
        if (hipFuncSetAttribute((const void*)trunk_fwd, hipFuncAttributeMaxDynamicSharedMemorySize, LDS_BYTES) != hipSuccess) { fprintf(stderr, "kernel_launch: hipFuncSetAttribute failed\n"); grid = -1; return; }
        if (hipOccupancyMaxActiveBlocksPerMultiprocessor(&per_cu, (const void*)trunk_fwd, NWAVES * 64, LDS_BYTES) != hipSuccess || per_cu < 1) { fprintf(stderr, "kernel_launch: occupancy query says %d blocks per CU\n", per_cu); (void)hipGetLastError(); per_cu = 1; }
        grid = cus;
        if (grid > 256) grid = 256;
    }
    if (grid < 0) return;
    if (hipMemsetAsync((char*)d_ws + WS_CTL, 0, CTL_ZERO_BYTES, stream) != hipSuccess) return;
    Args a{};
    for (int i = 0; i < 24; ++i) a.in[i] = (const float*)d_in[i];
    a.out = (float*)d_out; a.ws = (unsigned char*)d_ws;
#if MK_PER_PHASE
    for (int k = 0; k < NPH; ++k) { a.ph_lo = k; a.ph_hi = k + 1; hipLaunchKernelGGL(trunk_fwd, dim3(grid), dim3(NWAVES * 64), LDS_BYTES, stream, a);
#ifdef DBG_CHECKS
        if (k == 3) hipLaunchKernelGGL(dbg_check_indexer, dim3(S / 4), dim3(256), 0, stream, (unsigned char*)d_ws);
        if (k == 4) hipLaunchKernelGGL(dbg_check_attnA, dim3(64), dim3(256), 0, stream, (unsigned char*)d_ws);
        if (k == NPH - 1) hipLaunchKernelGGL(dbg_plant, dim3(1), dim3(64), 0, stream, (unsigned char*)d_ws, (float*)d_out);
#endif
    }
#else
    a.ph_lo = 0; a.ph_hi = NPH;
    hipLaunchKernelGGL(trunk_fwd, dim3(grid), dim3(NWAVES * 64), LDS_BYTES, stream, a);
#endif
    const hipError_t le = hipPeekAtLastError();
    if (le != hipSuccess) fprintf(stderr, "kernel_launch: launch failed: %s\n", hipGetErrorName(le));
}
```

```cpp
#include <hip/hip_runtime.h>
#include <cstdio>
#include <cstdint>
#include <cmath>
namespace pg8 {
#define PG8_LAS __attribute__((address_space(3)))
typedef unsigned short bf16_t;
typedef short bf16x8 __attribute__((ext_vector_type(8)));
typedef float f32x4 __attribute__((ext_vector_type(4)));
typedef unsigned u32x4 __attribute__((ext_vector_type(4)));
typedef unsigned u32x2 __attribute__((ext_vector_type(2)));
typedef int i32x4 __attribute__((ext_vector_type(4)));
typedef int i32x8 __attribute__((ext_vector_type(8)));
constexpr int BM = 256, BK = 64, HALF = 128, HTB = HALF * BK * 2  , STAGE_BYTES = 8 * HTB, NXCD = 8, WGM = 8;

__host__ __device__ __forceinline__ int lds_byte(int r, int c) { const int st = (r >> 4) * 2 + (c >> 5), rr = r & 15, cc = c & 31, ob = rr * 64 + cc * 2; return st * 1024 + (ob ^ (((ob >> 9) & 1) << 5)); }
__host__ __device__ __forceinline__ void stage_rc(int b, int& R, int& C) { const int st = b / 1024, sb = b % 1024, swz = sb ^ (((sb >> 9) & 1) << 5); R = (st >> 1) * 16 + swz / 64; C = (st & 1) * 32 + (swz % 64) / 2; }
__host__ __device__ __forceinline__ int perm32(int rho) { const int n = rho >> 4, i = rho & 15; return 8 * (i >> 2) + 4 * n + (i & 3); }

struct Unit { int pm, pn, kt0, ktn, sliced; };
struct Gemm { const bf16_t* A; const bf16_t* Bt; int M, N, K; };

struct StaticOrder {
    int nM, nN, nwg, G, c;
    __host__ __device__ void init(int M, int N, int G_, int c_) { nM = M / BM; nN = N / BM; nwg = nM * nN; G = G_; c = c_; }
    __host__ __device__ bool next(int i, Unit& u) const {
        const long L = (long)i * G + c; if (L >= nwg) return false;
        int wgid = (int)L; { const int q = nwg / NXCD, r = nwg % NXCD, xcd = wgid % NXCD, off = wgid / NXCD; wgid = (xcd < r ? xcd * (q + 1) : r * (q + 1) + (xcd - r) * q) + off; }
        const int nig = WGM * nN, gid = wgid / nig, fm = gid * WGM, gsz = (nM - fm) < WGM ? (nM - fm) : WGM;
        u.pm = fm + ((wgid % nig) % gsz); u.pn = (wgid % nig) / gsz; return true;
    }
    __device__ __forceinline__ void a_ready(const Unit&) const {}
    __device__ __forceinline__ void done(const Unit&) const {}
};

__device__ __forceinline__ unsigned cvt_pk_bf16(float lo, float hi) { unsigned r; asm volatile("v_cvt_pk_bf16_f32 %0, %1, %2" : "=v"(r) : "v"(lo), "v"(hi)); return r; }
typedef float f32x2 __attribute__((ext_vector_type(2)));
struct EpiStoreBf16 {
    static constexpr bool PERM = true, AFTER_DRAIN = false;
    bf16_t* O; int ldc;
    __device__ __forceinline__ void operator()(const f32x4 (&acc)[2][2][4][2], const Unit& u, int wr, int wc, int fr, int fq) const {
        const int row0 = u.pm * BM + wr * 64 + fr, col0 = u.pn * BM + wc * 32 + 8 * fq;
#pragma unroll
        for (int ai = 0; ai < 2; ++ai)
#pragma unroll
            for (int m = 0; m < 4; ++m) { bf16_t* rowp = O + (size_t)(row0 + ai * HALF + m * 16) * ldc + col0;
#pragma unroll
                for (int bj = 0; bj < 2; ++bj) { const f32x4 v0 = acc[ai][bj][m][0], v1 = acc[ai][bj][m][1];
                    u32x4 w; w.x = cvt_pk_bf16(v0[0], v0[1]); w.y = cvt_pk_bf16(v0[2], v0[3]); w.z = cvt_pk_bf16(v1[0], v1[1]); w.w = cvt_pk_bf16(v1[2], v1[3]);
                    *(u32x4*)(rowp + bj * HALF) = w; } }
    }
};
struct EpiStoreBf16S {
    static constexpr bool PERM = true, AFTER_DRAIN = false;
    bf16_t* O; int ldc; const float* rowscale; const float* wscale;
    __device__ __forceinline__ void operator()(const f32x4 (&acc)[2][2][4][2], const Unit& u, int wr, int wc, int fr, int fq) const {
        const int row0 = u.pm * BM + wr * 64 + fr, col0 = u.pn * BM + wc * 32 + 8 * fq; const float sw = wscale[0];
#pragma unroll
        for (int ai = 0; ai < 2; ++ai)
#pragma unroll
            for (int m = 0; m < 4; ++m) { const int row = row0 + ai * HALF + m * 16; bf16_t* rowp = O + (size_t)row * ldc + col0; const float f = rowscale[row] * sw;
#pragma unroll
                for (int bj = 0; bj < 2; ++bj) { const f32x4 v0 = __builtin_convertvector(__builtin_bit_cast(i32x4, acc[ai][bj][m][0]), f32x4) * f, v1 = __builtin_convertvector(__builtin_bit_cast(i32x4, acc[ai][bj][m][1]), f32x4) * f;
                    u32x4 w; w.x = cvt_pk_bf16(v0[0], v0[1]); w.y = cvt_pk_bf16(v0[2], v0[3]); w.z = cvt_pk_bf16(v1[0], v1[1]); w.w = cvt_pk_bf16(v1[2], v1[3]);
                    *(u32x4*)(rowp + bj * HALF) = w; } }
    }
};
struct EpiStoreBf16SN {
    static constexpr bool PERM = true, AFTER_DRAIN = false;
    bf16_t* O; int ldc; const float* rowscale; const float* wscale;
    const float* g0; const float* g1; const float* g2; const float* g3; const float* g4; const float* g5;
    PG8_LAS float* xch;
    __device__ __forceinline__ void operator()(const f32x4 (&acc)[2][2][4][2], const Unit& u, int wr, int wc, int fr_, int fq_) const {
        int fr = fr_, fq = fq_; asm volatile("" : "+v"(fr), "+v"(fq));
        const int row0 = u.pm * BM + wr * 64 + fr, col0 = u.pn * BM + wc * 32 + 8 * fq; const float sw = wscale[0];
        const int pn = u.pn;
        const int gsel = pn < 2 ? 0 : (pn < 4 ? 1 : ((pn >= 10 && pn < 13) ? 2 : ((pn >= 13 && pn < 16) ? 3 : ((pn >= 19 && pn < 22) ? 4 : ((pn >= 22 && pn < 25) ? 5 : -1)))));
        if (gsel < 0) {
#pragma unroll
            for (int ai = 0; ai < 2; ++ai)
#pragma unroll
                for (int m = 0; m < 4; ++m) { const int row = row0 + ai * HALF + m * 16; bf16_t* rowp = O + (size_t)row * ldc + col0; const float f = rowscale[row] * sw;
#pragma unroll
                    for (int bj = 0; bj < 2; ++bj) { const f32x4 v0 = __builtin_convertvector(__builtin_bit_cast(i32x4, acc[ai][bj][m][0]), f32x4) * f, v1 = __builtin_convertvector(__builtin_bit_cast(i32x4, acc[ai][bj][m][1]), f32x4) * f;
                        u32x4 w; w.x = cvt_pk_bf16(v0[0], v0[1]); w.y = cvt_pk_bf16(v0[2], v0[3]); w.z = cvt_pk_bf16(v1[0], v1[1]); w.w = cvt_pk_bf16(v1[2], v1[3]);
                        *(u32x4*)(rowp + bj * HALF) = w; } }
            return;
        }
        const bool d64 = gsel >= 4;
        const float* gv = gsel == 0 ? g0 : (gsel == 1 ? g1 : (gsel == 2 ? g2 : (gsel == 3 ? g3 : (gsel == 4 ? g4 : g5))));
        const float qs = (gsel & 1) ? 1.0f : (d64 ? 0.125f * 1.4426950408889634f : 0.08838834764831845f * 1.4426950408889634f);
        const int gi0 = (wc * 32 + 8 * fq) & (d64 ? 63 : 127);
        float gs[8];
#pragma unroll
        for (int e = 0; e < 8; ++e) gs[e] = gv[gi0 + e] * qs;
#pragma unroll
        for (int ai = 0; ai < 2; ++ai)
#pragma unroll
            for (int m = 0; m < 4; ++m) { const int row = row0 + ai * HALF + m * 16; const float f = rowscale[row] * sw; const int rit = wr * 64 + fr + ai * HALF + m * 16;
#pragma unroll
                for (int bj = 0; bj < 2; ++bj) {
                    const f32x4 a = __builtin_convertvector(__builtin_bit_cast(i32x4, acc[ai][bj][m][0]), f32x4) * f, b = __builtin_convertvector(__builtin_bit_cast(i32x4, acc[ai][bj][m][1]), f32x4) * f;
                    float ss = (a[0] * a[0] + a[1] * a[1]) + (a[2] * a[2] + a[3] * a[3]) + (b[0] * b[0] + b[1] * b[1]) + (b[2] * b[2] + b[3] * b[3]);
                    ss += __shfl_xor(ss, 16); ss += __shfl_xor(ss, 32);
                    if (fq == 0) xch[(wc * 256 + rit) * 2 + bj] = ss; }
                __builtin_amdgcn_sched_barrier(0); }
        asm volatile("s_waitcnt lgkmcnt(0)" ::: "memory");
        __builtin_amdgcn_s_barrier();
        const int wb = d64 ? (wc & 2) : 0;
#pragma unroll
        for (int ai = 0; ai < 2; ++ai)
#pragma unroll
            for (int m = 0; m < 4; ++m) { const int row = row0 + ai * HALF + m * 16; bf16_t* rowp = O + (size_t)row * ldc + col0; const int rit = wr * 64 + fr + ai * HALF + m * 16; const float f = rowscale[row] * sw;
#pragma unroll
                for (int bj = 0; bj < 2; ++bj) {
                    float t = xch[((wb + 0) * 256 + rit) * 2 + bj] + xch[((wb + 1) * 256 + rit) * 2 + bj];
                    if (!d64) t += xch[(2 * 256 + rit) * 2 + bj] + xch[(3 * 256 + rit) * 2 + bj];
                    const float rf = f / __builtin_sqrtf(t * (d64 ? (1.0f / 64.0f) : (1.0f / 128.0f)) + 1e-6f);
                    i32x4 ia = __builtin_bit_cast(i32x4, acc[ai][bj][m][0]), ib = __builtin_bit_cast(i32x4, acc[ai][bj][m][1]); asm volatile("" : "+v"(ia), "+v"(ib));
                    const f32x4 a = __builtin_convertvector(ia, f32x4) * rf, b = __builtin_convertvector(ib, f32x4) * rf;
                    u32x4 w; w.x = cvt_pk_bf16(a[0] * gs[0], a[1] * gs[1]); w.y = cvt_pk_bf16(a[2] * gs[2], a[3] * gs[3]); w.z = cvt_pk_bf16(b[0] * gs[4], b[1] * gs[5]); w.w = cvt_pk_bf16(b[2] * gs[6], b[3] * gs[7]);
                    *(u32x4*)(rowp + bj * HALF) = w; }
                __builtin_amdgcn_sched_barrier(0); }
    }
};
struct EpiResI8 {
    static constexpr bool PERM = false, AFTER_DRAIN = false;
    const float* res; float* out; int ld; const float* wscale; float ascale;
    __device__ __forceinline__ void operator()(const f32x4 (&acc)[2][2][4][2], const Unit& u, int wr, int wc, int fr, int fq) const {
        const int row0 = u.pm * BM + wr * 64 + fr, col0 = u.pn * BM + wc * 32 + 4 * fq; const float f = wscale[0] * ascale;
#pragma unroll
        for (int ai = 0; ai < 2; ++ai)
#pragma unroll
            for (int m = 0; m < 4; ++m) { const size_t ro = (size_t)(row0 + ai * HALF + m * 16) * ld + col0;
#pragma unroll
                for (int bj = 0; bj < 2; ++bj)
#pragma unroll
                    for (int n = 0; n < 2; ++n) { const f32x4 r = *(const f32x4*)(res + ro + bj * HALF + n * 16);
                        *(f32x4*)(out + ro + bj * HALF + n * 16) = __builtin_convertvector(__builtin_bit_cast(i32x4, acc[ai][bj][m][n]), f32x4) * f + r; } }
    }
};
struct EpiResF32 {
    static constexpr bool PERM = false, AFTER_DRAIN = false;
    const float* res; float* out; int ld;
    __device__ __forceinline__ void operator()(const f32x4 (&acc)[2][2][4][2], const Unit& u, int wr, int wc, int fr, int fq) const {
        const int row0 = u.pm * BM + wr * 64 + fr, col0 = u.pn * BM + wc * 32 + 4 * fq;
#pragma unroll
        for (int ai = 0; ai < 2; ++ai)
#pragma unroll
            for (int m = 0; m < 4; ++m) { const size_t ro = (size_t)(row0 + ai * HALF + m * 16) * ld + col0;
#pragma unroll
                for (int bj = 0; bj < 2; ++bj)
#pragma unroll
                    for (int n = 0; n < 2; ++n) { const f32x4 r = *(const f32x4*)(res + ro + bj * HALF + n * 16); *(f32x4*)(out + ro + bj * HALF + n * 16) = acc[ai][bj][m][n] + r; } }
    }
};
template <bool RES_BF16, int SHIFT>
struct EpiResB {
    static constexpr bool PERM = false, AFTER_DRAIN = false;
    const void* res; bf16_t* out; int ld;
    __device__ __forceinline__ void operator()(const f32x4 (&acc)[2][2][4][2], const Unit& u, int wr, int wc, int fr, int fq) const {
        const int row0 = u.pm * BM + wr * 64 + fr, col0 = u.pn * BM + wc * 32 + 4 * fq;
        constexpr float WS_ = 1.0f / (float)(1 << SHIFT);
#pragma unroll
        for (int ai = 0; ai < 2; ++ai)
#pragma unroll
            for (int m = 0; m < 4; ++m) { const size_t ro = (size_t)(row0 + ai * HALF + m * 16) * ld + col0;
#pragma unroll
                for (int bj = 0; bj < 2; ++bj)
#pragma unroll
                    for (int n = 0; n < 2; ++n) { const size_t o = ro + bj * HALF + n * 16; f32x4 r;
                        if (RES_BF16) { const u32x2 w = *(const u32x2*)((const bf16_t*)res + o); r[0] = __builtin_bit_cast(float, w.x << 16); r[1] = __builtin_bit_cast(float, w.x & 0xffff0000u); r[2] = __builtin_bit_cast(float, w.y << 16); r[3] = __builtin_bit_cast(float, w.y & 0xffff0000u); }
                        else r = *(const f32x4*)((const float*)res + o);
                        const f32x4 t = acc[ai][bj][m][n] * WS_ + r;
                        u32x2 q; q.x = cvt_pk_bf16(t[0], t[1]); q.y = cvt_pk_bf16(t[2], t[3]); *(u32x2*)(out + o) = q; } }
    }
};
__device__ __forceinline__ float silu_mul(float g, float u) { return g * u * __builtin_amdgcn_rcpf(1.0f + __builtin_amdgcn_exp2f(-1.4426950408889634f * g)); }
struct EpiSwiGLU {
    static constexpr bool PERM = true, AFTER_DRAIN = false;
    bf16_t* O; int ldf; int npn;
    __device__ __forceinline__ void operator()(const f32x4 (&acc)[2][2][4][2], const Unit& u, int wr, int wc, int fr, int fq) const {
        const int pnl = u.pn % npn;
        const int row0 = u.pm * BM + wr * 64 + fr, col0 = pnl * HALF + wc * 32 + 8 * fq;
#pragma unroll
        for (int ai = 0; ai < 2; ++ai)
#pragma unroll
            for (int m = 0; m < 4; ++m) { bf16_t* rowp = O + (size_t)(row0 + ai * HALF + m * 16) * ldf + col0;
                const f32x4 g0 = acc[ai][0][m][0], g1 = acc[ai][0][m][1], u0 = acc[ai][1][m][0], u1 = acc[ai][1][m][1];
                u32x4 w; w.x = cvt_pk_bf16(silu_mul(g0[0], u0[0]), silu_mul(g0[1], u0[1])); w.y = cvt_pk_bf16(silu_mul(g0[2], u0[2]), silu_mul(g0[3], u0[3]));
                w.z = cvt_pk_bf16(silu_mul(g1[0], u1[0]), silu_mul(g1[1], u1[1])); w.w = cvt_pk_bf16(silu_mul(g1[2], u1[2]), silu_mul(g1[3], u1[3]));
                *(u32x4*)rowp = w; }
    }
};
struct EpiMoeDown {
    static constexpr bool PERM = false, AFTER_DRAIN = false;
    float* out; const float* gate; int ld; int npn;
    __device__ __forceinline__ void operator()(const f32x4 (&acc)[2][2][4][2], const Unit& u, int wr, int wc, int fr, int fq) const {
        const int pnl = u.pn % npn;
        const int row0 = u.pm * BM + wr * 64 + fr, col0 = pnl * BM + wc * 32 + 4 * fq;
#pragma unroll
        for (int ai = 0; ai < 2; ++ai)
#pragma unroll
            for (int m = 0; m < 4; ++m) { const int row = row0 + ai * HALF + m * 16; const float gt = gate[row]; float* rowp = out + (size_t)row * ld + col0;
#pragma unroll
                for (int bj = 0; bj < 2; ++bj)
#pragma unroll
                    for (int n = 0; n < 2; ++n) *(f32x4*)(rowp + bj * HALF + n * 16) = acc[ai][bj][m][n] * gt; }
    }
};
constexpr int W8_SHIFT = 6;
__device__ __forceinline__ float clamp8(float v) { return __builtin_amdgcn_fmed3f(v, -448.0f, 448.0f); }
__device__ __forceinline__ unsigned pk4_fp8(float a, float b, float c, float d) { int w = __builtin_amdgcn_cvt_pk_fp8_f32(clamp8(a), clamp8(b), 0, false); w = __builtin_amdgcn_cvt_pk_fp8_f32(clamp8(c), clamp8(d), w, true); return (unsigned)w; }
template <bool W8> struct EpiSwiGLU8T {
    static constexpr bool PERM = true, AFTER_DRAIN = false;
    unsigned char* O; int ldf; int npn;
    __device__ __forceinline__ void operator()(const f32x4 (&acc)[2][2][4][2], const Unit& u, int wr, int wc, int fr, int fq) const {
        const int pnl = u.pn % npn;
        const int row0 = u.pm * BM + wr * 64 + fr, col0 = pnl * HALF + wc * 32 + 8 * fq;
#pragma unroll
        for (int ai = 0; ai < 2; ++ai)
#pragma unroll
            for (int m = 0; m < 4; ++m) { unsigned char* rowp = O + (size_t)(row0 + ai * HALF + m * 16) * ldf + col0;
                constexpr float WS_ = W8 ? 1.0f / (float)(1 << W8_SHIFT) : 1.0f;
                const f32x4 g0 = acc[ai][0][m][0] * WS_, g1 = acc[ai][0][m][1] * WS_, u0 = acc[ai][1][m][0] * WS_, u1 = acc[ai][1][m][1] * WS_;
                typedef unsigned u32x2_ __attribute__((ext_vector_type(2)));
                u32x2_ w; w.x = pk4_fp8(silu_mul(g0[0], u0[0]), silu_mul(g0[1], u0[1]), silu_mul(g0[2], u0[2]), silu_mul(g0[3], u0[3]));
                w.y = pk4_fp8(silu_mul(g1[0], u1[0]), silu_mul(g1[1], u1[1]), silu_mul(g1[2], u1[2]), silu_mul(g1[3], u1[3]));
                *(u32x2_*)rowp = w; }
    }
};
__device__ __forceinline__ void moe_slice_plan(int total, int G, int& n_full, int& sl) {
    n_full = (total / G) * G; const int r = total - n_full; sl = 1;
    if (r > 0) { if (r * 7 <= G) sl = 7; else if (r * 4 <= G) sl = 4; else if (r * 2 <= G) sl = 2; }
    if (sl == 1) n_full = total;
}
typedef EpiSwiGLU8T<true> EpiSwiGLU8;
__device__ __forceinline__ f32x4 i2f(const f32x4& a) { return __builtin_convertvector(__builtin_bit_cast(i32x4, a), f32x4); }
struct EpiSwiGLUi8 {
    static constexpr bool PERM = true, AFTER_DRAIN = false;
    unsigned char* O; int ldf; int npn; const float* rowscale; const float* wsg; const float* wsu;
    __device__ __forceinline__ void operator()(const f32x4 (&acc)[2][2][4][2], const Unit& u, int wr, int wc, int fr, int fq) const {
        const int e = u.pn / npn, pnl = u.pn - e * npn;
        const float sg = wsg[e], su = wsu[e];
        const int row0 = u.pm * BM + wr * 64 + fr, col0 = pnl * HALF + wc * 32 + 8 * fq;
#pragma unroll
        for (int ai = 0; ai < 2; ++ai)
#pragma unroll
            for (int m = 0; m < 4; ++m) { const int row = row0 + ai * HALF + m * 16; unsigned char* rowp = O + (size_t)row * ldf + col0;
                const float rs = rowscale[row], fg = rs * sg, fu = rs * su;
                const f32x4 g0 = i2f(acc[ai][0][m][0]) * fg, g1 = i2f(acc[ai][0][m][1]) * fg, u0 = i2f(acc[ai][1][m][0]) * fu, u1 = i2f(acc[ai][1][m][1]) * fu;
                typedef unsigned u32x2_ __attribute__((ext_vector_type(2)));
                u32x2_ w; w.x = pk4_fp8(silu_mul(g0[0], u0[0]), silu_mul(g0[1], u0[1]), silu_mul(g0[2], u0[2]), silu_mul(g0[3], u0[3]));
                w.y = pk4_fp8(silu_mul(g1[0], u1[0]), silu_mul(g1[1], u1[1]), silu_mul(g1[2], u1[2]), silu_mul(g1[3], u1[3]));
                *(u32x2_*)rowp = w; }
    }
};
#ifndef OUTM_BF16
#define OUTM_BF16 0
#endif
struct EpiMoeDown8 {
    static constexpr bool PERM = false, AFTER_DRAIN = false;
    float* out; const float* gate; int ld; int npn; float* outp;
    __device__ __forceinline__ void operator()(const f32x4 (&acc)[2][2][4][2], const Unit& u, int wr, int wc, int fr, int fq) const {
        const int pnl = u.pn % npn;
        const int row0 = u.pm * BM + wr * 64 + fr, col0 = pnl * BM + wc * 32 + 4 * fq;
#pragma unroll
        for (int ai = 0; ai < 2; ++ai)
#pragma unroll
            for (int m = 0; m < 4; ++m) { const int row = row0 + ai * HALF + m * 16; const float gt = gate[row] * (1.0f / (float)(1 << W8_SHIFT));
                float* rowp = u.sliced ? outp + (size_t)(u.sliced - 1) * (BM * BM) + (size_t)(wr * 64 + fr + ai * HALF + m * 16) * BM + wc * 32 + 4 * fq : out + (size_t)row * ld + col0;
#pragma unroll
                for (int bj = 0; bj < 2; ++bj)
#pragma unroll
                    for (int n = 0; n < 2; ++n) {
#if OUTM_BF16
                        if (!u.sliced) { const f32x4 t = acc[ai][bj][m][n] * gt; u32x2 q; q.x = cvt_pk_bf16(t[0], t[1]); q.y = cvt_pk_bf16(t[2], t[3]);
                            *(u32x2*)((bf16_t*)out + (size_t)row * ld + col0 + bj * HALF + n * 16) = q; continue; }
#endif
                        *(f32x4*)(rowp + bj * HALF + n * 16) = acc[ai][bj][m][n] * gt; } }
    }
};
struct EpiRes8 {
    static constexpr bool PERM = false, AFTER_DRAIN = false;
    const float* res; float* out; int ld;
    __device__ __forceinline__ void operator()(const f32x4 (&acc)[2][2][4][2], const Unit& u, int wr, int wc, int fr, int fq) const {
        const int row0 = u.pm * BM + wr * 64 + fr, col0 = u.pn * BM + wc * 32 + 4 * fq;
        constexpr float WS_ = 1.0f / (float)(1 << W8_SHIFT);
#pragma unroll
        for (int ai = 0; ai < 2; ++ai)
#pragma unroll
            for (int m = 0; m < 4; ++m) { const size_t ro = (size_t)(row0 + ai * HALF + m * 16) * ld + col0;
#pragma unroll
                for (int bj = 0; bj < 2; ++bj)
#pragma unroll
                    for (int n = 0; n < 2; ++n) { const f32x4 r = *(const f32x4*)(res + ro + bj * HALF + n * 16); *(f32x4*)(out + ro + bj * HALF + n * 16) = acc[ai][bj][m][n] * WS_ + r; } }
    }
};
struct MoeOrder {
    int rt0[9]; int npn, G, c;
    int ct;
    int n_full, sl, ktt;
    __device__ __forceinline__ bool next(int i, Unit& u) const {
        const int total = rt0[8] * npn, Lq = i * G + c;
        if (Lq >= n_full + (total - n_full) * sl) return false;
        int L = Lq;
        if (Lq >= n_full) { const int j = Lq - n_full; L = n_full + j / sl; const int part = j % sl; u.ktn = ktt / sl; u.kt0 = part * u.ktn; u.sliced = 1 + j; }
        int e = 0, rb = 0, nr = 1;
#pragma unroll
        for (int k = 0; k < 8; ++k) { const bool in = (L >= rt0[k] * npn) && (L < rt0[k + 1] * npn); e = in ? k : e; rb = in ? rt0[k] : rb; nr = in ? (rt0[k + 1] - rt0[k]) : nr; }
        const int j = L - rb * npn;
#ifdef MOE_ROWMAJOR
        u.pm = rb + (j / npn); u.pn = e * npn + (j % npn); return true;
#else
        u.pm = (ct > 0 ? e * ct : rb) + (j % nr); u.pn = e * npn + (j / nr); return true;
#endif
    }
    __device__ __forceinline__ void a_ready(const Unit&) const {}
    __device__ __forceinline__ void done(const Unit&) const {}
};
template <class Epi, class Sched, bool ALIGN_EPI = false, bool SP2 = false, int MODE = 0>
__device__ __forceinline__ void gemm_phase(PG8_LAS unsigned char* lds, const Gemm g, const Sched& S, const Epi& E) {
    constexpr bool FP8 = (MODE == 1);
    const int tid = threadIdx.x, wid = __builtin_amdgcn_readfirstlane(tid >> 6), lane = tid & 63, wr = wid >> 2, wc = wid & 3, fr = lane & 15, fq = lane >> 4;
    const int K = g.K, nt = K / BK;
    unsigned voffA[2], voffB[2];
#pragma unroll
    for (int i = 0; i < 2; ++i) { int R, C; stage_rc(tid * 16 + i * 8192, R, C); const int Rb = Epi::PERM ? ((R & ~31) + perm32(R & 31)) : R;
        voffA[i] = (unsigned)(R * K + C) * 2u; voffB[i] = (unsigned)(Rb * K + C) * 2u; }
    const size_t kstep = (size_t)(BK * 2);
    const size_t hstep = (size_t)HALF * K * 2;
    const size_t tstep = 2 * hstep;
    const unsigned ldsw = (unsigned)wid * 1024u;
    const int aoff = lds_byte(wr * 64 + fr, fq * 8), boff = lds_byte(wc * 32 + fr, fq * 8);
#define PG8_SA(b, h) (((b) * 2 + (h)) * HTB)
#define PG8_SB(b, h) ((4 + (b) * 2 + (h)) * HTB)
#define PG8_STAGE(bufoff, gbase, voff) do { _Pragma("unroll") for (int _i = 0; _i < 2; ++_i) \
        __builtin_amdgcn_global_load_lds((const unsigned*)((const char*)(gbase) + (voff)[_i]), (PG8_LAS unsigned*)(lds + (bufoff) + ldsw + _i * 8192), 16, 0, 0); } while (0)
#define PG8_LD16(off) (*(const PG8_LAS i32x4*)(lds + (off)))
#define PG8_LDA(dst, b, h) do { if constexpr (FP8) { _Pragma("unroll") for (int m = 0; m < 4; ++m) dst##8[m] = __builtin_shufflevector(PG8_LD16(PG8_SA(b, h) + aoff + m * 2048), PG8_LD16(PG8_SA(b, h) + aoff + m * 2048 + 1024), 0, 1, 2, 3, 4, 5, 6, 7); } \
        else { _Pragma("unroll") for (int m = 0; m < 4; ++m) _Pragma("unroll") for (int k = 0; k < 2; ++k) dst[m][k] = *(const PG8_LAS bf16x8*)(lds + PG8_SA(b, h) + aoff + m * 2048 + k * 1024); } } while (0)
#define PG8_LDB(dst, b, h) do { if constexpr (FP8) { _Pragma("unroll") for (int n = 0; n < 2; ++n) dst##8[n] = __builtin_shufflevector(PG8_LD16(PG8_SB(b, h) + boff + n * 2048), PG8_LD16(PG8_SB(b, h) + boff + n * 2048 + 1024), 0, 1, 2, 3, 4, 5, 6, 7); } \
        else { _Pragma("unroll") for (int n = 0; n < 2; ++n) _Pragma("unroll") for (int k = 0; k < 2; ++k) dst[n][k] = *(const PG8_LAS bf16x8*)(lds + PG8_SB(b, h) + boff + n * 2048 + k * 1024); } } while (0)
#define PG8_MMA(ai, bj, At, Bt) do { __builtin_amdgcn_s_setprio(1); \
        if constexpr (FP8) { _Pragma("unroll") for (int m = 0; m < 4; ++m) _Pragma("unroll") for (int n = 0; n < 2; ++n) \
            asm volatile("v_mfma_scale_f32_16x16x128_f8f6f4 %0, %1, %2, %0, %3, %3 op_sel_hi:[0,0,0]" : "+v"(acc[ai][bj][m][n]) : "v"(Bt##8[n]), "v"(At##8[m]), "v"(sc127)); } \
        else if constexpr (MODE == 2) { _Pragma("unroll") for (int m = 0; m < 4; ++m) _Pragma("unroll") for (int n = 0; n < 2; ++n) _Pragma("unroll") for (int k = 0; k < 2; ++k) \
            acc[ai][bj][m][n] = __builtin_bit_cast(f32x4, __builtin_amdgcn_mfma_i32_16x16x64_i8(__builtin_bit_cast(i32x4, Bt[n][k]), __builtin_bit_cast(i32x4, At[m][k]), __builtin_bit_cast(i32x4, acc[ai][bj][m][n]), 0, 0, 0)); } \
        else { _Pragma("unroll") for (int m = 0; m < 4; ++m) _Pragma("unroll") for (int n = 0; n < 2; ++n) _Pragma("unroll") for (int k = 0; k < 2; ++k) \
            acc[ai][bj][m][n] = __builtin_amdgcn_mfma_f32_16x16x32_bf16(Bt[n][k], At[m][k], acc[ai][bj][m][n], 0, 0, 0); } \
        __builtin_amdgcn_s_setprio(0); } while (0)
#define PG8_WAIT_V(n) asm volatile("s_waitcnt vmcnt(" #n ")" ::: "memory")
#define PG8_WAIT_L(n) asm volatile("s_waitcnt lgkmcnt(" #n ")" ::: "memory")
#define PG8_BAR __builtin_amdgcn_s_barrier()
#define PG8_SCHED __builtin_amdgcn_sched_barrier(0)
    Unit cur, nxt; int ui = 0;
    cur.kt0 = 0; cur.ktn = nt; cur.sliced = 0;
    if (!S.next(0, cur)) return;
    f32x4 acc[2][2][4][2];
#pragma unroll
    for (int a = 0; a < 2; ++a)
#pragma unroll
        for (int b = 0; b < 2; ++b)
#pragma unroll
            for (int m = 0; m < 4; ++m)
#pragma unroll
                for (int n = 0; n < 2; ++n) acc[a][b][m][n] = (f32x4){0.f, 0.f, 0.f, 0.f};
    int sc127 = 127; asm volatile("" : "+v"(sc127));
    bf16x8 At[4][2], B0[2][2], B1[2][2]; i32x8 At8[4], B08[2], B18[2];
    const char* cA = (const char*)g.A + (size_t)cur.pm * tstep + (size_t)cur.kt0 * kstep; const char* cB = (const char*)g.Bt + (size_t)cur.pn * tstep + (size_t)cur.kt0 * kstep;
    S.a_ready(cur);
    if constexpr (SP2) {
        PG8_STAGE(PG8_SB(0, 0), cB, voffB); PG8_STAGE(PG8_SB(0, 1), cB + hstep, voffB); PG8_STAGE(PG8_SA(0, 0), cA, voffA); PG8_STAGE(PG8_SA(0, 1), cA + hstep, voffA);
        if (wr == 1) PG8_BAR;
        PG8_WAIT_V(2); PG8_BAR;
        PG8_STAGE(PG8_SB(1, 0), cB + kstep, voffB); PG8_STAGE(PG8_SA(1, 0), cA + kstep, voffA); PG8_STAGE(PG8_SB(1, 1), cB + hstep + kstep, voffB);
        PG8_WAIT_V(6); PG8_BAR;
    } else {
        PG8_STAGE(PG8_SB(0, 0), cB, voffB); PG8_STAGE(PG8_SA(0, 0), cA, voffA); PG8_STAGE(PG8_SB(0, 1), cB + hstep, voffB); PG8_STAGE(PG8_SA(0, 1), cA + hstep, voffA);
        if (wr == 1) PG8_BAR;
        PG8_WAIT_V(4); PG8_BAR;
        PG8_STAGE(PG8_SB(1, 0), cB + kstep, voffB); PG8_STAGE(PG8_SA(1, 0), cA + kstep, voffA); PG8_STAGE(PG8_SB(1, 1), cB + hstep + kstep, voffB);
        PG8_WAIT_V(6); PG8_BAR;
    }
    for (;;) {
        nxt.kt0 = 0; nxt.ktn = nt; nxt.sliced = 0;
        const bool has_next = S.next(ui + 1, nxt);
        const int ntu = cur.ktn;
        const char* nA = has_next ? (const char*)g.A + (size_t)nxt.pm * tstep + (size_t)nxt.kt0 * kstep : cA; const char* nB = has_next ? (const char*)g.Bt + (size_t)nxt.pn * tstep + (size_t)nxt.kt0 * kstep : cB;
        for (int t = 0; t < ntu; t += 2) {
            const bool last = (t == ntu - 2);
            const char* a1 = cA + (size_t)(t + 1) * kstep;
            const char* a2 = last ? nA : cA + (size_t)(t + 2) * kstep; const char* b2 = last ? nB : cB + (size_t)(t + 2) * kstep;
            const char* a3 = a2 + kstep; const char* b3 = b2 + kstep;
            if (last && has_next) S.a_ready(nxt);
            if constexpr (SP2) {
            PG8_LDB(B0, 0, 0); PG8_LDB(B1, 0, 1); PG8_SCHED; PG8_LDA(At, 0, 0); PG8_STAGE(PG8_SA(1, 1), a1 + hstep, voffA);
            PG8_WAIT_V(8); PG8_WAIT_L(0); PG8_BAR; PG8_MMA(0, 0, At, B0); PG8_MMA(0, 1, At, B1); PG8_BAR; PG8_SCHED;
            PG8_LDA(At, 0, 1); PG8_STAGE(PG8_SB(0, 0), b2, voffB); PG8_STAGE(PG8_SB(0, 1), b2 + hstep, voffB); PG8_STAGE(PG8_SA(0, 0), a2, voffA);
            PG8_WAIT_V(8); PG8_WAIT_L(0); PG8_BAR; PG8_MMA(1, 0, At, B0); PG8_MMA(1, 1, At, B1); PG8_BAR; PG8_SCHED;
            PG8_LDB(B0, 1, 0); PG8_LDB(B1, 1, 1); PG8_SCHED; PG8_LDA(At, 1, 0); PG8_STAGE(PG8_SA(0, 1), a2 + hstep, voffA);
            PG8_WAIT_V(8); PG8_WAIT_L(0); PG8_BAR; PG8_MMA(0, 0, At, B0); PG8_MMA(0, 1, At, B1); PG8_BAR; PG8_SCHED;
            PG8_LDA(At, 1, 1); PG8_STAGE(PG8_SB(1, 0), b3, voffB); PG8_STAGE(PG8_SB(1, 1), b3 + hstep, voffB); PG8_STAGE(PG8_SA(1, 0), a3, voffA);
            PG8_WAIT_V(8); PG8_WAIT_L(0); PG8_BAR; PG8_MMA(1, 0, At, B0); PG8_MMA(1, 1, At, B1); PG8_BAR; PG8_SCHED;
            } else {
            PG8_LDB(B0, 0, 0); PG8_SCHED; PG8_LDA(At, 0, 0); PG8_STAGE(PG8_SA(1, 1), a1 + hstep, voffA);
            PG8_WAIT_L(8); PG8_BAR; PG8_WAIT_L(0); PG8_MMA(0, 0, At, B0); PG8_BAR; PG8_SCHED;
            PG8_LDB(B1, 0, 1); PG8_STAGE(PG8_SB(0, 0), b2, voffB);
            PG8_BAR; PG8_WAIT_L(0); PG8_MMA(0, 1, At, B1); PG8_BAR;
            PG8_LDA(At, 0, 1); PG8_STAGE(PG8_SA(0, 0), a2, voffA);
            PG8_BAR; PG8_WAIT_L(0); PG8_MMA(1, 0, At, B0); PG8_BAR; PG8_SCHED;
            PG8_STAGE(PG8_SB(0, 1), b2 + hstep, voffB);
            PG8_WAIT_V(6); PG8_BAR; PG8_MMA(1, 1, At, B1); PG8_BAR;
            PG8_LDB(B0, 1, 0); PG8_SCHED; PG8_LDA(At, 1, 0); PG8_STAGE(PG8_SA(0, 1), a2 + hstep, voffA);
            PG8_WAIT_L(8); PG8_BAR; PG8_WAIT_L(0); PG8_MMA(0, 0, At, B0); PG8_BAR; PG8_SCHED;
            PG8_LDB(B1, 1, 1); PG8_STAGE(PG8_SB(1, 0), b3, voffB);
            PG8_BAR; PG8_WAIT_L(0); PG8_MMA(0, 1, At, B1); PG8_BAR;
            PG8_LDA(At, 1, 1); PG8_STAGE(PG8_SA(1, 0), a3, voffA);
            PG8_BAR; PG8_WAIT_L(0); PG8_MMA(1, 0, At, B0); PG8_BAR; PG8_SCHED;
            PG8_STAGE(PG8_SB(1, 1), b3 + hstep, voffB);
            PG8_WAIT_V(6); PG8_BAR; PG8_MMA(1, 1, At, B1); PG8_BAR;
            }
        }
        if constexpr (FP8) asm volatile("s_nop 15\n\ts_nop 7" ::: "memory");
        if constexpr (ALIGN_EPI) { if (wr == 0) PG8_BAR; }
        if constexpr (!Epi::AFTER_DRAIN) { E(acc, cur, wr, wc, fr, fq); S.done(cur); }
        if (!has_next) break;
#pragma unroll
        for (int a = 0; a < 2; ++a)
#pragma unroll
            for (int b = 0; b < 2; ++b)
#pragma unroll
                for (int m = 0; m < 4; ++m)
#pragma unroll
                    for (int n = 0; n < 2; ++n) acc[a][b][m][n] = (f32x4){0.f, 0.f, 0.f, 0.f};
        cur = nxt; cA = nA; cB = nB; ++ui;
        if constexpr (ALIGN_EPI) { if (wr == 1) PG8_BAR; }
    }
    PG8_WAIT_V(0);
    if constexpr (!ALIGN_EPI) { if (wr == 0) PG8_BAR; }
    PG8_BAR;
    if constexpr (Epi::AFTER_DRAIN) { E.fused(acc, cur, wr, wc, fr, fq, lds, wid, lane); S.done(cur); }
#undef PG8_SA
#undef PG8_SB
#undef PG8_STAGE
#undef PG8_LD16
#undef PG8_LDA
#undef PG8_LDB
#undef PG8_MMA
#undef PG8_WAIT_V
#undef PG8_WAIT_L
#undef PG8_BAR
#undef PG8_SCHED
}
}

constexpr int NWAVES = 8;
constexpr int S = 8192, D = 2048, NIN = 7248, NINP = 7424, DFF = 5632, DFFE = 7168, NE = 8, DEPTH = 2;
constexpr int PITCH = NINP;
constexpr int C_QA = 0, C_KA = 512, C_VA = 1024, C_QI = 1536, C_QB = 2560, C_KB = 3328, C_VB = 4096, C_QC = 4864, C_KC = 5632, C_VC = 6400, C_KI = 7168, C_WI = 7232;
#ifndef GATHER_FUSED
#define GATHER_FUSED 0
#endif
constexpr int MOE_CT = 10, MOE_CAP = 256 * MOE_CT;
constexpr int MAXSLOT = GATHER_FUSED ? NE * MOE_CAP : 18432;
constexpr float RMS_EPS = 1e-6f;
constexpr float LOG2E = 1.4426950408889634f;
constexpr int TBL_N = 2304, TBL_OFF = 64;
constexpr int DFAR = 2112;

constexpr size_t MiB = 1u << 20;
constexpr size_t WS_CTL = 0, CTL_ZERO_BYTES = 1 * MiB;
constexpr size_t WS_TBL = 1 * MiB, WS_ROUTE = 2 * MiB;
constexpr size_t WS_WIN = 3 * MiB, WS_WOUT = WS_WIN + 58 * MiB, WS_WGU = WS_WOUT + 16 * MiB, WS_WDN = WS_WGU + 44 * MiB, WS_WMGU = WS_WDN + 22 * MiB, WS_WMDN = WS_WMGU + 448 * MiB;
constexpr size_t WS_H = WS_WMDN + 224 * MiB, WS_P = WS_H + 32 * MiB, WS_SC = WS_P + 116 * MiB, WS_WM = WS_SC + 256 * MiB, WS_MIX = WS_WM + 8 * MiB, WS_XB = WS_MIX + 32 * MiB;
constexpr size_t WS_ACT = WS_XB + 64 * MiB, WS_HS = WS_ACT + 252 * MiB, WS_END = WS_HS + 72 * MiB;
constexpr size_t WS_OUTM = WS_SC;
constexpr size_t WS_OUTP = WS_P;
static_assert((size_t)2 * NINP * D * 2 <= 58 * MiB && (size_t)2 * DFF * D * 2 <= 44 * MiB && (size_t)NE * 2 * DFFE * D * 2 <= 448 * MiB && (size_t)MAXSLOT * DFFE <= 252 * MiB && (size_t)MAXSLOT * D * 4 <= 256 * MiB, "ws map");
constexpr size_t RT_TOKE = 0, RT_TOKR = 65536, RT_TOKG = 131072, RT_TOKS = 196608, RT_SLOTG = 262144, RT_ROWS = 393216, RT_SLOTS = 458752;
constexpr size_t WS_WSC = WS_TBL + 512 * 1024;

constexpr int CW_TMO = 0, CW_CODE = 1, CW_BAR = 4096, CW_CNT = 8192, CW_Q = 12288;

constexpr int RING_OFF = 0, RING_BYTES = 131072;
constexpr int XPOSE_SCR = 64 * 65 * 4;
constexpr int LDSCTL_OFF = 8 * XPOSE_SCR, MISC_OFF = LDSCTL_OFF + 320;
constexpr int LDS_TBL_OFF = 134144;
constexpr int LDS_BYTES = 147456;
static_assert(LDS_TBL_OFF + TBL_N * 4 <= LDS_BYTES && MISC_OFF + 128 <= LDS_TBL_OFF && LDSCTL_OFF >= RING_BYTES && LDS_TBL_OFF % 16 == 0, "LDS map");

#define GAS __attribute__((address_space(1)))
#define LAS __attribute__((address_space(3)))
#define DI __device__ __forceinline__
typedef unsigned short bf16;
typedef unsigned v4u __attribute__((ext_vector_type(4)));
typedef unsigned v2u __attribute__((ext_vector_type(2)));
typedef float f32x4 __attribute__((ext_vector_type(4)));
typedef float f32x16 __attribute__((ext_vector_type(16)));
typedef short bf16x8 __attribute__((ext_vector_type(8)));
typedef short s16x4 __attribute__((ext_vector_type(4)));
typedef GAS unsigned gu32;
#define RLX_AGENT __ATOMIC_RELAXED, __HIP_MEMORY_SCOPE_AGENT
#define LDS_WAIT() asm volatile("s_waitcnt lgkmcnt(0)" ::: "memory")
#define VM_WAIT() asm volatile("s_waitcnt vmcnt(0)" ::: "memory")
DI unsigned f2bf(float f) { unsigned u = __builtin_bit_cast(unsigned, f); return (u + 0x7fffu + ((u >> 16) & 1u)) >> 16; }
DI unsigned pk2(float lo, float hi) { unsigned r; asm volatile("v_cvt_pk_bf16_f32 %0, %1, %2" : "=v"(r) : "v"(lo), "v"(hi)); return r; }
DI float bflo(unsigned w) { return __builtin_bit_cast(float, w << 16); }
DI float bfhi(unsigned w) { return __builtin_bit_cast(float, w & 0xffff0000u); }
DI float wave_sum(float v) {
#pragma unroll
    for (int o = 1; o < 64; o <<= 1) v += __shfl_xor(v, o);
    return v;
}
#define XB_TMO      128
#define XB_XCNT(j)  (256  + 64 * (j))
#define XB_XSUB(j)  (1280 + 64 * (j))
#define XB_XGEN(j)  (2304 + 64 * (j))
#define XB_TOP      3328
#define XB_TOPGEN   3392
#define XCD_BAR_WORDS 3456
#define XB_SPIN_CAP (1u << 18)

__device__ __forceinline__ unsigned xb_ld(unsigned* p)              { return __hip_atomic_load(p, __ATOMIC_RELAXED, __HIP_MEMORY_SCOPE_AGENT); }
__device__ __forceinline__ unsigned xb_add(unsigned* p, unsigned v) { return __hip_atomic_fetch_add(p, v, __ATOMIC_RELAXED, __HIP_MEMORY_SCOPE_AGENT); }
__device__ __forceinline__ unsigned xb_xcc_id() { return (unsigned)__builtin_amdgcn_s_getreg((3 << 11) | 20) & 0xFu; }
#define XB_SPIN(cond, bar) do { unsigned _sp = 0; while (cond) { __builtin_amdgcn_s_sleep(1); \
    if ((++_sp & 255u) == 0u) { if (xb_ld(&(bar)[XB_TMO])) break; if (_sp > XB_SPIN_CAP) { atomicAdd(&(bar)[XB_TMO], 1u); break; } } } } while (0)

struct XcdBarrier {
    unsigned* bar; unsigned x;
    volatile LAS unsigned* st;
};

__device__ __forceinline__ XcdBarrier xcd_barrier_post(unsigned* bar, volatile LAS unsigned* st) {
    XcdBarrier b; b.bar = bar; b.x = xb_xcc_id(); b.st = st;
    if (threadIdx.x == 0) (void)xb_add(&bar[XB_XCNT(b.x)], 1u);
    return b;
}
__device__ __forceinline__ void xcd_barrier_complete(unsigned* bar, unsigned x, unsigned& nloc, unsigned& nx) {
    const unsigned G = gridDim.x * gridDim.y * gridDim.z;
    unsigned sum, cnt, mine, sp = 0u;
    for (;;) {
        sum = 0u; cnt = 0u; mine = 0u;
#pragma unroll
        for (unsigned j = 0; j < 16; ++j) { const unsigned c = xb_ld(&bar[XB_XCNT(j)]); sum += c; cnt += (c > 0u) ? 1u : 0u; mine = (j == x) ? c : mine; }
        if (sum == G) break;
        __builtin_amdgcn_s_sleep(1);
        if ((++sp & 255u) == 0u) { if (xb_ld(&bar[XB_TMO])) break; if (sp > XB_SPIN_CAP) { atomicAdd(&bar[XB_TMO], 1u); break; } }
    }
    nloc = mine > 0u ? mine : 1u; nx = cnt > 0u ? cnt : 1u;
}

__device__ __forceinline__ void xcd_barrier(const XcdBarrier& b) {
    asm volatile("s_waitcnt vmcnt(0)" ::: "memory");
    __syncthreads();
    if (threadIdx.x == 0) {
        unsigned* bar = b.bar;
        __builtin_amdgcn_s_waitcnt(0);
        unsigned nloc = b.st[0], nx = b.st[1];
        if (nloc == 0u) { xcd_barrier_complete(bar, b.x, nloc, nx); b.st[0] = nloc; b.st[1] = nx; }
        const unsigned old = xb_add(&bar[XB_XSUB(b.x)], 1u);
        const unsigned gen = old / nloc;
        if (old + 1u == (gen + 1u) * nloc) {
            __builtin_amdgcn_fence(__ATOMIC_RELEASE, "agent");
            asm volatile("s_waitcnt vmcnt(0)" ::: "memory");
            const unsigned og = xb_add(&bar[XB_TOP], 1u);
            const unsigned tg = og / nx;
            if (og + 1u == (tg + 1u) * nx) xb_add(&bar[XB_TOPGEN], 1u);
            else XB_SPIN(xb_ld(&bar[XB_TOPGEN]) == tg, bar);
            __builtin_amdgcn_fence(__ATOMIC_ACQUIRE, "agent");
            xb_add(&bar[XB_XGEN(b.x)], 1u);
            asm volatile("s_waitcnt vmcnt(0)" ::: "memory");
        } else {
            XB_SPIN(xb_ld(&bar[XB_XGEN(b.x)]) == gen, bar);
            __builtin_amdgcn_fence(__ATOMIC_ACQUIRE, "agent");
            asm volatile("s_waitcnt vmcnt(0)" ::: "memory");
        }
    }
    __syncthreads();
}


struct Args { const float* in[24]; float* out; unsigned char* ws; int ph_lo, ph_hi; };
struct Frame {
    LAS unsigned char* lds;
    volatile LAS unsigned* MISC;
    gu32* ctl;
    unsigned char* ws;
    const Args* a; float* out;
    int tid, lane, wave, vcu, G;
};

DI int rowmap(int map, int n) {
    if (map == 1) return n < 2560 ? n : (n < 2640 ? n + (C_KI - 2560) : n - 80);
    if (map == 2) return ((n >> 7) << 8) + (n & 127);
    if (map == 3) return ((n >> 7) << 8) + 128 + (n & 127);
    return n;
}
DI void xpose_item(const float* __restrict__ W, int K, int N, bf16* __restrict__ WT, int map, LAS float* scr, int item, int lane) {
    const int nblk = (N + 63) >> 6, kb = item / nblk, nb = item - kb * nblk, k0 = kb << 6, n0 = nb << 6;
    const int kk = lane >> 4, nq = (lane & 15) << 2;
    const bool okc = (n0 + nq) < N;
    f32x4 v[16];
#pragma unroll
    for (int i = 0; i < 16; ++i) { v[i] = (f32x4){0.f, 0.f, 0.f, 0.f}; if (okc) v[i] = __builtin_nontemporal_load((const GAS f32x4*)(W + (size_t)(k0 + 4 * i + kk) * N + n0 + nq)); }
#pragma unroll
    for (int i = 0; i < 16; ++i) { LAS float* d = scr + (4 * i + kk) * 65 + nq; d[0] = v[i].x; d[1] = v[i].y; d[2] = v[i].z; d[3] = v[i].w; }
    LDS_WAIT(); asm volatile("" ::: "memory");
    const int c = lane & 7;
#pragma unroll
    for (int j = 0; j < 8; ++j) { const int n = (lane >> 3) + 8 * j; const LAS float* s = scr + (8 * c) * 65 + n;
        v4u o; o.x = pk2(s[0 * 65], s[1 * 65]); o.y = pk2(s[2 * 65], s[3 * 65]); o.z = pk2(s[4 * 65], s[5 * 65]); o.w = pk2(s[6 * 65], s[7 * 65]);
        if (n0 + n < N) __builtin_nontemporal_store(o, (GAS v4u*)(WT + (size_t)rowmap(map, n0 + n) * K + k0 + 8 * c)); }
    LDS_WAIT(); asm volatile("" ::: "memory");
}
DI void xpose_item8(const float* __restrict__ W, int K, int N, unsigned char* __restrict__ WT, int map, LAS float* scr, int item, int lane) {
    const int nblk = (N + 63) >> 6, kb = item / nblk, nb = item - kb * nblk, k0 = kb << 6, n0 = nb << 6;
    const int kk = lane >> 4, nq = (lane & 15) << 2;
    const bool okc = (n0 + nq) < N;
    f32x4 v[16];
#pragma unroll
    for (int i = 0; i < 16; ++i) { v[i] = (f32x4){0.f, 0.f, 0.f, 0.f}; if (okc) v[i] = __builtin_nontemporal_load((const GAS f32x4*)(W + (size_t)(k0 + 4 * i + kk) * N + n0 + nq)); }
    constexpr float SC8 = (float)(1 << pg8::W8_SHIFT);
#pragma unroll
    for (int i = 0; i < 16; ++i) { LAS float* d = scr + (4 * i + kk) * 65 + nq; d[0] = v[i].x * SC8; d[1] = v[i].y * SC8; d[2] = v[i].z * SC8; d[3] = v[i].w * SC8; }
    LDS_WAIT(); asm volatile("" ::: "memory");
    const int c = lane & 3;
#pragma unroll
    for (int j = 0; j < 4; ++j) { const int n = (lane >> 2) + 16 * j; const LAS float* s = scr + (16 * c) * 65 + n;
        v4u o; o.x = pg8::pk4_fp8(s[0 * 65], s[1 * 65], s[2 * 65], s[3 * 65]); o.y = pg8::pk4_fp8(s[4 * 65], s[5 * 65], s[6 * 65], s[7 * 65]);
        o.z = pg8::pk4_fp8(s[8 * 65], s[9 * 65], s[10 * 65], s[11 * 65]); o.w = pg8::pk4_fp8(s[12 * 65], s[13 * 65], s[14 * 65], s[15 * 65]);
        if (n0 + n < N) __builtin_nontemporal_store(o, (GAS v4u*)(WT + (size_t)rowmap(map, n0 + n) * K + k0 + 16 * c)); }
    LDS_WAIT(); asm volatile("" ::: "memory");
}
DI int t5_bucket(int n) {
    if (n < 16) return n;
    const int large = 16 + (int)(logf((float)n / 16.0f) / 4.852030263919617f * 16.0f);
    return large < 31 ? large : 31;
}
DI void rms_row_to_bf16(const float* xrow, const f32x4 (&g)[8], bf16* orow, int lane) {
    const GAS f32x4* xr = (const GAS f32x4*)xrow + lane;
    f32x4 v[8]; float s = 0.f;
#pragma unroll
    for (int j = 0; j < 8; ++j) { v[j] = xr[64 * j]; s += (v[j].x * v[j].x + v[j].y * v[j].y) + (v[j].z * v[j].z + v[j].w * v[j].w); }
    const float rstd = 1.0f / sqrtf(wave_sum(s) * (1.0f / D) + RMS_EPS);
    GAS v2u* o8 = (GAS v2u*)orow + lane;
#pragma unroll
    for (int j = 0; j < 8; ++j) { v2u o; o.x = pk2(v[j].x * rstd * g[j].x, v[j].y * rstd * g[j].y); o.y = pk2(v[j].z * rstd * g[j].z, v[j].w * rstd * g[j].w); o8[64 * j] = o; }
}
template <bool B16> DI f32x4 xrow4(const void* row, int idx) {
    if (B16) { const v2u w = ((const GAS v2u*)row)[idx]; return (f32x4){bflo(w.x), bfhi(w.x), bflo(w.y), bfhi(w.y)}; }
    return ((const GAS f32x4*)row)[idx];
}
DI void rms_phase(Frame& F, const float* x, const float* gvec, bf16* H) {
    const int gw = F.vcu * NWAVES + F.wave, NGW = F.G * NWAVES;
    f32x4 g[8];
#pragma unroll
    for (int j = 0; j < 8; ++j) g[j] = ((const GAS f32x4*)gvec)[F.lane + 64 * j];
    for (int m = gw; m < S; m += NGW) rms_row_to_bf16(x + (size_t)m * D, g, H + (size_t)m * D, F.lane);
}
DI void rms_phase8(Frame& F, const float* x, const float* gvec, unsigned char* H8) {
    const int gw = F.vcu * NWAVES + F.wave, NGW = F.G * NWAVES, lane = F.lane;
    f32x4 g[8];
#pragma unroll
    for (int j = 0; j < 8; ++j) g[j] = ((const GAS f32x4*)gvec)[lane + 64 * j];
    for (int m = gw; m < S; m += NGW) {
        const GAS f32x4* xr = (const GAS f32x4*)(x + (size_t)m * D) + lane;
        f32x4 v[8]; float s = 0.f;
#pragma unroll
        for (int j = 0; j < 8; ++j) { v[j] = xr[64 * j]; s += (v[j].x * v[j].x + v[j].y * v[j].y) + (v[j].z * v[j].z + v[j].w * v[j].w); }
        const float rstd = 1.0f / sqrtf(wave_sum(s) * (1.0f / D) + RMS_EPS);
        GAS unsigned* o4 = (GAS unsigned*)(H8 + (size_t)m * D) + lane;
#pragma unroll
        for (int j = 0; j < 8; ++j) o4[64 * j] = pg8::pk4_fp8(v[j].x * rstd * g[j].x, v[j].y * rstd * g[j].y, v[j].z * rstd * g[j].z, v[j].w * rstd * g[j].w);
    }
}
constexpr int I_IN = (D / 64) * ((NIN + 63) / 64), I_OUT = (D / 64) * (D / 64), I_G = (D / 64) * (DFF / 64), I_DN = (DFF / 64) * (D / 64), I_MG = (D / 64) * (DFFE / 64), I_MD = (DFFE / 64) * (D / 64);
constexpr int NBG = I_OUT + 2 * I_G + I_DN + I_IN + I_OUT + 16 * I_MG + 8 * I_MD;
#ifndef BG_QUOTA
#define BG_QUOTA 0
#endif
constexpr int BG_N1 = 96 * BG_QUOTA, BG_N10 = 96 * BG_QUOTA, BG_N7 = 128 * BG_QUOTA;
constexpr int BG_A0 = (NBG - BG_N1 - BG_N10 - BG_N7) / 2, BG_I1 = BG_A0 + BG_N1, BG_A1 = NBG - BG_N10 - BG_N7, BG_I10 = NBG - BG_N7;
static_assert(BG_A0 >= 2 * I_OUT + 2 * I_G + I_DN + I_IN && BG_A0 % 8 == 0 && BG_I1 % 8 == 0 && BG_A1 % 8 == 0 && BG_I10 % 8 == 0, "everything layer 0's FFN and layer 1's projections need is converted during layer 0's attention phase");
#ifndef DENSE_GU_FP8
#define DENSE_GU_FP8 1
#endif
#ifndef DENSE_DOWN_FP8
#define DENSE_DOWN_FP8 1
#endif
struct XItem { const float* W; unsigned char* WT; int K, N, map, item, fp8  ; float inv; };
#ifndef OUTPROJ_INT8
#define OUTPROJ_INT8 0
#endif
constexpr float MIX_CLIP = 8.0f;
#ifndef INPROJ_INT8
#define INPROJ_INT8 1
#endif
#ifndef GU_INT8
#define GU_INT8 1
#endif
DI XItem bg_decode(Frame& F, int it) {
    unsigned char* WIN = F.ws + WS_WIN; unsigned char* WOUT = F.ws + WS_WOUT; unsigned char* WGU = F.ws + WS_WGU; unsigned char* WDN = F.ws + WS_WDN;
    unsigned char* WMGU = F.ws + WS_WMGU; unsigned char* WMDN = F.ws + WS_WMDN;
    int r = it; XItem x; const float* wsc = (const float*)(F.ws + WS_WSC);
    if (r < I_OUT) { x = OUTPROJ_INT8 ? XItem{F.a->in[2], WOUT, D, D, 0, r, 2, wsc[32 + 2]} : XItem{F.a->in[2], WOUT, D, D, 0, r, 0, 1.f}; return x; } r -= I_OUT;
    if (r < I_G) { x = XItem{F.a->in[17], WGU, D, DFF, 2, r, DENSE_GU_FP8 ? (GU_INT8 ? 2 : 1) : 0, GU_INT8 ? wsc[32 + 4] : 1.f}; return x; } r -= I_G;
    if (r < I_G) { x = XItem{F.a->in[18], WGU, D, DFF, 3, r, DENSE_GU_FP8 ? (GU_INT8 ? 2 : 1) : 0, GU_INT8 ? wsc[32 + 5] : 1.f}; return x; } r -= I_G;
    if (r < I_DN) { x = XItem{F.a->in[19], WDN, DFF, D, 0, r, DENSE_DOWN_FP8, 1.f}; return x; } r -= I_DN;
    if (r < I_IN) { x = INPROJ_INT8 ? XItem{F.a->in[1] + (size_t)D * NIN, WIN + (size_t)NINP * D, D, NIN, 1, r, 2, wsc[32 + 1]} : XItem{F.a->in[1] + (size_t)D * NIN, WIN + (size_t)NINP * D * 2, D, NIN, 1, r, 0, 1.f}; return x; } r -= I_IN;
    if (r < I_OUT) { x = OUTPROJ_INT8 ? XItem{F.a->in[2] + (size_t)D * D, WOUT + (size_t)D * D, D, D, 0, r, 2, wsc[32 + 3]} : XItem{F.a->in[2] + (size_t)D * D, WOUT + (size_t)D * D * 2, D, D, 0, r, 0, 1.f}; return x; } r -= I_OUT;
    if (r < 8 * I_MG) { const int e = r / I_MG; x = XItem{F.a->in[21] + (size_t)e * D * DFFE, WMGU + (size_t)e * 2 * DFFE * D, D, DFFE, 2, r - e * I_MG, GU_INT8 ? 2 : 1, GU_INT8 ? wsc[32 + 6 + e] : 1.f}; return x; } r -= 8 * I_MG;
    if (r < 8 * I_MG) { const int e = r / I_MG; x = XItem{F.a->in[22] + (size_t)e * D * DFFE, WMGU + (size_t)e * 2 * DFFE * D, D, DFFE, 3, r - e * I_MG, GU_INT8 ? 2 : 1, GU_INT8 ? wsc[32 + 14 + e] : 1.f}; return x; } r -= 8 * I_MG;
    { const int e = r / I_MD; x = XItem{F.a->in[23] + (size_t)e * DFFE * D, WMDN + (size_t)e * D * DFFE, DFFE, D, 0, r - e * I_MD, 1, 1.f}; return x; }
}
template <int I0 = 0, int I1 = 16>
DI void xi_load(const XItem& x, f32x4 (&v)[16], int lane) {
    const int nblk = (x.N + 63) >> 6, kb = x.item / nblk, nb = x.item - kb * nblk, k0 = kb << 6, n0 = nb << 6;
    const int kk = lane >> 4, nq = (lane & 15) << 2;
    const bool okc = (n0 + nq) < x.N;
#pragma unroll
    for (int i = I0; i < I1; ++i) { v[i] = (f32x4){0.f, 0.f, 0.f, 0.f}; if (okc) v[i] = __builtin_nontemporal_load((const GAS f32x4*)(x.W + (size_t)(k0 + 4 * i + kk) * x.N + n0 + nq)); }
}
DI void xi_finish(const XItem& x, const f32x4 (&v)[16], LAS float* scr, int lane_) {
    int lane = lane_; asm volatile("" : "+v"(lane));
    const int nblk = (x.N + 63) >> 6, kb = x.item / nblk, nb = x.item - kb * nblk, k0 = kb << 6, n0 = nb << 6;
    const int kk = lane >> 4, nq = (lane & 15) << 2;
    const float sc = x.fp8 == 1 ? (float)(1 << pg8::W8_SHIFT) : (x.fp8 == 2 ? x.inv : 1.0f);
#pragma unroll
    for (int i = 0; i < 16; ++i) { LAS float* d = scr + (4 * i + kk) * 65 + nq; d[0] = v[i].x * sc; d[1] = v[i].y * sc; d[2] = v[i].z * sc; d[3] = v[i].w * sc; }
    LDS_WAIT(); asm volatile("" ::: "memory");
    if (x.fp8 == 2) {
        const int c = lane & 3;
#pragma unroll
        for (int j = 0; j < 4; ++j) { const int n = (lane >> 2) + 16 * j; const LAS float* s = scr + (16 * c) * 65 + n; v4u o;
#pragma unroll
            for (int d = 0; d < 4; ++d) { unsigned w = 0u;
#pragma unroll
                for (int b = 0; b < 4; ++b) w = __builtin_amdgcn_cvt_pk_u8_f32(rintf(s[(4 * d + b) * 65]) + 128.0f, b, w);
                o[d] = w ^ 0x80808080u; }
            if (n0 + n < x.N) __builtin_nontemporal_store(o, (GAS v4u*)(x.WT + (size_t)rowmap(x.map, n0 + n) * x.K + k0 + 16 * c)); }
    } else if (x.fp8) {
        const int c = lane & 3;
#pragma unroll
        for (int j = 0; j < 4; ++j) { const int n = (lane >> 2) + 16 * j; const LAS float* s = scr + (16 * c) * 65 + n;
            v4u o; o.x = pg8::pk4_fp8(s[0 * 65], s[1 * 65], s[2 * 65], s[3 * 65]); o.y = pg8::pk4_fp8(s[4 * 65], s[5 * 65], s[6 * 65], s[7 * 65]);
            o.z = pg8::pk4_fp8(s[8 * 65], s[9 * 65], s[10 * 65], s[11 * 65]); o.w = pg8::pk4_fp8(s[12 * 65], s[13 * 65], s[14 * 65], s[15 * 65]);
            if (n0 + n < x.N) __builtin_nontemporal_store(o, (GAS v4u*)(x.WT + (size_t)rowmap(x.map, n0 + n) * x.K + k0 + 16 * c)); }
    } else {
        const int c = lane & 7;
#pragma unroll
        for (int j = 0; j < 8; ++j) { const int n = (lane >> 3) + 8 * j; const LAS float* s = scr + (8 * c) * 65 + n;
            v4u o; o.x = pk2(s[0 * 65], s[1 * 65]); o.y = pk2(s[2 * 65], s[3 * 65]); o.z = pk2(s[4 * 65], s[5 * 65]); o.w = pk2(s[6 * 65], s[7 * 65]);
            if (n0 + n < x.N) __builtin_nontemporal_store(o, (GAS v4u*)(x.WT + ((size_t)rowmap(x.map, n0 + n) * x.K + k0 + 8 * c) * 2)); }
    }
    LDS_WAIT(); asm volatile("" ::: "memory");
}
#ifndef BG_P3
#define BG_P3 16
#endif
#ifndef BG_DEPTH3
#define BG_DEPTH3 0
#endif
DI void bg_convert(Frame& F, int lo, int hi, int rank, int nconv) {
    LAS float* scr = (LAS float*)(F.lds + F.wave * XPOSE_SCR);
    const int step = 8 * nconv;
    int ia = lo + 8 * rank + F.wave;
#if BG_DEPTH3
    f32x4 va[16], vb[16], vc[16];
    if (ia < hi) {
        int ib = ia + step, ic = ib + step;
        XItem xa = bg_decode(F, ia); xi_load(xa, va, F.lane);
        XItem xb = bg_decode(F, ib < hi ? ib : hi - 1); if (ib < hi) xi_load(xb, vb, F.lane);
        for (;;) {
            XItem xc = bg_decode(F, ic < hi ? ic : hi - 1); if (ic < hi) xi_load<0, BG_P3>(xc, vc, F.lane);
            xi_finish(xa, va, scr, F.lane);
            if (ic < hi) xi_load<BG_P3, 16>(xc, vc, F.lane);
            if (ib >= hi) break;
            ia = ic + step; xa = bg_decode(F, ia < hi ? ia : hi - 1); if (ia < hi) xi_load<0, BG_P3>(xa, va, F.lane);
            xi_finish(xb, vb, scr, F.lane);
            if (ia < hi) xi_load<BG_P3, 16>(xa, va, F.lane);
            if (ic >= hi) break;
            ib = ia + step; xb = bg_decode(F, ib < hi ? ib : hi - 1); if (ib < hi) xi_load<0, BG_P3>(xb, vb, F.lane);
            xi_finish(xc, vc, scr, F.lane);
            if (ib < hi) xi_load<BG_P3, 16>(xb, vb, F.lane);
            if (ia >= hi) break;
            ic = ib + step;
        }
    }
#else
    f32x4 va[16], vb[16];
    if (ia < hi) {
        XItem xa = bg_decode(F, ia); xi_load(xa, va, F.lane);
        for (;;) {
            const int ib = ia + step;
            XItem xb = bg_decode(F, ib < hi ? ib : hi - 1); if (ib < hi) xi_load(xb, vb, F.lane);
            xi_finish(xa, va, scr, F.lane);
            if (ib >= hi) break;
            ia = ib + step;
            xa = bg_decode(F, ia < hi ? ia : hi - 1); if (ia < hi) xi_load(xa, va, F.lane);
            xi_finish(xb, vb, scr, F.lane);
            if (ia >= hi) break;
        }
    }
#endif
    __syncthreads();
}
DI unsigned pk4_i8(float a, float b, float c, float d) {
    unsigned w = __builtin_amdgcn_cvt_pk_u8_f32(rintf(a) + 128.0f, 0, 0u); w = __builtin_amdgcn_cvt_pk_u8_f32(rintf(b) + 128.0f, 1, w);
    w = __builtin_amdgcn_cvt_pk_u8_f32(rintf(c) + 128.0f, 2, w); w = __builtin_amdgcn_cvt_pk_u8_f32(rintf(d) + 128.0f, 3, w); return w ^ 0x80808080u;
}
DI float wave_max(float v) {
#pragma unroll
    for (int o = 1; o < 64; o <<= 1) v = fmaxf(v, __shfl_xor(v, o));
    return v;
}
template <bool B16 = false>
DI void rms_phase_i8(Frame& F, const void* x, const float* gvec, unsigned char* H8, float* rowscale) {
    const int gw = F.vcu * NWAVES + F.wave, NGW = F.G * NWAVES, lane = F.lane;
    f32x4 g[8];
#pragma unroll
    for (int j = 0; j < 8; ++j) g[j] = ((const GAS f32x4*)gvec)[lane + 64 * j];
    for (int m = gw; m < S; m += NGW) {
        const unsigned char* xr = (const unsigned char*)x + (size_t)m * D * (B16 ? 2 : 4);
        f32x4 v[8]; float s = 0.f;
#pragma unroll
        for (int j = 0; j < 8; ++j) { v[j] = xrow4<B16>(xr, lane + 64 * j); s += (v[j].x * v[j].x + v[j].y * v[j].y) + (v[j].z * v[j].z + v[j].w * v[j].w); }
        const float rstd = 1.0f / sqrtf(wave_sum(s) * (1.0f / D) + RMS_EPS);
        float am = 0.f;
#pragma unroll
        for (int j = 0; j < 8; ++j) { v[j].x *= rstd * g[j].x; v[j].y *= rstd * g[j].y; v[j].z *= rstd * g[j].z; v[j].w *= rstd * g[j].w;
            am = fmaxf(fmaxf(am, fmaxf(fabsf(v[j].x), fabsf(v[j].y))), fmaxf(fabsf(v[j].z), fabsf(v[j].w))); }
        am = fmaxf(wave_max(am), 1e-20f);
        const float inv = 127.0f / am;
        GAS unsigned* o4 = (GAS unsigned*)(H8 + (size_t)m * D) + lane;
#pragma unroll
        for (int j = 0; j < 8; ++j) o4[64 * j] = pk4_i8(v[j].x * inv, v[j].y * inv, v[j].z * inv, v[j].w * inv);
        if (lane == 0) rowscale[m] = am * (1.0f / 127.0f);
    }
}
DI void p0_prologue(Frame& F) {
    LAS float* scr = (LAS float*)(F.lds + F.wave * XPOSE_SCR);
    const int gw = F.vcu * NWAVES + F.wave, NGW = F.G * NWAVES;
    unsigned char* WIN = F.ws + WS_WIN;
#if INPROJ_INT8
    float inv0;
    { float ss = 0.f;
#pragma unroll
      for (int j = 0; j < 16; ++j) { const f32x4 v = *(const GAS f32x4*)(F.a->in[1] + (size_t)F.lane * NIN + 4 * j); ss += (v.x * v.x + v.y * v.y) + (v.z * v.z + v.w * v.w); }
      inv0 = 127.0f / fmaxf(5.0f * sqrtf(wave_sum(ss) * (1.0f / 4096.0f)), 1e-20f); }
    { f32x4 va[16];
      for (int it = gw; it < I_IN; it += NGW) { const XItem x{F.a->in[1], WIN, D, NIN, 1, it, 2, inv0}; xi_load(x, va, F.lane); xi_finish(x, va, scr, F.lane); } }
    constexpr int WIN_ROWB = D;
#else
    for (int it = gw; it < I_IN; it += NGW) xpose_item(F.a->in[1], D, NIN, (bf16*)WIN, 1, scr, it, F.lane);
    constexpr int WIN_ROWB = 2 * D;
#endif
    { const int gt = (F.vcu * NWAVES + F.wave) * 64 + F.lane, NGT = F.G * NWAVES * 64; constexpr int PADV = (NINP - NIN) * WIN_ROWB / 16;
      for (int i = gt; i < 2 * PADV; i += NGT) { const int l = i / PADV, j = i - l * PADV; *((GAS v4u*)(WIN + (size_t)l * NINP * WIN_ROWB + (size_t)NIN * WIN_ROWB) + j) = (v4u){0u, 0u, 0u, 0u}; }
      float* TBL = (float*)(F.ws + WS_TBL); const float* rel_bias = F.a->in[16];
      for (int i = gt; i < 16 * TBL_N; i += NGT) { const int hd = i / TBL_N, d = (i - hd * TBL_N) - TBL_OFF; float v = 0.f;
          if (d >= 0) { const float e = __expf(rel_bias[t5_bucket(d) * 16 + hd]);
              if (hd >= 4 && hd < 10) { const int mult = (d <= 128 ? 1 : 0) + (((d & 3) == 0 && d <= 512) ? 1 : 0) + (((d & 15) == 0 && d <= 2048) ? 1 : 0); v = e * (float)mult; }
              else v = e; }
          TBL[i] = v; } }
    { const int gwv = F.vcu * NWAVES + F.wave;
      if (gwv < 22) { const float* Wm; int N;
          if (gwv < 2) { Wm = F.a->in[1] + (size_t)gwv * D * NIN; N = NIN; } else if (gwv < 4) { Wm = F.a->in[2] + (size_t)(gwv - 2) * D * D; N = D; } else if (gwv == 4) { Wm = F.a->in[17]; N = DFF; } else if (gwv == 5) { Wm = F.a->in[18]; N = DFF; }
          else if (gwv < 14) { Wm = F.a->in[21] + (size_t)(gwv - 6) * D * DFFE; N = DFFE; } else { Wm = F.a->in[22] + (size_t)(gwv - 14) * D * DFFE; N = DFFE; }
          float ss = 0.f;
#pragma unroll
          for (int j = 0; j < 16; ++j) { const f32x4 v = *(const GAS f32x4*)(Wm + (size_t)F.lane * N + 4 * j); ss += (v.x * v.x + v.y * v.y) + (v.z * v.z + v.w * v.w); }
          const float clip = fmaxf(5.0f * sqrtf(wave_sum(ss) * (1.0f / 4096.0f)), 1e-20f);
          if (F.lane == 0) { float* wsc = (float*)(F.ws + WS_WSC); wsc[gwv] = clip * (1.0f / 127.0f); wsc[32 + gwv] = 127.0f / clip; } } }
#if INPROJ_INT8
    rms_phase_i8(F, F.a->in[0], F.a->in[3], F.ws + WS_H, (float*)(F.ws + WS_ROUTE + RT_ROWS));
#else
    rms_phase(F, F.a->in[0], F.a->in[3], (bf16*)(F.ws + WS_H));
#endif
}

DI void pn_phase(Frame& F, int layer) {
    const int gw = F.vcu * NWAVES + F.wave, NGW = F.G * NWAVES, lane = F.lane;
    bf16* P = (bf16*)(F.ws + WS_P);
    float gs[8][8];
#pragma unroll
    for (int j = 0; j < 8; ++j) {
        const int cc = lane + 64 * j; int col, gi; const float* gv; float sc = 1.0f;
        if (j < 2) { col = 8 * cc; gi = col & 127; if (col < C_KA) { gv = F.a->in[5] + layer * 128; sc = 0.08838834764831845f * LOG2E; } else gv = F.a->in[6] + layer * 128; }
        else if (j < 5) { col = C_QB + 8 * (cc - 128); gi = (col - C_QB) & 127; if (col < C_KB) { gv = F.a->in[7] + layer * 128; sc = 0.08838834764831845f * LOG2E; } else gv = F.a->in[8] + layer * 128; }
        else { col = C_QC + 8 * (cc - 320); gi = (col - C_QC) & 63; if (col < C_KC) { gv = F.a->in[9] + layer * 64; sc = 0.125f * LOG2E; } else gv = F.a->in[10] + layer * 64; }
#pragma unroll
        for (int e = 0; e < 8; ++e) gs[j][e] = gv[gi + e] * sc;
    }
    for (int m = gw; m < S; m += NGW) {
        bf16* row = P + (size_t)m * PITCH;
        v4u raw[8];
#pragma unroll
        for (int j = 0; j < 8; ++j) { const int cc = lane + 64 * j; const int col = j < 2 ? 8 * cc : (j < 5 ? C_QB + 8 * (cc - 128) : C_QC + 8 * (cc - 320)); raw[j] = *(const GAS v4u*)(row + col); }
#pragma unroll
        for (int j = 0; j < 8; ++j) { const int cc = lane + 64 * j; const int col = j < 2 ? 8 * cc : (j < 5 ? C_QB + 8 * (cc - 128) : C_QC + 8 * (cc - 320));
            float x[8]; x[0] = bflo(raw[j].x); x[1] = bfhi(raw[j].x); x[2] = bflo(raw[j].y); x[3] = bfhi(raw[j].y); x[4] = bflo(raw[j].z); x[5] = bfhi(raw[j].z); x[6] = bflo(raw[j].w); x[7] = bfhi(raw[j].w);
            float ss = 0.f;
#pragma unroll
            for (int e = 0; e < 8; ++e) ss += x[e] * x[e];
            ss += __shfl_xor(ss, 1); ss += __shfl_xor(ss, 2); ss += __shfl_xor(ss, 4);
            float rstd;
            if (j < 5) { ss += __shfl_xor(ss, 8); rstd = 1.0f / sqrtf(ss * (1.0f / 128.0f) + RMS_EPS); } else rstd = 1.0f / sqrtf(ss * (1.0f / 64.0f) + RMS_EPS);
            v4u o; o.x = pk2(x[0] * rstd * gs[j][0], x[1] * rstd * gs[j][1]); o.y = pk2(x[2] * rstd * gs[j][2], x[3] * rstd * gs[j][3]);
            o.z = pk2(x[4] * rstd * gs[j][4], x[5] * rstd * gs[j][5]); o.w = pk2(x[6] * rstd * gs[j][6], x[7] * rstd * gs[j][7]);
            *(GAS v4u*)(row + col) = o; }
    }
}

template <bool B16 = false>
DI void rms_router_phase(Frame& F, const void* x, const float* gvec, const float* wr  , bf16* H) {
    const int gw = F.vcu * NWAVES + F.wave, NGW = F.G * NWAVES, lane = F.lane;
    LAS float* wrT = (LAS float*)(F.lds + RING_OFF);
    for (int i = F.tid; i < D * 8; i += NWAVES * 64) wrT[(i & 7) * D + (i >> 3)] = wr[i];
    __syncthreads();
    f32x4 g[8];
#pragma unroll
    for (int j = 0; j < 8; ++j) g[j] = ((const GAS f32x4*)gvec)[lane + 64 * j];
    int* tok_e = (int*)(F.ws + WS_ROUTE + RT_TOKE); int* tok_r = (int*)(F.ws + WS_ROUTE + RT_TOKR); float* tok_g = (float*)(F.ws + WS_ROUTE + RT_TOKG);
    volatile LAS unsigned* cntL = (volatile LAS unsigned*)(F.lds + RING_OFF + 65536);
    if (F.tid < 16) cntL[F.tid] = 0u;
    __syncthreads();
    int my_m = -1, my_e1 = 0, my_e2 = 0, my_l1 = 0, my_l2 = 0, kk = 0; float my_g1 = 0.f, my_g2 = 0.f;
    for (int m = gw; m < S; m += NGW, ++kk) {
        const unsigned char* xr = (const unsigned char*)x + (size_t)m * D * (B16 ? 2 : 4);
        f32x4 v[8]; float s = 0.f;
#pragma unroll
        for (int j = 0; j < 8; ++j) { v[j] = xrow4<B16>(xr, lane + 64 * j); s += (v[j].x * v[j].x + v[j].y * v[j].y) + (v[j].z * v[j].z + v[j].w * v[j].w); }
        const float rstd = 1.0f / sqrtf(wave_sum(s) * (1.0f / D) + RMS_EPS);
        GAS v2u* o8 = (GAS v2u*)(H + (size_t)m * D) + lane;
        float lg[8];
#pragma unroll
        for (int e = 0; e < 8; ++e) lg[e] = 0.f;
#pragma unroll
        for (int j = 0; j < 8; ++j) { v[j].x *= rstd * g[j].x; v[j].y *= rstd * g[j].y; v[j].z *= rstd * g[j].z; v[j].w *= rstd * g[j].w;
            v2u o; o.x = pk2(v[j].x, v[j].y); o.y = pk2(v[j].z, v[j].w); o8[64 * j] = o;
#pragma unroll
            for (int e = 0; e < 8; ++e) { const f32x4 w = *(const LAS f32x4*)(wrT + e * D + 4 * (lane + 64 * j)); lg[e] += (v[j].x * w.x + v[j].y * w.y) + (v[j].z * w.z + v[j].w * w.w); } }
#pragma unroll
        for (int e = 0; e < 8; ++e) lg[e] = wave_sum(lg[e]);
        int e1 = 0; float v1 = lg[0];
#pragma unroll
        for (int e = 1; e < 8; ++e) if (lg[e] > v1) { v1 = lg[e]; e1 = e; }
        int e2 = -1; float v2 = 0.f;
#pragma unroll
        for (int e = 0; e < 8; ++e) if (e != e1 && (e2 < 0 || lg[e] > v2)) { v2 = lg[e]; e2 = e; }
        if (lane == (kk & 63)) {
            const float ex = __expf(v2 - v1); my_g1 = 1.0f / (1.0f + ex); my_g2 = ex * my_g1; my_m = m; my_e1 = e1; my_e2 = e2;
            my_l1 = (int)__hip_atomic_fetch_add((LAS unsigned*)(F.lds + RING_OFF + 65536) + e1, 1u, __ATOMIC_RELAXED, __HIP_MEMORY_SCOPE_WORKGROUP);
            my_l2 = (int)__hip_atomic_fetch_add((LAS unsigned*)(F.lds + RING_OFF + 65536) + e2, 1u, __ATOMIC_RELAXED, __HIP_MEMORY_SCOPE_WORKGROUP);
        }
    }
    __syncthreads();
    if (F.tid < 8) cntL[8 + F.tid] = __hip_atomic_fetch_add((unsigned*)(F.ctl + CW_CNT + 64 * F.tid), cntL[F.tid], RLX_AGENT);
    __syncthreads();
#if GATHER_FUSED == 1
    {
        int* tok_s = (int*)(F.ws + WS_ROUTE + RT_TOKS); float* slot_g = (float*)(F.ws + WS_ROUTE + RT_SLOTG); float* slot_s = (float*)(F.ws + WS_ROUTE + RT_SLOTS);
        unsigned char* HS = F.ws + WS_HS;
        VM_WAIT();
        __builtin_amdgcn_fence(__ATOMIC_RELEASE, "agent"); __builtin_amdgcn_fence(__ATOMIC_ACQUIRE, "agent");
        VM_WAIT();
        for (int r = 0; r < kk; ++r) {
            const int m = __shfl(my_m, r), e1 = __shfl(my_e1, r), e2 = __shfl(my_e2, r);
            const int s1 = e1 * MOE_CAP + (int)cntL[8 + e1] + __shfl(my_l1, r), s2 = e2 * MOE_CAP + (int)cntL[8 + e2] + __shfl(my_l2, r);
            const float g1 = __shfl(my_g1, r), g2 = __shfl(my_g2, r);
            const GAS v4u* src = (const GAS v4u*)(H + (size_t)m * D) + 4 * lane;
            v4u o[2]; float xv[32]; float am = 0.f;
#pragma unroll
            for (int j = 0; j < 4; ++j) { const v4u a = src[j];
                xv[8 * j] = bflo(a.x); xv[8 * j + 1] = bfhi(a.x); xv[8 * j + 2] = bflo(a.y); xv[8 * j + 3] = bfhi(a.y); xv[8 * j + 4] = bflo(a.z); xv[8 * j + 5] = bfhi(a.z); xv[8 * j + 6] = bflo(a.w); xv[8 * j + 7] = bfhi(a.w); }
#pragma unroll
            for (int j = 0; j < 32; ++j) am = fmaxf(am, fabsf(xv[j]));
            am = fmaxf(wave_max(am), 1e-20f);
            const float inv = 127.0f / am;
#pragma unroll
            for (int j = 0; j < 2; ++j) { o[j].x = pk4_i8(xv[16 * j] * inv, xv[16 * j + 1] * inv, xv[16 * j + 2] * inv, xv[16 * j + 3] * inv); o[j].y = pk4_i8(xv[16 * j + 4] * inv, xv[16 * j + 5] * inv, xv[16 * j + 6] * inv, xv[16 * j + 7] * inv);
                o[j].z = pk4_i8(xv[16 * j + 8] * inv, xv[16 * j + 9] * inv, xv[16 * j + 10] * inv, xv[16 * j + 11] * inv); o[j].w = pk4_i8(xv[16 * j + 12] * inv, xv[16 * j + 13] * inv, xv[16 * j + 14] * inv, xv[16 * j + 15] * inv); }
            GAS v4u* d1 = (GAS v4u*)(HS + (size_t)s1 * D) + 2 * lane; GAS v4u* d2 = (GAS v4u*)(HS + (size_t)s2 * D) + 2 * lane;
            d1[0] = o[0]; d1[1] = o[1]; d2[0] = o[0]; d2[1] = o[1];
            if (lane == 0) { tok_s[2 * m] = s1; tok_s[2 * m + 1] = s2; slot_g[s1] = g1; slot_g[s2] = g2; slot_s[s1] = am * (1.0f / 127.0f); slot_s[s2] = am * (1.0f / 127.0f); }
        }
    }
#else
    if (my_m >= 0) { tok_e[2 * my_m] = my_e1; tok_e[2 * my_m + 1] = my_e2; tok_r[2 * my_m] = (int)cntL[8 + my_e1] + my_l1; tok_r[2 * my_m + 1] = (int)cntL[8 + my_e2] + my_l2;
        tok_g[2 * my_m] = my_g1; tok_g[2 * my_m + 1] = my_g2; }
#endif
    __syncthreads();
}
DI void moe_offsets(Frame& F, int (&off)[9]) {
    int acc = 0;
#pragma unroll
    for (int e = 0; e < 8; ++e) { off[e] = acc; const int c = (int)__hip_atomic_load((unsigned*)(F.ctl + CW_CNT + 64 * e), RLX_AGENT); acc += (c + 255) & ~255; }
    off[8] = acc;
}
DI void gather_phase(Frame& F) {
    const int gw = F.vcu * NWAVES + F.wave, NGW = F.G * NWAVES, lane = F.lane;
    int off[9]; moe_offsets(F, off);
    const int* tok_e = (const int*)(F.ws + WS_ROUTE + RT_TOKE); const int* tok_r = (const int*)(F.ws + WS_ROUTE + RT_TOKR); const float* tok_g = (const float*)(F.ws + WS_ROUTE + RT_TOKG);
    int* tok_s = (int*)(F.ws + WS_ROUTE + RT_TOKS); float* slot_g = (float*)(F.ws + WS_ROUTE + RT_SLOTG);
    const bf16* H = (const bf16*)(F.ws + WS_H); unsigned char* HS = F.ws + WS_HS;
    for (int m = gw; m < S; m += NGW) {
        const int e1 = tok_e[2 * m], e2 = tok_e[2 * m + 1];
        int o1 = 0, o2 = 0;
#pragma unroll
        for (int e = 0; e < 8; ++e) { o1 = (e == e1) ? (GATHER_FUSED ? e * MOE_CAP : off[e]) : o1; o2 = (e == e2) ? (GATHER_FUSED ? e * MOE_CAP : off[e]) : o2; }
        const int s1 = o1 + tok_r[2 * m], s2 = o2 + tok_r[2 * m + 1];
        const GAS v4u* src = (const GAS v4u*)(H + (size_t)m * D) + 4 * lane;
        v4u o[2];
#if GU_INT8
        float xv[32]; float am = 0.f;
#pragma unroll
        for (int j = 0; j < 4; ++j) { const v4u a = src[j];
            xv[8 * j] = bflo(a.x); xv[8 * j + 1] = bfhi(a.x); xv[8 * j + 2] = bflo(a.y); xv[8 * j + 3] = bfhi(a.y); xv[8 * j + 4] = bflo(a.z); xv[8 * j + 5] = bfhi(a.z); xv[8 * j + 6] = bflo(a.w); xv[8 * j + 7] = bfhi(a.w); }
#pragma unroll
        for (int j = 0; j < 32; ++j) am = fmaxf(am, fabsf(xv[j]));
        am = fmaxf(wave_max(am), 1e-20f);
        const float inv = 127.0f / am;
#pragma unroll
        for (int j = 0; j < 2; ++j) { o[j].x = pk4_i8(xv[16 * j] * inv, xv[16 * j + 1] * inv, xv[16 * j + 2] * inv, xv[16 * j + 3] * inv); o[j].y = pk4_i8(xv[16 * j + 4] * inv, xv[16 * j + 5] * inv, xv[16 * j + 6] * inv, xv[16 * j + 7] * inv);
            o[j].z = pk4_i8(xv[16 * j + 8] * inv, xv[16 * j + 9] * inv, xv[16 * j + 10] * inv, xv[16 * j + 11] * inv); o[j].w = pk4_i8(xv[16 * j + 12] * inv, xv[16 * j + 13] * inv, xv[16 * j + 14] * inv, xv[16 * j + 15] * inv); }
        if (lane == 0) { float* slot_s = (float*)(F.ws + WS_ROUTE + RT_SLOTS); slot_s[s1] = am * (1.0f / 127.0f); slot_s[s2] = am * (1.0f / 127.0f); }
#else
#pragma unroll
        for (int j = 0; j < 2; ++j) { const v4u a = src[2 * j], b = src[2 * j + 1];
            o[j].x = pg8::pk4_fp8(bflo(a.x), bfhi(a.x), bflo(a.y), bfhi(a.y)); o[j].y = pg8::pk4_fp8(bflo(a.z), bfhi(a.z), bflo(a.w), bfhi(a.w));
            o[j].z = pg8::pk4_fp8(bflo(b.x), bfhi(b.x), bflo(b.y), bfhi(b.y)); o[j].w = pg8::pk4_fp8(bflo(b.z), bfhi(b.z), bflo(b.w), bfhi(b.w)); }
#endif
        GAS v4u* d1 = (GAS v4u*)(HS + (size_t)s1 * D) + 2 * lane; GAS v4u* d2 = (GAS v4u*)(HS + (size_t)s2 * D) + 2 * lane;
        d1[0] = o[0]; d1[1] = o[1]; d2[0] = o[0]; d2[1] = o[1];
        if (lane == 0) { tok_s[2 * m] = s1; tok_s[2 * m + 1] = s2; slot_g[s1] = tok_g[2 * m]; slot_g[s2] = tok_g[2 * m + 1]; }
    }
    for (int p = gw; p < off[8]; p += NGW) {
        int e = 0;
#pragma unroll
        for (int k = 1; k < 8; ++k) e += (p >= off[k]) ? 1 : 0;
        int oe = 0;
#pragma unroll
        for (int k = 0; k < 8; ++k) oe = (k == e) ? off[k] : oe;
        const int c = (int)__hip_atomic_load((unsigned*)(F.ctl + CW_CNT + 64 * e), RLX_AGENT);
        if (p >= oe + c) { const int ps = GATHER_FUSED ? e * MOE_CAP + (p - oe) : p;
            GAS v4u* d = (GAS v4u*)(HS + (size_t)ps * D) + 2 * lane; d[0] = (v4u){0u, 0u, 0u, 0u}; d[1] = (v4u){0u, 0u, 0u, 0u};
            if (lane == 0) { slot_g[ps] = 0.f; ((float*)(F.ws + WS_ROUTE + RT_SLOTS))[ps] = 0.f; } }
    }
}
DI f32x4 moe_row_piece(const float* OUTM, const float* OUTP, const int (&rt0)[9], int n_full, int sl, int slot, int jj, int lane) {
#if GATHER_FUSED
    const int pmf = slot >> 8, ef = pmf / MOE_CT; int rb = 0, nr = 1;
#pragma unroll
    for (int k = 0; k < 8; ++k) { rb = (k == ef) ? rt0[k] : rb; nr = (k == ef) ? (rt0[k + 1] - rt0[k]) : nr; }
    const int pm = rb + (pmf - ef * MOE_CT);
#else
    const int pm = slot >> 8; int rb = 0, nr = 1;
#pragma unroll
    for (int k = 0; k < 8; ++k) { const bool in = (pm >= rt0[k]) && (pm < rt0[k + 1]); rb = in ? rt0[k] : rb; nr = in ? (rt0[k + 1] - rt0[k]) : nr; }
#endif
#ifdef MOE_ROWMAJOR
    const int L = rb * (D / 256) + (pm - rb) * (D / 256) + jj;
#else
    const int L = rb * (D / 256) + jj * nr + (pm - rb);
#endif
#if OUTM_BF16
    if (L < n_full) return xrow4<true>((const bf16*)OUTM + (size_t)slot * D + jj * 256, lane);
#else
    if (L < n_full) return *((const GAS f32x4*)(OUTM + (size_t)slot * D + jj * 256) + lane);
#endif
    f32x4 a = (f32x4){0.f, 0.f, 0.f, 0.f}; const int j = L - n_full;
    for (int p = 0; p < sl; ++p) a += *((const GAS f32x4*)(OUTP + (size_t)(j * sl + p) * 65536 + (size_t)(slot & 255) * 256) + lane);
    return a;
}
#ifndef XB_BF16
#define XB_BF16 1
#endif
DI void combine_phase(Frame& F) {
    const int gw = F.vcu * NWAVES + F.wave, NGW = F.G * NWAVES, lane = F.lane;
    const int* tok_s = (const int*)(F.ws + WS_ROUTE + RT_TOKS); const float* XB = (const float*)(F.ws + WS_XB); const float* OUTM = (const float*)(F.ws + WS_OUTM); const float* OUTP = (const float*)(F.ws + WS_OUTP);
    int off[9]; moe_offsets(F, off); int rt0[9];
#pragma unroll
    for (int e = 0; e < 9; ++e) rt0[e] = off[e] >> 8;
    int n_full, sl; pg8::moe_slice_plan(rt0[8] * (D / 256), F.G, n_full, sl);
    for (int m = gw; m < S; m += NGW) {
        const int s1 = tok_s[2 * m], s2 = tok_s[2 * m + 1];
        const unsigned char* a = (const unsigned char*)XB + (size_t)m * D * (XB_BF16 ? 2 : 4);
        GAS f32x4* o = (GAS f32x4*)(F.out + (size_t)m * D) + lane;
#pragma unroll
        for (int jj = 0; jj < 8; ++jj) o[64 * jj] = (xrow4<XB_BF16 != 0>(a, lane + 64 * jj) + moe_row_piece(OUTM, OUTP, rt0, n_full, sl, s1, jj, lane)) + moe_row_piece(OUTM, OUTP, rt0, n_full, sl, s2, jj, lane);
    }
}

#ifndef SC_NT
#define SC_NT 1
#endif
DI void i1_unit(Frame& F, int u, int kb_lo, int kb_hi) {
    const int lane = F.lane, tid = F.tid, r = lane & 31, hf = lane >> 5;
    const bf16* P = (const bf16*)(F.ws + WS_P); float* SC = (float*)(F.ws + WS_SC);
    const int aq = (r >> 2) & 1, ah = ((r >> 3) << 2) | (r & 3);
    const int t0 = 32 * u + 4 * F.wave;
    LAS unsigned char* ring = F.lds + RING_OFF;
    bf16x8 af[2][4]; float wv[2][16];
#pragma unroll
    for (int mb = 0; mb < 2; ++mb) {
#pragma unroll
        for (int s = 0; s < 4; ++s) af[mb][s] = *(const GAS bf16x8*)(P + (size_t)(t0 + 2 * mb + aq) * PITCH + C_QI + ah * 64 + 16 * s + 8 * hf);
        const GAS v4u* wp = (const GAS v4u*)(P + (size_t)(t0 + 2 * mb + hf) * PITCH + C_WI); const v4u w0 = wp[0], w1 = wp[1];
        wv[mb][0] = bflo(w0.x); wv[mb][1] = bfhi(w0.x); wv[mb][2] = bflo(w0.y); wv[mb][3] = bfhi(w0.y); wv[mb][4] = bflo(w0.z); wv[mb][5] = bfhi(w0.z); wv[mb][6] = bflo(w0.w); wv[mb][7] = bfhi(w0.w);
        wv[mb][8] = bflo(w1.x); wv[mb][9] = bfhi(w1.x); wv[mb][10] = bflo(w1.y); wv[mb][11] = bfhi(w1.y); wv[mb][12] = bflo(w1.z); wv[mb][13] = bfhi(w1.z); wv[mb][14] = bflo(w1.w); wv[mb][15] = bfhi(w1.w);
#pragma unroll
        for (int i = 0; i < 16; ++i) wv[mb][i] *= 0.03125f;
    }
    if (kb_hi <= kb_lo) return;
    const int c_lo = kb_lo >> 3, c_hi = (kb_hi + 7) >> 3;
    v4u st[4];
#define I1_ISSUE(c) do { _Pragma("unroll") for (int i_ = 0; i_ < 4; ++i_) { const int p_ = tid + 512 * i_; int key_ = 256 * (c) + (p_ >> 3); key_ = key_ < S ? key_ : S - 1; \
        st[i_] = *(const GAS v4u*)(P + (size_t)key_ * PITCH + C_KI + 8 * (p_ & 7)); } } while (0)
#define I1_WRITE(b) do { _Pragma("unroll") for (int i_ = 0; i_ < 4; ++i_) { const int p_ = tid + 512 * i_, k_ = p_ >> 3; \
        *(LAS v4u*)(ring + (b) * 32768 + k_ * 128 + (((p_ & 7) ^ (k_ & 7)) << 4)) = st[i_]; } } while (0)
    I1_ISSUE(c_lo); I1_WRITE(c_lo & 1);
    __syncthreads();
    for (int c = c_lo; c < c_hi; ++c) {
        const bool more = (c + 1 < c_hi);
        if (more) I1_ISSUE(c + 1);
        const LAS unsigned char* buf = ring + (c & 1) * 32768;
        const int kbs = (kb_lo - 8 * c) > 0 ? (kb_lo - 8 * c) : 0, kbe = (kb_hi - 8 * c) < 8 ? (kb_hi - 8 * c) : 8;
        for (int kb = kbs; kb < kbe; ++kb) {
            const LAS unsigned char* kp = buf + (kb * 32 + r) * 128;
            bf16x8 bc[4];
#pragma unroll
            for (int s = 0; s < 4; ++s) bc[s] = *(const LAS bf16x8*)(kp + (((2 * s + hf) ^ (r & 7)) << 4));
#pragma unroll
            for (int mb = 0; mb < 2; ++mb) {
                f32x16 acc;
#pragma unroll
                for (int i = 0; i < 16; ++i) acc[i] = 0.f;
#pragma unroll
                for (int s = 0; s < 4; ++s) acc = __builtin_amdgcn_mfma_f32_32x32x16_bf16(af[mb][s], bc[s], acc, 0, 0, 0);
                float sc = 0.f;
#pragma unroll
                for (int i = 0; i < 16; ++i) sc += wv[mb][i] * fmaxf(acc[i], 0.f);
#if SC_NT
                __builtin_nontemporal_store(sc, (GAS float*)SC + ((size_t)(t0 + 2 * mb + hf) * S + 256 * c + 32 * kb + r));
#else
                SC[(size_t)(t0 + 2 * mb + hf) * S + 256 * c + 32 * kb + r] = sc;
#endif
            }
        }
        if (more) I1_WRITE((c + 1) & 1);
        __syncthreads();
    }
#undef I1_ISSUE
#undef I1_WRITE
}
DI void i1_phase(Frame& F) {
    const int c = F.vcu;
    if (F.G == 256) {
        if (c < 128) { i1_unit(F, c, 0, c + 1); i1_unit(F, 255 - c, 0, 127 - c); }
        else i1_unit(F, c, c - 128, c + 1);
    } else for (int u = c; u < S / 32; u += F.G) i1_unit(F, u, 0, u + 1);
}

DI int wave_sum_i(int v) {
#pragma unroll
    for (int o = 1; o < 64; o <<= 1) v += __shfl_xor(v, o);
    return v;
}
#define WRITELANE(x, v, L) asm volatile("s_nop 1\n\tv_writelane_b32 %0, %1, %2" : "+v"(x) : "s"(v), "n"(L))
template <int NREG>
DI void i2_select(const float* srow, unsigned* wrow, int t, int lane, LAS unsigned* cbuf  ) {
    constexpr int K = 256, CAP = 128;
    unsigned key[NREG];
    const GAS float* sp = (const GAS float*)srow + lane;
    const int limit = t - lane;
#pragma unroll
    for (int i = 0; i < NREG; ++i) { const unsigned u = __builtin_bit_cast(unsigned, SC_NT ? __builtin_nontemporal_load(sp + 64 * i) : sp[64 * i]); const unsigned k = (u & 0x80000000u) ? ~u : (u | 0x80000000u); key[i] = (limit >= 64 * i) ? k : 0u; }
    unsigned T = 0u; int cT = t + 1, cU = 0, bit = 31;
    if (t >= 1024) {
        unsigned mx = 0u;
#pragma unroll
        for (int i = 0; i < NREG; ++i) mx = key[i] > mx ? key[i] : mx;
#pragma unroll
        for (int o = 1; o < 64; o <<= 1) { const unsigned other = (unsigned)__shfl_xor((int)mx, o); mx = other > mx ? other : mx; }
        unsigned Th = mx & 0xFF800000u; int cprev = 0;
        for (int step = 0; step < 6; ++step) {
            int cl = 0;
#pragma unroll
            for (int i = 0; i < NREG; ++i) cl += (key[i] >= Th) ? 1 : 0;
            const int c = wave_sum_i(cl);
            if (c >= K) { T = Th; cT = c; cU = cprev; bit = 22; break; }
            cprev = c;
            if (Th < 0x00800000u) break;
            Th -= 0x00800000u;
        }
    }
    for (; bit >= 0; --bit) {
        if (cT - cU <= CAP) break;
        const unsigned cand = T | (1u << bit);
        int cl = 0;
#pragma unroll
        for (int i = 0; i < NREG; ++i) cl += (key[i] >= cand) ? 1 : 0;
        const int c = wave_sum_i(cl);
        if (c >= K) { T = cand; cT = c; } else cU = c;
    }
    if (bit >= 0) {
        const unsigned width = (bit == 31) ? 0xFFFFFFFFu : ((2u << bit) - 1u);
        int pos = 0;
#pragma unroll
        for (int i = 0; i < NREG; ++i) {
            const bool inb = (key[i] != 0u) && ((key[i] - T) <= width);
            const unsigned long long m = __ballot(inb);
            if (m != 0ull) { const int idx = pos + (int)__builtin_amdgcn_mbcnt_hi((unsigned)(m >> 32), __builtin_amdgcn_mbcnt_lo((unsigned)m, 0u)); if (inb && idx < CAP) cbuf[idx] = key[i]; pos += __popcll(m); }
        }
        LDS_WAIT(); asm volatile("" ::: "memory");
        const unsigned c0 = (lane < pos) ? cbuf[lane] : 0u, c1 = (lane + 64 < pos) ? cbuf[lane + 64] : 0u;
        LDS_WAIT(); asm volatile("" ::: "memory");
        for (; bit >= 0; --bit) {
            const unsigned cand = T | (1u << bit);
            const int c = cU + __popcll(__ballot(c0 >= cand)) + __popcll(__ballot(c1 >= cand));
            if (c >= K) { T = cand; cT = c; }
        }
    }
    unsigned lo0 = 0u, hi0 = 0u, lo1 = 0u, hi1 = 0u;
    if (cT == K && T != 0u) {
#pragma unroll
        for (int i = 0; i < NREG; ++i) {
            const unsigned long long sm = __ballot(key[i] >= T);
            if (i < 64) { WRITELANE(lo0, (unsigned)sm, i & 63); WRITELANE(hi0, (unsigned)(sm >> 32), i & 63); }
            else { WRITELANE(lo1, (unsigned)sm, i & 63); WRITELANE(hi1, (unsigned)(sm >> 32), i & 63); }
        }
    } else {
    int cg = 0;
#pragma unroll
    for (int i = 0; i < NREG; ++i) cg += __popcll(__ballot(key[i] > T));
    const int need = K - cg;
    unsigned T1 = T + 1u; asm volatile("" : "+v"(T1));
    int running = 0;
#pragma unroll
    for (int i = 0; i < NREG; ++i) {
        const bool nz = key[i] != 0u;
        const bool eq = nz && (key[i] == T);
        const unsigned long long eqm = __ballot(eq);
        const int myrank = running + (int)__builtin_amdgcn_mbcnt_hi((unsigned)(eqm >> 32), __builtin_amdgcn_mbcnt_lo((unsigned)eqm, 0u));
        const bool sel = nz && ((key[i] >= T1) || (eq && myrank < need));
        const unsigned long long sm = __ballot(sel);
        running += __popcll(eqm);
        if (i < 64) { WRITELANE(lo0, (unsigned)sm, i & 63); WRITELANE(hi0, (unsigned)(sm >> 32), i & 63); }
        else { WRITELANE(lo1, (unsigned)sm, i & 63); WRITELANE(hi1, (unsigned)(sm >> 32), i & 63); }
    }
    }
    if (NREG <= 64) { if (lane < NREG) *(GAS v2u*)(wrow + 2 * lane) = (v2u){lo0, hi0}; }
    else { *(GAS v2u*)(wrow + 2 * lane) = (v2u){lo0, hi0}; if (lane < NREG - 64) *(GAS v2u*)(wrow + 128 + 2 * lane) = (v2u){lo1, hi1}; }
}
DI void i2_phase(Frame& F) {
    const int gw = F.vcu * NWAVES + F.wave, NGW = F.G * NWAVES;
    const float* SC = (const float*)(F.ws + WS_SC); unsigned* WM = (unsigned*)(F.ws + WS_WM);
    LAS unsigned* cbuf = (LAS unsigned*)(F.lds + RING_OFF) + F.wave * 128;
    for (int t = gw; t < 2048; t += NGW) i2_select<32>(SC + (size_t)t * S, WM + (size_t)t * 256, t, F.lane, cbuf);
    for (int t = 2048 + gw; t < 4096; t += NGW) i2_select<64>(SC + (size_t)t * S, WM + (size_t)t * 256, t, F.lane, cbuf);
    for (int t = 4096 + gw; t < 6144; t += NGW) i2_select<96>(SC + (size_t)t * S, WM + (size_t)t * 256, t, F.lane, cbuf);
    for (int t = 6144 + gw; t < 8192; t += NGW) i2_select<128>(SC + (size_t)t * S, WM + (size_t)t * 256, t, F.lane, cbuf);
}

typedef __bf16 bf16x2_t __attribute__((ext_vector_type(2)));
typedef float f32x2_t __attribute__((ext_vector_type(2)));
typedef short v4i16_t __attribute__((ext_vector_type(4)));
DI unsigned cvtpk_s(float lo, float hi) { f32x2_t v = {lo, hi}; bf16x2_t b = __builtin_convertvector(v, bf16x2_t); return __builtin_bit_cast(unsigned, b); }
DI s16x4 vtr(const LAS unsigned char* p) { return __builtin_bit_cast(s16x4, __builtin_amdgcn_ds_read_tr16_b64_v4i16((LAS v4i16_t*)p)); }
DI unsigned off_a(unsigned row, unsigned ch) { return 2048u * (row >> 3) + 512u * (ch >> 2) + 64u * (row & 7) + 16u * ((ch & 3) ^ ((row >> 2) & 3)); }

#ifndef DBG_NOMASK
#define DBG_NOMASK 0
#endif
DI float and_mask_f(float v, int m) { return __builtin_bit_cast(float, __builtin_bit_cast(int, v) & m); }
#define SBAR() __builtin_amdgcn_sched_barrier(0)
#ifndef ATT_SEG
#define ATT_SEG 0
#endif
#ifndef ATT_SGB
#define ATT_SGB 0
#endif
#if ATT_SGB
#define SBF() do { } while (0)
#else
#define SBF() __builtin_amdgcn_sched_barrier(0)
#endif
#define SGB(mask, n) __builtin_amdgcn_sched_group_barrier((mask), (n), 0);
#ifndef ATT_L2_TOUCH
#define ATT_L2_TOUCH 0
#endif
#ifndef FARSPEC
#define FARSPEC 0
#endif
#ifndef ATT_STAGGER
#define ATT_STAGGER 0
#endif
#ifndef ATT_QBMAJOR
#define ATT_QBMAJOR 0
#endif
#ifndef ATT_WIDE
#define ATT_WIDE 0
#endif
#ifndef ATT_PREF
#define ATT_PREF 0
#endif
#ifndef PREF_AB
#define PREF_AB 0
#endif
#ifndef PREF_KB
#define PREF_KB 0
#endif
#ifndef PREF_VA
#define PREF_VA 0
#endif
#ifndef PREF_VB
#define PREF_VB 0
#endif
#ifndef KIND2_FUSED
#define KIND2_FUSED 1
#endif
constexpr int AT_SLOT = 32768, AT_BUF = 65536;


template <int KIND, int I, bool FAR> DI void at_sm_el(f32x16& Sx, const float (&tv)[16], int mm, float& lsum) {
    float p = __builtin_amdgcn_exp2f(Sx[I]); if (!FAR) p *= tv[I];
    if (KIND == 0 && !DBG_NOMASK) p = and_mask_f(p, __builtin_amdgcn_sbfe(mm, (I & 3) + 8 * (I >> 2), 1));
    Sx[I] = p; lsum += p;
}
DI void at_pack(const f32x16& Sx, bf16x8 (&pb)[2]) {
#pragma unroll
    for (int s2 = 0; s2 < 2; ++s2) { v4u pw; pw.x = cvtpk_s(Sx[8 * s2], Sx[8 * s2 + 1]); pw.y = cvtpk_s(Sx[8 * s2 + 2], Sx[8 * s2 + 3]);
        pw.z = cvtpk_s(Sx[8 * s2 + 4], Sx[8 * s2 + 5]); pw.w = cvtpk_s(Sx[8 * s2 + 6], Sx[8 * s2 + 7]); pb[s2] = __builtin_bit_cast(bf16x8, pw); }
}
struct AttnShared { float m2[3]; float lam; float post; };

template <int KIND>
DI void attn_unit(Frame& F, int layer, int head, int qb, const AttnShared& sh) {
    int tid = F.tid; asm volatile("" : "+v"(tid));
    constexpr bool WIDE = (KIND != 2) && ATT_WIDE;
    const int lane = tid & 63, w = F.wave, g = WIDE ? 0 : (w >> 2), wq = WIDE ? w : (w & 3), r = lane & 31, hf = lane >> 5;
    const bf16* P = (const bf16*)(F.ws + WS_P);
    const int colQ = (KIND == 0 ? C_QA : (KIND == 1 ? C_QB : C_QC)) + 128 * head;
    const int colK = (KIND == 0 ? C_KA : (KIND == 1 ? C_KB : C_KC)) + 128 * head;
    const int colV = (KIND == 0 ? C_VA : (KIND == 1 ? C_VB : C_VC)) + 128 * head;
    const int outc = (KIND == 0 ? 0 : (KIND == 1 ? 512 : 1280)) + 128 * head;
    const int tblh = (KIND == 0 ? 0 : (KIND == 1 ? 4 : 10)) + head;
    const int q0 = (WIDE ? 256 : 128) * qb, kbeg = (KIND == 1) ? (q0 > 2048 ? q0 - 2048 : 0) : 0, nss = (q0 + (WIDE ? 256 : 128) - kbeg) >> 7;
    const int qrow0 = q0 + 32 * wq, myq = qrow0 + r;
    constexpr int NQS = (KIND == 2) ? 4 : 8;
    LAS unsigned char* ring = F.lds + RING_OFF;
    LAS float* tblL = (LAS float*)(F.lds + LDS_TBL_OFF);
    { unsigned char* wsp_ = F.ws; asm volatile("" : "+s"(wsp_));
      const float* TB = (const float*)(wsp_ + WS_TBL) + tblh * TBL_N; for (int i = tid; i < TBL_N; i += NWAVES * 64) tblL[i] = TB[i]; }
    bf16x8 qf[NQS];
#pragma unroll
    for (int s = 0; s < NQS; ++s) qf[s] = *(const GAS bf16x8*)(P + (size_t)myq * PITCH + colQ + (KIND == 2 ? 64 * g : 0) + 16 * s + 8 * hf);
    const int ld_o = 16 * tid, ld_row = ((ld_o >> 11) << 3) | ((ld_o >> 6) & 7), ld_ch = (((ld_o >> 9) & 3) << 2) | (((ld_o >> 4) & 3) ^ ((ld_row >> 2) & 3));
    const bf16* ld_src = P + (size_t)ld_row * PITCH + 8 * ld_ch;
#define AT_ISSUE(ss, b) do { _Pragma("unroll") for (int i_ = 0; i_ < 8; ++i_) \
        __builtin_amdgcn_global_load_lds((const unsigned*)(ld_src + (size_t)(kbeg + 128 * (ss) + 64 * (i_ >> 2) + 32 * (i_ & 1)) * PITCH + (((i_ >> 1) & 1) ? colV : colK)), \
                                         (LAS unsigned*)(ring + (b) * AT_BUF + i_ * 8192 + w * 1024), 16, 0, 0); } while (0)
    AT_ISSUE(0, 0);
    const unsigned* WM = (const unsigned*)(F.ws + WS_WM);
    v4u mw = (v4u){0u, 0u, 0u, 0u}, mwn = (v4u){0u, 0u, 0u, 0u};
    if (KIND == 0) { if (WIDE) mw = *(const GAS v4u*)(WM + (size_t)myq * 256); else { const v2u t_ = *(const GAS v2u*)(WM + (size_t)myq * 256 + (2 * g)); mw.x = t_.x; mw.y = t_.y; } }
    __syncthreads();
    const unsigned kbase_e = 2048u * (r >> 3) + 64u * (r & 7) + 16u * ((unsigned)hf ^ ((r >> 2) & 3)) + (KIND == 2 ? 1024u * g : 0u);
    const unsigned kbase_o = 2048u * (r >> 3) + 64u * (r & 7) + 16u * ((2u + hf) ^ ((r >> 2) & 3)) + (KIND == 2 ? 1024u * g : 0u);
    const unsigned i16 = lane & 15, tq = i16 >> 2, tp = i16 & 3, blk = (lane >> 4) & 1;
    const unsigned vbase0 = 64u * (4 * hf + tq) + 16u * ((2 * blk + (tp >> 1)) ^ (unsigned)hf) + 8u * (tp & 1);
    const unsigned vbase1 = 64u * (4 * hf + tq) + 16u * ((2 * blk + (tp >> 1)) ^ (2u + hf)) + 8u * (tp & 1);
    f32x16 O[4];
#pragma unroll
    for (int b = 0; b < 4; ++b)
#pragma unroll
        for (int i = 0; i < 16; ++i) O[b][i] = 0.f;
    float lsum = 0.f;
    const float sinit = -sh.m2[KIND];
    const float sinit_far = (KIND != 1) ? __builtin_bit_cast(float, __builtin_amdgcn_readfirstlane(__builtin_bit_cast(int, sinit + __builtin_amdgcn_logf(tblL[TBL_N - 1])))) : sinit;

#define AT_BLOCK(Kimg, Vimg, k0_, mword) do { \
        const int k0 = (k0_); \
        if (k0 <= qrow0 + 31 && !(KIND == 1 && qrow0 - (k0 + 31) > 2048)) { \
            f32x16 Sx; _Pragma("unroll") for (int i = 0; i < 16; ++i) Sx[i] = sinit; \
            _Pragma("unroll") for (int s = 0; s < NQS; ++s) { const bf16x8 kf = *(const LAS bf16x8*)((Kimg) + ((s & 1) ? kbase_o : kbase_e) + 512 * (s >> 1)); \
                Sx = __builtin_amdgcn_mfma_f32_32x32x16_bf16(kf, qf[s], Sx, 0, 0, 0); } \
            { const LAS float* tp_ = tblL + ((KIND != 1 && qrow0 - (k0 + 31) >= DFAR) ? (TBL_N - 28) : (myq - k0 - 4 * hf + TBL_OFF - 27));     \
                _Pragma("unroll") for (int i = 0; i < 16; ++i) Sx[i] = __builtin_amdgcn_exp2f(Sx[i]) * tp_[27 - ((i & 3) + 8 * (i >> 2))]; \
            } \
            if (KIND == 0 && !DBG_NOMASK) { const int mm = (int)((mword) >> (4 * hf)); \
                _Pragma("unroll") for (int i = 0; i < 16; ++i) { const float pv_ = Sx[i]; Sx[i] = and_mask_f(pv_, __builtin_amdgcn_sbfe(mm, (i & 3) + 8 * (i >> 2), 1)); } } \
            _Pragma("unroll") for (int i = 0; i < 16; ++i) lsum += Sx[i]; \
            bf16x8 pb[2]; \
            _Pragma("unroll") for (int s2 = 0; s2 < 2; ++s2) { v4u pw; pw.x = cvtpk_s(Sx[8 * s2], Sx[8 * s2 + 1]); pw.y = cvtpk_s(Sx[8 * s2 + 2], Sx[8 * s2 + 3]); \
                pw.z = cvtpk_s(Sx[8 * s2 + 4], Sx[8 * s2 + 5]); pw.w = cvtpk_s(Sx[8 * s2 + 6], Sx[8 * s2 + 7]); pb[s2] = __builtin_bit_cast(bf16x8, pw); } \
            _Pragma("unroll") for (int b = 0; b < 4; ++b) \
                _Pragma("unroll") for (int s2 = 0; s2 < 2; ++s2) { \
                    const s16x4 lo = vtr((Vimg) + vbase0 + 2048 * (2 * s2) + 512 * b), hi = vtr((Vimg) + vbase1 + 2048 * (2 * s2 + 1) + 512 * b); \
                    const bf16x8 vf = __builtin_shufflevector(lo, hi, 0, 1, 2, 3, 4, 5, 6, 7); \
                    O[b] = __builtin_amdgcn_mfma_f32_32x32x16_bf16(vf, pb[s2], O[b], 0, 0, 0); } \
        } } while (0)


#define AT_TV(tv, k0) float tv[16]; if (!FARV) { const LAS float* tp__##tv = tblL + ((KIND != 1 && qrow0 - ((k0) + 31) >= DFAR) ? (TBL_N - 28) : (myq - (k0) - 4 * hf + TBL_OFF - 27)); \
        _Pragma("unroll") for (int i = 0; i < 16; ++i) tv[i] = tp__##tv[27 - ((i & 3) + 8 * (i >> 2))]; } SBF();
#define AT_KLD(kf, Kimg) bf16x8 kf[NQS]; _Pragma("unroll") for (int s_ = 0; s_ < NQS; ++s_) kf[s_] = *(const LAS bf16x8*)((Kimg) + ((s_ & 1) ? kbase_o : kbase_e) + 512 * (s_ >> 1)); SBF();
#define AT_VLD(vf, Vimg) bf16x8 vf[8]; _Pragma("unroll") for (int j_ = 0; j_ < 4; ++j_) { const s16x4 lo_ = vtr((Vimg) + vbase0 + 2048 * (2 * (j_ & 1)) + 512 * (j_ >> 1)), hi_ = vtr((Vimg) + vbase1 + 2048 * (2 * (j_ & 1) + 1) + 512 * (j_ >> 1)); \
        vf[j_] = __builtin_shufflevector(lo_, hi_, 0, 1, 2, 3, 4, 5, 6, 7); } SBF();
#define AT_VLD2(vf, Vimg) _Pragma("unroll") for (int j_ = 4; j_ < 8; ++j_) { const s16x4 lo_ = vtr((Vimg) + vbase0 + 2048 * (2 * (j_ & 1)) + 512 * (j_ >> 1)), hi_ = vtr((Vimg) + vbase1 + 2048 * (2 * (j_ & 1) + 1) + 512 * (j_ >> 1)); \
        vf[j_] = __builtin_shufflevector(lo_, hi_, 0, 1, 2, 3, 4, 5, 6, 7); } SBF();
#ifdef ATT_PRIO
#define AT_P1 __builtin_amdgcn_s_setprio(1);
#define AT_P0 __builtin_amdgcn_s_setprio(0);
#else
#define AT_P1
#define AT_P0
#endif
#define AT_QKS(Sx, kf, s) { AT_P1 Sx = __builtin_amdgcn_mfma_f32_32x32x16_bf16(kf[s], qf[s], Sx, 0, 0, 0); AT_P0 }
#define AT_PVS(pb, vf, j) { AT_P1 O[(j) >> 1] = __builtin_amdgcn_mfma_f32_32x32x16_bf16(vf[j], pb[(j) & 1], O[(j) >> 1], 0, 0, 0); AT_P0 }
#define AT_SM2(Sx, tv, mm, i) { at_sm_el<KIND, (i), FARV>(Sx, tv, mm, lsum); at_sm_el<KIND, (i) + 1, FARV>(Sx, tv, mm, lsum); SBF(); }
#define AT_SM4(Sx, tv, mm, i) { AT_SM2(Sx, tv, mm, i) AT_SM2(Sx, tv, mm, (i) + 2) }
#define AT_SINIT(Sx) f32x16 Sx; _Pragma("unroll") for (int i = 0; i < 16; ++i) Sx[i] = FARV ? sinit_far : sinit;
#define AT_QK_ALONE(Sx, Kimg) { AT_KLD(kf_, Kimg) if (NQS == 8) { AT_QKS(Sx, kf_, 0) AT_QKS(Sx, kf_, 1) AT_QKS(Sx, kf_, 2) AT_QKS(Sx, kf_, 3) AT_QKS(Sx, kf_, NQS - 4) AT_QKS(Sx, kf_, NQS - 3) AT_QKS(Sx, kf_, NQS - 2) AT_QKS(Sx, kf_, NQS - 1) } \
        else { AT_QKS(Sx, kf_, 0) AT_QKS(Sx, kf_, 1) AT_QKS(Sx, kf_, 2) AT_QKS(Sx, kf_, 3) } }
#define AT_QK_SM(Sn, KimgN, Sp, tvp, mmp) { AT_KLD(kf_, KimgN) if (NQS == 8) { \
        AT_QKS(Sn, kf_, 0) AT_SM2(Sp, tvp, mmp, 0) AT_QKS(Sn, kf_, 1) AT_SM2(Sp, tvp, mmp, 2) AT_QKS(Sn, kf_, 2) AT_SM2(Sp, tvp, mmp, 4) AT_QKS(Sn, kf_, 3) AT_SM2(Sp, tvp, mmp, 6) \
        AT_QKS(Sn, kf_, NQS - 4) AT_SM2(Sp, tvp, mmp, 8) AT_QKS(Sn, kf_, NQS - 3) AT_SM2(Sp, tvp, mmp, 10) AT_QKS(Sn, kf_, NQS - 2) AT_SM2(Sp, tvp, mmp, 12) AT_QKS(Sn, kf_, NQS - 1) AT_SM2(Sp, tvp, mmp, 14) } \
        else { AT_QKS(Sn, kf_, 0) AT_SM4(Sp, tvp, mmp, 0) AT_QKS(Sn, kf_, 1) AT_SM4(Sp, tvp, mmp, 4) AT_QKS(Sn, kf_, 2) AT_SM4(Sp, tvp, mmp, 8) AT_QKS(Sn, kf_, 3) AT_SM4(Sp, tvp, mmp, 12) } }
#define AT_PV_ALONE(pb, Vimg) { AT_VLD(vf_, Vimg) AT_PVS(pb, vf_, 0) AT_PVS(pb, vf_, 1) AT_VLD2(vf_, Vimg) AT_PVS(pb, vf_, 2) AT_PVS(pb, vf_, 3) AT_PVS(pb, vf_, 4) AT_PVS(pb, vf_, 5) AT_PVS(pb, vf_, 6) AT_PVS(pb, vf_, 7) }
#define AT_PV_SM(pb, Vimg, Sn, tvn, mmn) { AT_VLD(vf_, Vimg) AT_PVS(pb, vf_, 0) AT_SM2(Sn, tvn, mmn, 0) AT_PVS(pb, vf_, 1) AT_VLD2(vf_, Vimg) AT_SM2(Sn, tvn, mmn, 2) AT_PVS(pb, vf_, 2) AT_SM2(Sn, tvn, mmn, 4) AT_PVS(pb, vf_, 3) AT_SM2(Sn, tvn, mmn, 6) \
        AT_PVS(pb, vf_, 4) AT_SM2(Sn, tvn, mmn, 8) AT_PVS(pb, vf_, 5) AT_SM2(Sn, tvn, mmn, 10) AT_PVS(pb, vf_, 6) AT_SM2(Sn, tvn, mmn, 12) AT_PVS(pb, vf_, 7) AT_SM2(Sn, tvn, mmn, 14) }

    for (int ss = 0; ss < nss; ++ss) {
        const int b = ss & 1; const bool more = (ss + 1 < nss);
#if ATT_STAGGER
        if (w < 4) __builtin_amdgcn_s_sleep(ATT_STAGGER);
#endif
#if ATT_L2_TOUCH
        unsigned touch_ = 0u;
        if (ss + 2 < nss) { const bf16* tb2_ = P + (size_t)(kbeg + 128 * (ss + 2)) * PITCH;
            int tt_ = F.tid; asm volatile("" : "+v"(tt_));
            const unsigned touch_off = (unsigned)((((tt_ >> 1) & 127) * PITCH + ((tt_ >> 8) ? colV : colK) + 64 * (tt_ & 1)) * 2);
            asm volatile("global_load_dword %0, %1, %2" : "=v"(touch_) : "v"(touch_off), "s"(tb2_) : "memory"); }
#endif
        if (more) { AT_ISSUE(ss + 1, b ^ 1);
#ifdef DBG_DOUBLE_DMA
            AT_ISSUE(ss + 1, b ^ 1);
#endif
            if (KIND == 0) { if (WIDE) mwn = *(const GAS v4u*)(WM + (size_t)myq * 256 + 4 * (ss + 1)); else { const v2u t_ = *(const GAS v2u*)(WM + (size_t)myq * 256 + (4 * (ss + 1) + 2 * g)); mwn.x = t_.x; mwn.y = t_.y; } } }
        LAS unsigned char* base = ring + b * AT_BUF;
        const int kss = kbeg + 128 * ss;
#if ATT_PREF
#define AT_VLD8(vf, Vimg) bf16x8 vf[8]; _Pragma("unroll") for (int j_ = 0; j_ < 8; ++j_) { const s16x4 lo_ = vtr((Vimg) + vbase0 + 2048 * (2 * (j_ & 1)) + 512 * (j_ >> 1)), hi_ = vtr((Vimg) + vbase1 + 2048 * (2 * (j_ & 1) + 1) + 512 * (j_ >> 1)); \
        vf[j_] = __builtin_shufflevector(lo_, hi_, 0, 1, 2, 3, 4, 5, 6, 7); } SBF();
#define AT_QKC(Sx, kf) { if (NQS == 8) { AT_QKS(Sx, kf, 0) AT_QKS(Sx, kf, 1) AT_QKS(Sx, kf, 2) AT_QKS(Sx, kf, 3) AT_QKS(Sx, kf, NQS - 4) AT_QKS(Sx, kf, NQS - 3) AT_QKS(Sx, kf, NQS - 2) AT_QKS(Sx, kf, NQS - 1) } \
        else { AT_QKS(Sx, kf, 0) AT_QKS(Sx, kf, 1) AT_QKS(Sx, kf, 2) AT_QKS(Sx, kf, 3) } SBF(); }
#define AT_QKC_SM(Sn, kf, Sp, tvp, mmp) { if (NQS == 8) { \
        AT_QKS(Sn, kf, 0) AT_SM2(Sp, tvp, mmp, 0) AT_QKS(Sn, kf, 1) AT_SM2(Sp, tvp, mmp, 2) AT_QKS(Sn, kf, 2) AT_SM2(Sp, tvp, mmp, 4) AT_QKS(Sn, kf, 3) AT_SM2(Sp, tvp, mmp, 6) \
        AT_QKS(Sn, kf, NQS - 4) AT_SM2(Sp, tvp, mmp, 8) AT_QKS(Sn, kf, NQS - 3) AT_SM2(Sp, tvp, mmp, 10) AT_QKS(Sn, kf, NQS - 2) AT_SM2(Sp, tvp, mmp, 12) AT_QKS(Sn, kf, NQS - 1) AT_SM2(Sp, tvp, mmp, 14) } \
        else { AT_QKS(Sn, kf, 0) AT_SM4(Sp, tvp, mmp, 0) AT_QKS(Sn, kf, 1) AT_SM4(Sp, tvp, mmp, 4) AT_QKS(Sn, kf, 2) AT_SM4(Sp, tvp, mmp, 8) AT_QKS(Sn, kf, 3) AT_SM4(Sp, tvp, mmp, 12) } }
#define AT_PVC(pb, vf) { AT_PVS(pb, vf, 0) AT_PVS(pb, vf, 1) AT_PVS(pb, vf, 2) AT_PVS(pb, vf, 3) AT_PVS(pb, vf, 4) AT_PVS(pb, vf, 5) AT_PVS(pb, vf, 6) AT_PVS(pb, vf, 7) SBF(); }
#define AT_PVC_SM(pb, vf, Sn, tvn, mmn) { AT_PVS(pb, vf, 0) AT_SM2(Sn, tvn, mmn, 0) AT_PVS(pb, vf, 1) AT_SM2(Sn, tvn, mmn, 2) AT_PVS(pb, vf, 2) AT_SM2(Sn, tvn, mmn, 4) AT_PVS(pb, vf, 3) AT_SM2(Sn, tvn, mmn, 6) \
        AT_PVS(pb, vf, 4) AT_SM2(Sn, tvn, mmn, 8) AT_PVS(pb, vf, 5) AT_SM2(Sn, tvn, mmn, 10) AT_PVS(pb, vf, 6) AT_SM2(Sn, tvn, mmn, 12) AT_PVS(pb, vf, 7) AT_SM2(Sn, tvn, mmn, 14) }
#define AT_KLD_IF(c, kf, Kimg) bf16x8 kf[NQS]; if (c) { _Pragma("unroll") for (int s_ = 0; s_ < NQS; ++s_) kf[s_] = *(const LAS bf16x8*)((Kimg) + ((s_ & 1) ? kbase_o : kbase_e) + 512 * (s_ >> 1)); } SBF();
#define AT_KLD_IF2(c, kf, Kimg) if (c) { _Pragma("unroll") for (int s_ = 0; s_ < NQS; ++s_) kf[s_] = *(const LAS bf16x8*)((Kimg) + ((s_ & 1) ? kbase_o : kbase_e) + 512 * (s_ >> 1)); } SBF();
#define AT_VLDR(c, vf, Vimg, j0, j1) if (c) { _Pragma("unroll") for (int j_ = (j0); j_ < (j1); ++j_) { const s16x4 lo_ = vtr((Vimg) + vbase0 + 2048 * (2 * (j_ & 1)) + 512 * (j_ >> 1)), hi_ = vtr((Vimg) + vbase1 + 2048 * (2 * (j_ & 1) + 1) + 512 * (j_ >> 1)); \
        vf[j_] = __builtin_shufflevector(lo_, hi_, 0, 1, 2, 3, 4, 5, 6, 7); } } SBF();
#define AT_FUSED2N(Ka, Va, Kb, Vb, k0a, k0b, mma, mmb, FAR_) do { \
            constexpr bool FARV = (FAR_); constexpr bool PKB = (KIND == 2) || PREF_KB, PVA = (KIND == 2) || PREF_VA, PVB = (KIND == 2) || PREF_VB; \
            AT_SINIT(S0) \
            AT_KLD(kfa_, Ka) AT_KLD_IF(PKB, kfb_, Kb) \
            AT_TV(tv0, k0a) \
            AT_QKC(S0, kfa_) \
            AT_SINIT(S1) \
            AT_KLD_IF2(!PKB, kfb_, Kb) \
            bf16x8 vfa_[8], vfb_[8]; \
            AT_VLDR(PVA, vfa_, Va, 0, 4) \
            AT_QKC_SM(S1, kfb_, S0, tv0, mma) \
            bf16x8 pb[2]; at_pack(S0, pb); \
            AT_TV(tv1, k0b) \
            AT_VLDR(!PVA, vfa_, Va, 0, 4) \
            AT_VLDR(true, vfa_, Va, 4, 8) \
            AT_VLDR(PVB, vfb_, Vb, 0, 8) \
            AT_PVC_SM(pb, vfa_, S1, tv1, mmb) \
            at_pack(S1, pb); \
            AT_VLDR(!PVB, vfb_, Vb, 0, 8) \
            AT_PVC(pb, vfb_) } while (0)
#endif
#if ATT_SGB
#define SGB_QKA SGB(0x008, 1) SGB(0x100, 1)
#define SGB_QKB(TR, VA) SGB(0x008, 1) SGB(0x400, TR) SGB(0x002, VA) SGB(0x100, 2)
#define SGB_PVA(VA) SGB(0x008, 1) SGB(0x400, 2) SGB(0x002, VA) SGB(0x100, 2)
#define AT_PIPE() { constexpr int VE = FARV ? (KIND == 0 ? 3 : 1) : (KIND == 0 ? 4 : 2);     \
        SGB(0x100, NQS + 8) \
        if (NQS == 8) { SGB_QKA SGB_QKA SGB_QKA SGB_QKA SGB_QKA SGB_QKA SGB_QKA SGB_QKA \
            SGB_QKB(2, 2 * VE) SGB_QKB(2, 2 * VE) SGB_QKB(2, 2 * VE) SGB_QKB(2, 2 * VE) SGB_QKB(2, 2 * VE) SGB_QKB(2, 2 * VE) SGB_QKB(2, 2 * VE) SGB_QKB(2, 2 * VE) } \
        else { SGB_QKA SGB_QKA SGB_QKA SGB_QKA SGB_QKB(4, 4 * VE) SGB_QKB(4, 4 * VE) SGB_QKB(4, 4 * VE) SGB_QKB(4, 4 * VE) } \
        SGB(0x002, 8) \
        SGB_PVA(2 * VE) SGB_PVA(2 * VE) SGB_PVA(2 * VE) SGB_PVA(2 * VE) SGB_PVA(2 * VE) SGB_PVA(2 * VE) SGB_PVA(2 * VE) SGB_PVA(2 * VE) \
        SGB(0x002, 8) \
        SGB(0x008, 8) }
#else
#define AT_PIPE() { }
#endif
#if ATT_SEG
#define AT_HQK(Sx, kf) { if (NQS == 8) { AT_QKS(Sx, kf, 0) AT_QKS(Sx, kf, 1) AT_QKS(Sx, kf, 2) AT_QKS(Sx, kf, 3) AT_QKS(Sx, kf, 4) AT_QKS(Sx, kf, 5) AT_QKS(Sx, kf, 6) AT_QKS(Sx, kf, 7) } \
        else { AT_QKS(Sx, kf, 0) AT_QKS(Sx, kf, 1) AT_QKS(Sx, kf, 2) AT_QKS(Sx, kf, 3) } }
#define AT_HSM(Sx, tv, mm) { AT_SM4(Sx, tv, mm, 0) AT_SM4(Sx, tv, mm, 4) AT_SM4(Sx, tv, mm, 8) AT_SM4(Sx, tv, mm, 12) }
#define AT_HPV(pb, vf) { AT_PVS(pb, vf, 0) AT_PVS(pb, vf, 1) AT_PVS(pb, vf, 2) AT_PVS(pb, vf, 3) AT_PVS(pb, vf, 4) AT_PVS(pb, vf, 5) AT_PVS(pb, vf, 6) AT_PVS(pb, vf, 7) }
#define AT_HVLD(vf, Vimg) bf16x8 vf[8]; _Pragma("unroll") for (int j_ = 0; j_ < 8; ++j_) { const s16x4 lo_ = vtr((Vimg) + vbase0 + 2048 * (2 * (j_ & 1)) + 512 * (j_ >> 1)), hi_ = vtr((Vimg) + vbase1 + 2048 * (2 * (j_ & 1) + 1) + 512 * (j_ >> 1)); \
        vf[j_] = __builtin_shufflevector(lo_, hi_, 0, 1, 2, 3, 4, 5, 6, 7); }
#define AT_FUSED2H(Ka, Va, Kb, Vb, k0a, k0b, mma, mmb, FAR_) do { \
            constexpr bool FARV = (FAR_); \
            AT_SINIT(S0) AT_SINIT(S1) \
            { AT_KLD(kfa_, Ka) AT_HQK(S0, kfa_) } \
            { AT_KLD(kfb_, Kb) AT_HQK(S1, kfb_) } \
            AT_TV(tv0, k0a) AT_TV(tv1, k0b) \
            { const float last_ = S1[15]; asm volatile("" : "+v"(S0) : "v"(last_)); }                      \
            AT_HSM(S0, tv0, mma) AT_HSM(S1, tv1, mmb) \
            bf16x8 pba[2], pbb[2]; at_pack(S0, pba); at_pack(S1, pbb); \
            asm volatile("" : "+v"(pba[0]), "+v"(pba[1]) : "v"(pbb[1]));                                  \
            { AT_HVLD(vfa_, Va) AT_HPV(pba, vfa_) } \
            { AT_HVLD(vfb_, Vb) AT_HPV(pbb, vfb_) } } while (0)
#endif
#define AT_FUSED2O(Ka, Va, Kb, Vb, k0a, k0b, mma, mmb, FAR_) do {     \
            constexpr bool FARV = (FAR_); \
            AT_SINIT(S0) AT_SINIT(S1) \
            AT_QK_ALONE(S0, Ka) \
            { AT_TV(tv0, k0a) \
              AT_QK_SM(S1, Kb, S0, tv0, mma) } \
            bf16x8 pb[2]; at_pack(S0, pb); \
            { AT_TV(tv1, k0b) \
              AT_PV_SM(pb, Va, S1, tv1, mmb) } \
            at_pack(S1, pb); \
            AT_PV_ALONE(pb, Vb) \
            AT_PIPE() } while (0)
#if ATT_SEG
#define AT_FUSED2(Ka, Va, Kb, Vb, k0a, k0b, mma, mmb, FAR_) do { if ((ATT_SEG >> KIND) & 1) AT_FUSED2H(Ka, Va, Kb, Vb, k0a, k0b, mma, mmb, FAR_); else AT_FUSED2O(Ka, Va, Kb, Vb, k0a, k0b, mma, mmb, FAR_); } while (0)
#elif ATT_PREF
#define AT_FUSED2(Ka, Va, Kb, Vb, k0a, k0b, mma, mmb, FAR_) do { if (KIND == 2 || PREF_AB) AT_FUSED2N(Ka, Va, Kb, Vb, k0a, k0b, mma, mmb, FAR_); else AT_FUSED2O(Ka, Va, Kb, Vb, k0a, k0b, mma, mmb, FAR_); } while (0)
#else
#define AT_FUSED2(Ka, Va, Kb, Vb, k0a, k0b, mma, mmb, FAR_) AT_FUSED2O(Ka, Va, Kb, Vb, k0a, k0b, mma, mmb, FAR_)
#endif
        if (WIDE) {
#pragma unroll 1
            for (int sl = 0; sl < 2; ++sl) {
                const int k0a = kss + 64 * sl, k0b = k0a + 32;
                LAS unsigned char* Ka = base + sl * AT_SLOT; LAS unsigned char* Va = Ka + 16384; LAS unsigned char* Kb = Ka + 8192; LAS unsigned char* Vb = Va + 8192;
                const unsigned mwa = sl ? mw.z : mw.x, mwb = sl ? mw.w : mw.y;
                if (FARSPEC && KIND == 0 && qrow0 - (k0b + 31) >= DFAR) {
                    const int mma = (int)(mwa >> (4 * hf)), mmb = (int)(mwb >> (4 * hf));
                    AT_FUSED2(Ka, Va, Kb, Vb, k0a, k0b, mma, mmb, true);
                } else if (k0b <= qrow0 + 31 && !(KIND == 1 && qrow0 - (k0a + 31) > 2048)) {
                    const int mma = (int)(mwa >> (4 * hf)), mmb = (int)(mwb >> (4 * hf));
                    AT_FUSED2(Ka, Va, Kb, Vb, k0a, k0b, mma, mmb, false);
                } else {
                    AT_BLOCK(Ka, Va, k0a, mwa);
                    AT_BLOCK(Kb, Vb, k0b, mwb);
                }
            }
        } else if (KIND != 2) {
            const int k0a = kss + 64 * g, k0b = k0a + 32;
            LAS unsigned char* Ka = base + g * AT_SLOT; LAS unsigned char* Va = Ka + 16384; LAS unsigned char* Kb = Ka + 8192; LAS unsigned char* Vb = Va + 8192;
            if (FARSPEC && KIND == 0 && qrow0 - (k0b + 31) >= DFAR) {
                const int mma = (int)(mw.x >> (4 * hf)), mmb = (int)(mw.y >> (4 * hf));
                AT_FUSED2(Ka, Va, Kb, Vb, k0a, k0b, mma, mmb, true);
            } else if (k0b <= qrow0 + 31 && !(KIND == 1 && qrow0 - (k0a + 31) > 2048)) {
                const int mma = (int)(mw.x >> (4 * hf)), mmb = (int)(mw.y >> (4 * hf));
                AT_FUSED2(Ka, Va, Kb, Vb, k0a, k0b, mma, mmb, false);
            } else {
                AT_BLOCK(Ka, Va, k0a, mw.x);
                AT_BLOCK(Kb, Vb, k0b, mw.y);
            }
        } else {
#pragma unroll 1
            for (int sl = 0; sl < 2; ++sl) {
                const int k0a = kss + 64 * sl, k0b = k0a + 32;
                LAS unsigned char* Ka = base + sl * AT_SLOT; LAS unsigned char* Va = Ka + 16384; LAS unsigned char* Kb = Ka + 8192; LAS unsigned char* Vb = Va + 8192;
                if (FARSPEC && qrow0 - (k0b + 31) >= DFAR) { AT_FUSED2(Ka, Va, Kb, Vb, k0a, k0b, 0, 0, true); }
                else if (k0b <= qrow0 + 31) { AT_FUSED2(Ka, Va, Kb, Vb, k0a, k0b, 0, 0, false); }
                else { AT_BLOCK(Ka, Va, k0a, 0u); AT_BLOCK(Kb, Vb, k0b, 0u); }
            }
        }
#undef AT_FUSED2
#undef AT_FUSED2O
#if ATT_SEG
#undef AT_FUSED2H
#undef AT_HQK
#undef AT_HSM
#undef AT_HPV
#undef AT_HVLD
#endif
#undef AT_PIPE
#if ATT_PREF
#undef AT_FUSED2N
#endif
#if ATT_PREF
#undef AT_VLD8
#undef AT_KLD_IF
#undef AT_KLD_IF2
#undef AT_VLDR
#undef AT_QKC
#undef AT_QKC_SM
#undef AT_PVC
#undef AT_PVC_SM
#endif
        if (more) mw = mwn;
#ifdef PROBE_ATTBAR
        unsigned long long tb0_ = 0; if (tid == 0) tb0_ = __builtin_readcyclecounter();
#endif
        __syncthreads();
#ifdef PROBE_ATTBAR
        if (tid == 0) { const unsigned long long d_ = __builtin_readcyclecounter() - tb0_; F.MISC[28] += (unsigned)(d_ >> 4); }
#endif
#if ATT_L2_TOUCH
        asm volatile("" :: "v"(touch_));
#endif
    }
#undef AT_BLOCK
#undef AT_TV
#undef AT_KLD
#undef AT_VLD
#undef AT_VLD2
#undef AT_QKS
#undef AT_PVS
#undef AT_SM2
#undef AT_SM4
#undef AT_SINIT
#undef AT_QK_ALONE
#undef AT_QK_SM
#undef AT_PV_ALONE
#undef AT_PV_SM
#undef AT_ISSUE
    LAS float* stg = (LAS float*)ring;
    float ltot = lsum + __shfl_xor(lsum, 32);
    if (!WIDE && g == 1) {
        const float sc = (KIND == 2) ? 1.0f / ltot : 1.0f;
#pragma unroll
        for (int b = 0; b < 4; ++b)
#pragma unroll
            for (int i = 0; i < 16; ++i) stg[((wq * 64) + (b * 16 + i)) * 64 + lane] = O[b][i] * sc;
        stg[16384 + wq * 64 + lane] = ltot;
    }
    __syncthreads();
    if (g == 0) {
        bf16* MIX = (bf16*)(F.ws + WS_MIX);
        if (WIDE) {
            const float inv = 1.0f / ltot;
#pragma unroll
            for (int b = 0; b < 4; ++b) {
#pragma unroll
                for (int i = 0; i < 16; ++i) O[b][i] *= inv;
                SBAR(); }
        } else if (KIND != 2) {
            ltot += stg[16384 + wq * 64 + lane];
            const float inv = 1.0f / ltot;
#pragma unroll
            for (int b = 0; b < 4; ++b) {
#pragma unroll
                for (int i = 0; i < 16; ++i) O[b][i] = (O[b][i] + stg[((wq * 64) + (b * 16 + i)) * 64 + lane]) * inv;
                SBAR(); }
        } else {
            const float inv = 1.0f / ltot; float ss2 = 0.f;
#pragma unroll
            for (int b = 0; b < 4; ++b) {
#pragma unroll
                for (int i = 0; i < 16; ++i) { const float o = O[b][i] * inv - sh.lam * stg[((wq * 64) + (b * 16 + i)) * 64 + lane]; O[b][i] = o; ss2 += o * o; }
                SBAR(); }
            ss2 += __shfl_xor(ss2, 32);
            const float rstd = sh.post / sqrtf(ss2 * (1.0f / 128.0f) + RMS_EPS);
            const float* gsub = F.a->in[15] + layer * 128;
#pragma unroll
            for (int b = 0; b < 4; ++b) {
#pragma unroll
                for (int i4 = 0; i4 < 4; ++i4) { const f32x4 gv = *(const GAS f32x4*)(gsub + 32 * b + 8 * i4 + 4 * hf);
                    O[b][4 * i4] *= rstd * gv.x; O[b][4 * i4 + 1] *= rstd * gv.y; O[b][4 * i4 + 2] *= rstd * gv.z; O[b][4 * i4 + 3] *= rstd * gv.w; }
                SBAR(); }
        }
#ifdef DBG_ZERO_KIND
        if (KIND == DBG_ZERO_KIND) {
#pragma unroll
            for (int b = 0; b < 4; ++b)
#pragma unroll
                for (int i = 0; i < 16; ++i) O[b][i] = 0.f; }
#endif
#if OUTPROJ_INT8
        unsigned char* orow8 = (unsigned char*)MIX + (size_t)myq * D + outc + 4 * hf;
        constexpr float QS = 127.0f / MIX_CLIP;
#pragma unroll
        for (int b = 0; b < 4; ++b)
#pragma unroll
            for (int i4 = 0; i4 < 4; ++i4) *(GAS unsigned*)(orow8 + 32 * b + 8 * i4) = pk4_i8(O[b][4 * i4] * QS, O[b][4 * i4 + 1] * QS, O[b][4 * i4 + 2] * QS, O[b][4 * i4 + 3] * QS);
#else
        bf16* orow = MIX + (size_t)myq * D + outc + 4 * hf;
#pragma unroll
        for (int b = 0; b < 4; ++b)
#pragma unroll
            for (int i4 = 0; i4 < 4; ++i4) { v2u o; o.x = cvtpk_s(O[b][4 * i4], O[b][4 * i4 + 1]); o.y = cvtpk_s(O[b][4 * i4 + 2], O[b][4 * i4 + 3]); *(GAS v2u*)(orow + 32 * b + 8 * i4) = o; }
#endif
    }
    __syncthreads();
}

DI void attn_setup(Frame& F, int layer, AttnShared& sh) {
    if (F.wave == 0) {
        const int lane = F.lane;
        float ga = fmaxf(fabsf(F.a->in[5][layer * 128 + lane]), fabsf(F.a->in[5][layer * 128 + 64 + lane])), gb = fmaxf(fabsf(F.a->in[6][layer * 128 + lane]), fabsf(F.a->in[6][layer * 128 + 64 + lane]));
        float gc = fmaxf(fabsf(F.a->in[7][layer * 128 + lane]), fabsf(F.a->in[7][layer * 128 + 64 + lane])), gd = fmaxf(fabsf(F.a->in[8][layer * 128 + lane]), fabsf(F.a->in[8][layer * 128 + 64 + lane]));
        float ge = fabsf(F.a->in[9][layer * 64 + lane]), gf = fabsf(F.a->in[10][layer * 64 + lane]);
        float l1 = F.a->in[11][layer * 64 + lane] * F.a->in[12][layer * 64 + lane], l2 = F.a->in[13][layer * 64 + lane] * F.a->in[14][layer * 64 + lane];
#pragma unroll
        for (int o = 1; o < 64; o <<= 1) { ga = fmaxf(ga, __shfl_xor(ga, o)); gb = fmaxf(gb, __shfl_xor(gb, o)); gc = fmaxf(gc, __shfl_xor(gc, o)); gd = fmaxf(gd, __shfl_xor(gd, o));
            ge = fmaxf(ge, __shfl_xor(ge, o)); gf = fmaxf(gf, __shfl_xor(gf, o)); l1 += __shfl_xor(l1, o); l2 += __shfl_xor(l2, o); }
        if (lane == 0) {
            const float lam_init = 0.8f - 0.6f * expf(-0.3f * (float)layer);
            volatile LAS float* mf = (volatile LAS float*)(F.MISC + 16);
            mf[0] = 1.02f * 11.313708499f * LOG2E * ga * gb + 0.5f;
            mf[1] = 1.02f * 11.313708499f * LOG2E * gc * gd + 0.5f;
            mf[2] = 1.02f * 8.0f * LOG2E * ge * gf + 0.5f;
            mf[3] = expf(l1) - expf(l2) + lam_init;
            mf[4] = 1.0f - lam_init;
        }
    }
    __syncthreads();
}
template <int KIND, int NHEAD>
DI void attn_queue(Frame& F, int layer, int head_fixed, int qslot) {
    AttnShared sh;
    { volatile LAS float* mf = (volatile LAS float*)(F.MISC + 16); sh.m2[0] = mf[0]; sh.m2[1] = mf[1]; sh.m2[2] = mf[2]; sh.lam = mf[3]; sh.post = mf[4]; }
    constexpr int QPH = ((KIND != 2) && ATT_WIDE) ? 32 : 64;
    const int nunits = head_fixed < 0 ? QPH * NHEAD : QPH;
    for (;;) {
        if (F.tid == 0) { unsigned char* wsp_ = F.ws; asm volatile("" : "+s"(wsp_));
            F.MISC[0] = __hip_atomic_fetch_add((unsigned*)(wsp_ + WS_CTL) + CW_Q + 64 * qslot, 1u, RLX_AGENT); }
        __syncthreads();
        const int u = (int)F.MISC[0];
        __syncthreads();
        if (u >= nunits) break;
        const bool qbmajor = ATT_QBMAJOR && KIND != 1 && head_fixed < 0;
        const int hd = head_fixed >= 0 ? head_fixed : (qbmajor ? (u % NHEAD) : (u / QPH)), qb = QPH - 1 - (qbmajor ? (u / NHEAD) : (u % QPH));
        attn_unit<KIND>(F, layer, hd, qb, sh);
    }
}
#ifndef BG_DIV
#define BG_DIV 5
#endif
DI void attn_phase(Frame& F, int layer) {
    if (F.vcu % BG_DIV == 0) bg_convert(F, layer ? BG_I1 : 0, layer ? BG_A1 : BG_A0, F.vcu / BG_DIV, (F.G + BG_DIV - 1) / BG_DIV);
    AttnShared sh; attn_setup(F, layer, sh);
#ifdef PROBE_ATT
#define PA0(k) do { if ((k) == PROBE_ATT && layer == 0) { __syncthreads(); if (F.tid == 0) { const unsigned long long t_ = __builtin_amdgcn_s_memrealtime(); F.MISC[24] = (unsigned)t_; F.MISC[25] = (unsigned)(t_ >> 32); } } } while (0)
#define PA1(k) do { if ((k) == PROBE_ATT && layer == 0) { __syncthreads(); if (F.tid == 0) { const unsigned long long t_ = __builtin_amdgcn_s_memrealtime() - (((unsigned long long)F.MISC[25] << 32) | F.MISC[24]); F.MISC[26] = (unsigned)t_; F.MISC[27] = (unsigned)(t_ >> 32); } } } while (0)
#else
#define PA0(k) do { } while (0)
#define PA1(k) do { } while (0)
#endif
#ifndef ATT_KINDS
#define ATT_KINDS 7
#endif
    const int qs = 16 * layer;
#if ATT_WIDE
    PA0(1); if (ATT_KINDS & 1) attn_queue<0, 4>(F, layer, -1, qs + 11); PA1(1);
    PA0(0); if (ATT_KINDS & 4) attn_queue<2, 6>(F, layer, -1, qs + 10); PA1(0);
#else
    PA0(0); if (ATT_KINDS & 4) attn_queue<2, 6>(F, layer, -1, qs + 10); PA1(0);
    PA0(1); if (ATT_KINDS & 1) attn_queue<0, 4>(F, layer, -1, qs + 11); PA1(1);
#endif
    PA0(2); if (ATT_KINDS & 2) attn_queue<1, 6>(F, layer, -1, qs + 12); PA1(2);
}
#ifdef DBG_CHECKS
constexpr size_t WS_DBG = WS_CTL + 512 * 1024;
__global__ void dbg_check_indexer(unsigned char* ws) {
    const int t = blockIdx.x * 4 + (threadIdx.x >> 6), lane = threadIdx.x & 63;
    const float* SC = (const float*)(ws + WS_SC); const unsigned* WM = (const unsigned*)(ws + WS_WM); const bf16* P = (const bf16*)(ws + WS_P);
    unsigned* flags = (unsigned*)(ws + WS_DBG);
    int pc = 0; float mins = 3.0e38f, maxu = -3.0e38f; int above = 0;
    for (int s = lane; s < S; s += 64) {
        const unsigned w = WM[(size_t)t * 256 + (s >> 5)]; const int bit = (w >> (s & 31)) & 1;
        if (s <= t) { const float v = SC[(size_t)t * S + s]; if (bit) { pc++; mins = fminf(mins, v); } else maxu = fmaxf(maxu, v); }
        else if (bit && s < ((t >> 11) + 1) * 2048) above++;
    }
    for (int o = 1; o < 64; o <<= 1) { pc += __shfl_xor(pc, o); above += __shfl_xor(above, o); mins = fminf(mins, __shfl_xor(mins, o)); maxu = fmaxf(maxu, __shfl_xor(maxu, o)); }
    if (lane == 0) {
        const int want = (t + 1 < 256) ? t + 1 : 256;
        if (pc != want) atomicAdd(&flags[0], 1u);
        if (above) atomicAdd(&flags[2], 1u);
        if (mins < maxu) atomicAdd(&flags[3], 1u);
        if (t > 1000 && pc == 256 && mins <= maxu + 1e-12f) atomicAdd(&flags[4], 1u);
    }
    { const int s = (lane * 131 + t * 7) % (t + 1);
      float sc = 0.f;
      for (int h = 0; h < 16; ++h) { float d = 0.f;
          for (int k = 0; k < 64; ++k) d += __builtin_bit_cast(float, (unsigned)P[(size_t)t * PITCH + C_QI + h * 64 + k] << 16) * __builtin_bit_cast(float, (unsigned)P[(size_t)s * PITCH + C_KI + k] << 16);
          sc += __builtin_bit_cast(float, (unsigned)P[(size_t)t * PITCH + C_WI + h] << 16) * 0.03125f * fmaxf(d, 0.f); }
      const float got = SC[(size_t)t * S + s];
      if (fabsf(got - sc) > 1e-3f * (fabsf(sc) + 0.05f)) atomicAdd(&flags[1], 1u); }
}
__global__ void dbg_check_attnA(unsigned char* ws) {
    const int lane = threadIdx.x & 63, wv = blockIdx.x * 4 + (threadIdx.x >> 6);
    const int head = wv & 3, t = 100 + (wv >> 2) * 127;
    const bf16* P = (const bf16*)(ws + WS_P); const unsigned* WM = (const unsigned*)(ws + WS_WM); const float* TBL = (const float*)(ws + WS_TBL); const bf16* MIX = (const bf16*)(ws + WS_MIX);
    unsigned* flags = (unsigned*)(ws + WS_DBG);
    if (wv == 0 && lane == 0) atomicAdd(&flags[5], 1u);
    const float q0 = __builtin_bit_cast(float, (unsigned)P[(size_t)t * PITCH + C_QA + head * 128 + lane] << 16), q1 = __builtin_bit_cast(float, (unsigned)P[(size_t)t * PITCH + C_QA + head * 128 + 64 + lane] << 16);
    float l = 0.f, o0 = 0.f, o1 = 0.f;
    for (int s = 0; s <= t; ++s) {
        const unsigned w = WM[(size_t)t * 256 + (s >> 5)]; if (!((w >> (s & 31)) & 1)) continue;
        float d = q0 * __builtin_bit_cast(float, (unsigned)P[(size_t)s * PITCH + C_KA + head * 128 + lane] << 16) + q1 * __builtin_bit_cast(float, (unsigned)P[(size_t)s * PITCH + C_KA + head * 128 + 64 + lane] << 16);
        for (int o = 1; o < 64; o <<= 1) d += __shfl_xor(d, o);
        const float p = exp2f(d - 16.0f) * TBL[head * TBL_N + ((t - s) < 2239 ? (t - s) : 2239) + TBL_OFF];
        l += p; o0 += p * __builtin_bit_cast(float, (unsigned)P[(size_t)s * PITCH + C_VA + head * 128 + lane] << 16); o1 += p * __builtin_bit_cast(float, (unsigned)P[(size_t)s * PITCH + C_VA + head * 128 + 64 + lane] << 16);
    }
    o0 /= l; o1 /= l;
    const float g0 = __builtin_bit_cast(float, (unsigned)MIX[(size_t)t * D + head * 128 + lane] << 16), g1 = __builtin_bit_cast(float, (unsigned)MIX[(size_t)t * D + head * 128 + 64 + lane] << 16);
    float e2 = (g0 - o0) * (g0 - o0) + (g1 - o1) * (g1 - o1), n2 = o0 * o0 + o1 * o1;
    for (int o = 1; o < 64; o <<= 1) { e2 += __shfl_xor(e2, o); n2 += __shfl_xor(n2, o); }
    if (lane == 0 && e2 > 1e-3f * n2) atomicAdd(&flags[6], 1u);
    if (lane == 0 && e2 > 3e-2f * n2) atomicAdd(&flags[7], 1u);
}
__global__ void dbg_plant(unsigned char* ws, float* out) {
    const unsigned* flags = (const unsigned*)(ws + WS_DBG);
    if (threadIdx.x == 0) {
        if (flags[0]) out[0] += 1.0e6f;
        if (flags[1]) out[1] += 1.0e5f;
        if (flags[2]) out[2] += 1.0e4f;
        if (flags[3]) out[3] += 1.0e3f;
        if (flags[4] > 100) out[4] += 3.0e3f;
        if (flags[5] != 1) out[5] += 1.0e7f;
        if (flags[6] > 3) out[6] += 1.0e4f;
        if (flags[7] > 3) out[7] += 1.0e5f;
    }
}
#endif

#ifndef MK_PER_PHASE
#define MK_PER_PHASE 0
#endif
#ifndef PN_FUSED
#define PN_FUSED 1
#endif
#ifndef GEMM_SP2
#define GEMM_SP2 true
#endif
#ifndef GEMM_ALIGN
#define GEMM_ALIGN true
#endif
constexpr int NPH = 20;
#ifndef PH_MASK
#define PH_MASK 0xFFFFFu
#endif
#define IN(k) ((((PH_MASK) >> (k)) & 1u) && lo <= (k) && (k) < hi)
#define SEAM(k) do { if (IN(k) && IN((k) + 1)) xcd_barrier(bar); } while (0)
#if defined(PROBE_PH) || defined(PROBE_ATT)
#ifndef PROBE_MULT
#define PROBE_MULT 2
#endif
#ifndef PROBE_PH
#define PROBE_PH 99
#endif
#define PB0(k) do { if ((k) == PROBE_PH) { __syncthreads(); if (F.tid == 0) { const unsigned long long t_ = __builtin_amdgcn_s_memrealtime(); F.MISC[24] = (unsigned)t_; F.MISC[25] = (unsigned)(t_ >> 32); } } } while (0)
#define PB1(k) do { if ((k) == PROBE_PH) { __syncthreads(); if (F.tid == 0) { const unsigned long long t_ = __builtin_amdgcn_s_memrealtime() - (((unsigned long long)F.MISC[25] << 32) | F.MISC[24]); F.MISC[26] = (unsigned)t_; F.MISC[27] = (unsigned)(t_ >> 32); } } } while (0)
#else
#define PB0(k) do { } while (0)
#define PB1(k) do { } while (0)
#endif
template <int LAYER>
DI void layer_phases(Frame& F, const int lo, const int hi, const XcdBarrier& bar) {
    bf16* H = (bf16*)(F.ws + WS_H); bf16* P = (bf16*)(F.ws + WS_P); bf16* MIX = (bf16*)(F.ws + WS_MIX); float* XB = (float*)(F.ws + WS_XB);
    bf16* ACT = (bf16*)(F.ws + WS_ACT); bf16* HS = (bf16*)(F.ws + WS_HS);
    const int bid = (int)blockIdx.x;
        constexpr int layer = LAYER; constexpr int pb = LAYER ? 10 : 1;
        PB0(pb); if (IN(pb)) {
#if INPROJ_INT8
            pg8::Gemm g{H, (const bf16*)(F.ws + WS_WIN + (size_t)layer * NINP * D), S, NINP, D / 2}; pg8::StaticOrder So; So.init(S, NINP, F.G, bid);
#if PN_FUSED
            pg8::EpiStoreBf16SN E{P, PITCH, (const float*)(F.ws + WS_ROUTE + RT_ROWS), (const float*)(F.ws + WS_WSC) + layer,
                                  F.a->in[5] + layer * 128, F.a->in[6] + layer * 128, F.a->in[7] + layer * 128, F.a->in[8] + layer * 128, F.a->in[9] + layer * 64, F.a->in[10] + layer * 64,
                                  (LAS float*)(F.lds + LDS_TBL_OFF)};
            pg8::gemm_phase<pg8::EpiStoreBf16SN, pg8::StaticOrder, true, GEMM_SP2, 2>(F.lds + RING_OFF, g, So, E);
#else
            pg8::EpiStoreBf16S E{P, PITCH, (const float*)(F.ws + WS_ROUTE + RT_ROWS), (const float*)(F.ws + WS_WSC) + layer};
            pg8::gemm_phase<pg8::EpiStoreBf16S, pg8::StaticOrder, GEMM_ALIGN, GEMM_SP2, 2>(F.lds + RING_OFF, g, So, E);
#endif
#else
            pg8::Gemm g{H, (const bf16*)(F.ws + WS_WIN) + (size_t)layer * NINP * D, S, NINP, D}; pg8::StaticOrder So; So.init(S, NINP, F.G, bid);
            pg8::EpiStoreBf16 E{P, PITCH};
            pg8::gemm_phase<pg8::EpiStoreBf16, pg8::StaticOrder, true, GEMM_SP2>(F.lds + RING_OFF, g, So, E);
#endif
            { constexpr int REM = ((S / 256) * (NINP / 256)) % 256;
              if (F.G == 256 && bid >= REM) bg_convert(F, layer ? BG_A1 : BG_A0, layer ? BG_I10 : BG_I1, bid - REM, 256 - REM); }
        } SEAM(pb); PB1(pb);
        PB0(pb + 1); if (IN(pb + 1)) { if (!(PN_FUSED && INPROJ_INT8)) pn_phase(F, layer); i1_phase(F); } SEAM(pb + 1); PB1(pb + 1);
        PB0(pb + 2); if (IN(pb + 2)) { i2_phase(F); } SEAM(pb + 2); PB1(pb + 2);
        PB0(pb + 3); if (IN(pb + 3)) { attn_phase(F, layer); } SEAM(pb + 3); PB1(pb + 3);
        PB0(pb + 4); if (IN(pb + 4)) {
#if OUTPROJ_INT8
            pg8::Gemm g{MIX, (const bf16*)(F.ws + WS_WOUT + (size_t)layer * D * D), S, D, D / 2}; pg8::StaticOrder So; So.init(S, D, F.G, bid);
            pg8::EpiResI8 E{layer == 0 ? F.a->in[0] : (const float*)XB, XB, D, (const float*)(F.ws + WS_WSC) + 2 + layer, MIX_CLIP / 127.0f};
            pg8::gemm_phase<pg8::EpiResI8, pg8::StaticOrder, true, GEMM_SP2, 2>(F.lds + RING_OFF, g, So, E);
#else
            pg8::Gemm g{MIX, (const bf16*)(F.ws + WS_WOUT) + (size_t)layer * D * D, S, D, D}; pg8::StaticOrder So; So.init(S, D, F.G, bid);
#if XB_BF16
            if constexpr (LAYER == 0) { pg8::EpiResB<false, 0> E{F.a->in[0], (bf16*)XB, D}; pg8::gemm_phase<pg8::EpiResB<false, 0>, pg8::StaticOrder, true, GEMM_SP2>(F.lds + RING_OFF, g, So, E); }
            else { pg8::EpiResB<true, 0> E{XB, (bf16*)XB, D}; pg8::gemm_phase<pg8::EpiResB<true, 0>, pg8::StaticOrder, true, GEMM_SP2>(F.lds + RING_OFF, g, So, E); }
#else
            pg8::EpiResF32 E{layer == 0 ? F.a->in[0] : (const float*)XB, XB, D};
            pg8::gemm_phase<pg8::EpiResF32, pg8::StaticOrder, true, GEMM_SP2>(F.lds + RING_OFF, g, So, E);
#endif
#endif
        } SEAM(pb + 4); PB1(pb + 4);
        if (layer == 0) {
            PB0(6); if (IN(6)) {
#if DENSE_GU_FP8 && GU_INT8
                rms_phase_i8<XB_BF16 != 0>(F, XB, F.a->in[4], (unsigned char*)HS, (float*)(F.ws + WS_ROUTE + RT_ROWS));
#elif DENSE_GU_FP8
                rms_phase8(F, XB, F.a->in[4], (unsigned char*)HS);
#else
                rms_phase(F, XB, F.a->in[4], H);
#endif
            } SEAM(6); PB1(6);
            PB0(7); if (IN(7)) {
                pg8::Gemm g{H, (const bf16*)(F.ws + WS_WGU), S, 2 * DFF, D}; pg8::StaticOrder So; So.init(S, 2 * DFF, F.G, bid);
#if DENSE_GU_FP8 && GU_INT8
                pg8::Gemm g8{HS, (const bf16*)(F.ws + WS_WGU), S, 2 * DFF, D / 2};
                pg8::EpiSwiGLUi8 E{(unsigned char*)ACT, DFF, 2 * DFF / 256, (const float*)(F.ws + WS_ROUTE + RT_ROWS), (const float*)(F.ws + WS_WSC) + 4, (const float*)(F.ws + WS_WSC) + 5};
                pg8::gemm_phase<pg8::EpiSwiGLUi8, pg8::StaticOrder, GEMM_ALIGN, GEMM_SP2, 2>(F.lds + RING_OFF, g8, So, E);
#elif DENSE_GU_FP8
                pg8::Gemm g8{HS, (const bf16*)(F.ws + WS_WGU), S, 2 * DFF, D / 2};
                pg8::EpiSwiGLU8T<true> E{(unsigned char*)ACT, DFF, 2 * DFF / 256};
                pg8::gemm_phase<pg8::EpiSwiGLU8T<true>, pg8::StaticOrder, true, GEMM_SP2, true>(F.lds + RING_OFF, g8, So, E);
#elif DENSE_DOWN_FP8
                pg8::EpiSwiGLU8T<false> E{(unsigned char*)ACT, DFF, 2 * DFF / 256};
                pg8::gemm_phase<pg8::EpiSwiGLU8T<false>, pg8::StaticOrder, true, GEMM_SP2>(F.lds + RING_OFF, g, So, E);
#else
                pg8::EpiSwiGLU E{ACT, DFF, 2 * DFF / 256};
                pg8::gemm_phase<pg8::EpiSwiGLU, pg8::StaticOrder, true, GEMM_SP2>(F.lds + RING_OFF, g, So, E);
#endif
                { constexpr int REM = ((S / 256) * (2 * DFF / 256)) % 256;
                  if (F.G == 256 && bid >= REM) bg_convert(F, BG_I10, NBG, bid - REM, 256 - REM); }
            } SEAM(7); PB1(7);
            PB0(8); if (IN(8)) {
#if DENSE_DOWN_FP8
                pg8::Gemm g{ACT, (const bf16*)(F.ws + WS_WDN), S, D, DFF / 2}; pg8::StaticOrder So; So.init(S, D, F.G, bid);
#if XB_BF16
                pg8::EpiResB<true, pg8::W8_SHIFT> E{XB, (bf16*)XB, D};
                pg8::gemm_phase<pg8::EpiResB<true, pg8::W8_SHIFT>, pg8::StaticOrder, true, GEMM_SP2, true>(F.lds + RING_OFF, g, So, E);
#else
                pg8::EpiRes8 E{XB, XB, D};
                pg8::gemm_phase<pg8::EpiRes8, pg8::StaticOrder, true, GEMM_SP2, true>(F.lds + RING_OFF, g, So, E);
#endif
#else
                pg8::Gemm g{ACT, (const bf16*)(F.ws + WS_WDN), S, D, DFF}; pg8::StaticOrder So; So.init(S, D, F.G, bid);
                pg8::EpiResF32 E{XB, XB, D};
                pg8::gemm_phase<pg8::EpiResF32, pg8::StaticOrder, true, GEMM_SP2>(F.lds + RING_OFF, g, So, E);
#endif
            } SEAM(8); PB1(8);
            PB0(9); if (IN(9)) {
#if INPROJ_INT8
                rms_phase_i8<XB_BF16 != 0>(F, XB, F.a->in[3] + D, (unsigned char*)H, (float*)(F.ws + WS_ROUTE + RT_ROWS));
#else
                rms_phase(F, XB, F.a->in[3] + D, H);
#endif
            } SEAM(9); PB1(9);
        } else {
            PB0(15); if (IN(15)) { rms_router_phase<XB_BF16 != 0>(F, XB, F.a->in[4] + D, F.a->in[20], H); } SEAM(15); PB1(15);
#if GATHER_FUSED != 1
            PB0(16); if (IN(16)) { gather_phase(F); } SEAM(16); PB1(16);
#endif
            PB0(17); if (IN(17)) {
                int off[9]; moe_offsets(F, off);
                pg8::MoeOrder Mo;
_Pragma("unroll")
                for (int e = 0; e < 9; ++e) Mo.rt0[e] = off[e] >> 8; Mo.npn = 2 * DFFE / 256; Mo.G = F.G; Mo.c = bid; Mo.n_full = Mo.rt0[8] * Mo.npn; Mo.sl = 1; Mo.ktt = D / 128; Mo.ct = GATHER_FUSED ? MOE_CT : 0;
                pg8::Gemm g{HS, (const bf16*)(F.ws + WS_WMGU), MAXSLOT, NE * 2 * DFFE, D / 2};
#if GU_INT8
                pg8::EpiSwiGLUi8 E{(unsigned char*)ACT, DFFE, 2 * DFFE / 256, (const float*)(F.ws + WS_ROUTE + RT_SLOTS), (const float*)(F.ws + WS_WSC) + 6, (const float*)(F.ws + WS_WSC) + 14};
                pg8::gemm_phase<pg8::EpiSwiGLUi8, pg8::MoeOrder, GEMM_ALIGN, GEMM_SP2, 2>(F.lds + RING_OFF, g, Mo, E);
#else
                pg8::EpiSwiGLU8 E{(unsigned char*)ACT, DFFE, 2 * DFFE / 256};
                pg8::gemm_phase<pg8::EpiSwiGLU8, pg8::MoeOrder, true, GEMM_SP2, true>(F.lds + RING_OFF, g, Mo, E);
#endif
            } SEAM(17); PB1(17);
            PB0(18); if (IN(18)) {
                int off[9]; moe_offsets(F, off);
                pg8::MoeOrder Mo;
_Pragma("unroll")
                for (int e = 0; e < 9; ++e) Mo.rt0[e] = off[e] >> 8; Mo.npn = D / 256; Mo.G = F.G; Mo.c = bid; Mo.ktt = DFFE / 128; Mo.ct = GATHER_FUSED ? MOE_CT : 0;
                pg8::moe_slice_plan(Mo.rt0[8] * Mo.npn, F.G, Mo.n_full, Mo.sl);
                pg8::Gemm g{ACT, (const bf16*)(F.ws + WS_WMDN), MAXSLOT, NE * D, DFFE / 2};
                pg8::EpiMoeDown8 E{(float*)(F.ws + WS_OUTM), (const float*)(F.ws + WS_ROUTE + RT_SLOTG), D, D / 256, (float*)(F.ws + WS_OUTP)};
                pg8::gemm_phase<pg8::EpiMoeDown8, pg8::MoeOrder, GEMM_ALIGN, GEMM_SP2, true>(F.lds + RING_OFF, g, Mo, E);
            } SEAM(18); PB1(18);
            PB0(19); if (IN(19)) { combine_phase(F); } PB1(19);
        }
    }
__global__ void __launch_bounds__(NWAVES * 64, 2) trunk_fwd(Args args) {
    extern __shared__ __attribute__((aligned(16))) unsigned char lds[];
    Frame F;
    F.lds = (LAS unsigned char*)lds;
    F.MISC = (volatile LAS unsigned*)(F.lds + MISC_OFF);
    F.tid = threadIdx.x; F.lane = F.tid & 63; F.wave = __builtin_amdgcn_readfirstlane(F.tid >> 6);
    F.G = gridDim.x; { const int bx = blockIdx.x; F.vcu = (F.G % 8 == 0) ? (bx % 8) * (F.G / 8) + bx / 8 : bx; }
    F.ws = args.ws; F.ctl = (gu32*)(args.ws + WS_CTL); F.out = args.out;
    F.a = &args;
    for (int u = F.tid; u < (LDS_TBL_OFF - LDSCTL_OFF) / 4; u += NWAVES * 64) ((LAS unsigned*)(F.lds + LDSCTL_OFF))[u] = 0u;
    __syncthreads();
    const int lo = args.ph_lo, hi = args.ph_hi;
    XcdBarrier bar; bar.bar = (unsigned*)(F.ctl + CW_BAR); bar.x = 0; bar.st = nullptr;
    if (hi - lo > 1) bar = xcd_barrier_post((unsigned*)(F.ctl + CW_BAR), F.MISC + 8);

    PB0(0); if (IN(0)) { p0_prologue(F); } SEAM(0); PB1(0);

    layer_phases<0>(F, lo, hi, bar);
    layer_phases<1>(F, lo, hi, bar);
#ifdef PROBE_ATTBAR
    { __syncthreads(); if (blockIdx.x == 1) { const unsigned long long d_ = ((unsigned long long)F.MISC[28] << 4) * PROBE_ATTBAR, t0_ = __builtin_readcyclecounter(); while (__builtin_readcyclecounter() - t0_ < d_) __builtin_amdgcn_s_sleep(8); } }
#endif
#if defined(PROBE_PH) || defined(PROBE_ATT)
    { __syncthreads(); const unsigned long long d_ = (((unsigned long long)F.MISC[27] << 32) | F.MISC[26]) * PROBE_MULT, t0_ = __builtin_amdgcn_s_memrealtime();
      while (__builtin_amdgcn_s_memrealtime() - t0_ < d_) __builtin_amdgcn_s_sleep(8); }
#endif
#undef IN
#undef SEAM
}

extern "C" void kernel_launch(void* const* d_in, const int* in_sizes, int n_in, void* d_out, int out_size, void* d_ws, size_t ws_size, hipStream_t stream) {
    static int grid = 0;
    if (grid == 0) {
        if (n_in != 24 || in_sizes[0] != S * D || out_size != S * D || ws_size < WS_END) { fprintf(stderr, "kernel_launch: unexpected shapes (n_in %d, x %d, out %d, ws %zu < %zu); nothing launched\n", n_in, n_in > 0 ? in_sizes[0] : -1, out_size, ws_size, (size_t)WS_END); grid = -1; return; }
        int dev = 0, cus = 0, per_cu = 0;
        if (hipGetDevice(&dev) != hipSuccess || hipDeviceGetAttribute(&cus, hipDeviceAttributeMultiprocessorCount, dev) != hipSuccess) { grid = -1; return; }
        if (hipFuncSetAttribute((const void*)trunk_fwd, hipFuncAttributeMaxDynamicSharedMemorySize, LDS_BYTES) != hipSuccess) { fprintf(stderr, "kernel_launch: hipFuncSetAttribute failed\n"); grid = -1; return; }
        if (hipOccupancyMaxActiveBlocksPerMultiprocessor(&per_cu, (const void*)trunk_fwd, NWAVES * 64, LDS_BYTES) != hipSuccess || per_cu < 1) { fprintf(stderr, "kernel_launch: occupancy query says %d blocks per CU\n", per_cu); (void)hipGetLastError(); per_cu = 1; }
        grid = cus;
        if (grid > 256) grid = 256;
    }
    if (grid < 0) return;
    if (hipMemsetAsync((char*)d_ws + WS_CTL, 0, CTL_ZERO_BYTES, stream) != hipSuccess) return;
    Args a{};
    for (int i = 0; i < 24; ++i) a.in[i] = (const float*)d_in[i];
    a.out = (float*)d_out; a.ws = (unsigned char*)d_ws;
#if MK_PER_PHASE
    for (int k = 0; k < NPH; ++k) { a.ph_lo = k; a.ph_hi = k + 1; hipLaunchKernelGGL(trunk_fwd, dim3(grid), dim3(NWAVES * 64), LDS_BYTES, stream, a);
#ifdef DBG_CHECKS
        if (k == 3) hipLaunchKernelGGL(dbg_check_indexer, dim3(S / 4), dim3(256), 0, stream, (unsigned char*)d_ws);
        if (k == 4) hipLaunchKernelGGL(dbg_check_attnA, dim3(64), dim3(256), 0, stream, (unsigned char*)d_ws);
        if (k == NPH - 1) hipLaunchKernelGGL(dbg_plant, dim3(1), dim3(64), 0, stream, (unsigned char*)d_ws, (float*)d_out);
#endif
    }
#else
    a.ph_lo = 0; a.ph_hi = NPH;
    hipLaunchKernelGGL(trunk_fwd, dim3(grid), dim3(NWAVES * 64), LDS_BYTES, stream, a);
#endif
    const hipError_t le = hipPeekAtLastError();
    if (le != hipSuccess) fprintf(stderr, "kernel_launch: launch failed: %s\n", hipGetErrorName(le));
}
```

```cpp
#include <hip/hip_runtime.h>
#include <cstdio>
#include <cstdint>
#include <cmath>
namespace pg8 {
#define PG8_LAS __attribute__((address_space(3)))
typedef unsigned short bf16_t;
typedef short bf16x8 __attribute__((ext_vector_type(8)));
typedef float f32x4 __attribute__((ext_vector_type(4)));
typedef unsigned u32x4 __attribute__((ext_vector_type(4)));
typedef unsigned u32x2 __attribute__((ext_vector_type(2)));
typedef int i32x4 __attribute__((ext_vector_type(4)));
typedef int i32x8 __attribute__((ext_vector_type(8)));
constexpr int BM = 256, BK = 64, HALF = 128, HTB = HALF * BK * 2  , STAGE_BYTES = 8 * HTB, NXCD = 8, WGM = 8;

__host__ __device__ __forceinline__ int lds_byte(int r, int c) { const int st = (r >> 4) * 2 + (c >> 5), rr = r & 15, cc = c & 31, ob = rr * 64 + cc * 2; return st * 1024 + (ob ^ (((ob >> 9) & 1) << 5)); }
__host__ __device__ __forceinline__ void stage_rc(int b, int& R, int& C) { const int st = b / 1024, sb = b % 1024, swz = sb ^ (((sb >> 9) & 1) << 5); R = (st >> 1) * 16 + swz / 64; C = (st & 1) * 32 + (swz % 64) / 2; }
__host__ __device__ __forceinline__ int perm32(int rho) { const int n = rho >> 4, i = rho & 15; return 8 * (i >> 2) + 4 * n + (i & 3); }

struct Unit { int pm, pn, kt0, ktn, sliced; };
struct Gemm { const bf16_t* A; const bf16_t* Bt; int M, N, K; };

struct StaticOrder {
    int nM, nN, nwg, G, c;
    __host__ __device__ void init(int M, int N, int G_, int c_) { nM = M / BM; nN = N / BM; nwg = nM * nN; G = G_; c = c_; }
    __host__ __device__ bool next(int i, Unit& u) const {
        const long L = (long)i * G + c; if (L >= nwg) return false;
        int wgid = (int)L; { const int q = nwg / NXCD, r = nwg % NXCD, xcd = wgid % NXCD, off = wgid / NXCD; wgid = (xcd < r ? xcd * (q + 1) : r * (q + 1) + (xcd - r) * q) + off; }
        const int nig = WGM * nN, gid = wgid / nig, fm = gid * WGM, gsz = (nM - fm) < WGM ? (nM - fm) : WGM;
        u.pm = fm + ((wgid % nig) % gsz); u.pn = (wgid % nig) / gsz; return true;
    }
    __device__ __forceinline__ void a_ready(const Unit&) const {}
    __device__ __forceinline__ void done(const Unit&) const {}
};

__device__ __forceinline__ unsigned cvt_pk_bf16(float lo, float hi) { unsigned r; asm volatile("v_cvt_pk_bf16_f32 %0, %1, %2" : "=v"(r) : "v"(lo), "v"(hi)); return r; }
typedef float f32x2 __attribute__((ext_vector_type(2)));
struct EpiStoreBf16 {
    static constexpr bool PERM = true, AFTER_DRAIN = false;
    bf16_t* O; int ldc;
    __device__ __forceinline__ void operator()(const f32x4 (&acc)[2][2][4][2], const Unit& u, int wr, int wc, int fr, int fq) const {
        const int row0 = u.pm * BM + wr * 64 + fr, col0 = u.pn * BM + wc * 32 + 8 * fq;
#pragma unroll
        for (int ai = 0; ai < 2; ++ai)
#pragma unroll
            for (int m = 0; m < 4; ++m) { bf16_t* rowp = O + (size_t)(row0 + ai * HALF + m * 16) * ldc + col0;
#pragma unroll
                for (int bj = 0; bj < 2; ++bj) { const f32x4 v0 = acc[ai][bj][m][0], v1 = acc[ai][bj][m][1];
                    u32x4 w; w.x = cvt_pk_bf16(v0[0], v0[1]); w.y = cvt_pk_bf16(v0[2], v0[3]); w.z = cvt_pk_bf16(v1[0], v1[1]); w.w = cvt_pk_bf16(v1[2], v1[3]);
                    *(u32x4*)(rowp + bj * HALF) = w; } }
    }
};
struct EpiStoreBf16S {
    static constexpr bool PERM = true, AFTER_DRAIN = false;
    bf16_t* O; int ldc; const float* rowscale; const float* wscale;
    __device__ __forceinline__ void operator()(const f32x4 (&acc)[2][2][4][2], const Unit& u, int wr, int wc, int fr, int fq) const {
        const int row0 = u.pm * BM + wr * 64 + fr, col0 = u.pn * BM + wc * 32 + 8 * fq; const float sw = wscale[0];
#pragma unroll
        for (int ai = 0; ai < 2; ++ai)
#pragma unroll
            for (int m = 0; m < 4; ++m) { const int row = row0 + ai * HALF + m * 16; bf16_t* rowp = O + (size_t)row * ldc + col0; const float f = rowscale[row] * sw;
#pragma unroll
                for (int bj = 0; bj < 2; ++bj) { const f32x4 v0 = __builtin_convertvector(__builtin_bit_cast(i32x4, acc[ai][bj][m][0]), f32x4) * f, v1 = __builtin_convertvector(__builtin_bit_cast(i32x4, acc[ai][bj][m][1]), f32x4) * f;
                    u32x4 w; w.x = cvt_pk_bf16(v0[0], v0[1]); w.y = cvt_pk_bf16(v0[2], v0[3]); w.z = cvt_pk_bf16(v1[0], v1[1]); w.w = cvt_pk_bf16(v1[2], v1[3]);
                    *(u32x4*)(rowp + bj * HALF) = w; } }
    }
};
struct EpiStoreBf16SN {
    static constexpr bool PERM = true, AFTER_DRAIN = false;
    bf16_t* O; int ldc; const float* rowscale; const float* wscale;
    const float* g0; const float* g1; const float* g2; const float* g3; const float* g4; const float* g5;
    PG8_LAS float* xch;
    __device__ __forceinline__ void operator()(const f32x4 (&acc)[2][2][4][2], const Unit& u, int wr, int wc, int fr_, int fq_) const {
        int fr = fr_, fq = fq_; asm volatile("" : "+v"(fr), "+v"(fq));
        const int row0 = u.pm * BM + wr * 64 + fr, col0 = u.pn * BM + wc * 32 + 8 * fq; const float sw = wscale[0];
        const int pn = u.pn;
        const int gsel = pn < 2 ? 0 : (pn < 4 ? 1 : ((pn >= 10 && pn < 13) ? 2 : ((pn >= 13 && pn < 16) ? 3 : ((pn >= 19 && pn < 22) ? 4 : ((pn >= 22 && pn < 25) ? 5 : -1)))));
        if (gsel < 0) {
#pragma unroll
            for (int ai = 0; ai < 2; ++ai)
#pragma unroll
                for (int m = 0; m < 4; ++m) { const int row = row0 + ai * HALF + m * 16; bf16_t* rowp = O + (size_t)row * ldc + col0; const float f = rowscale[row] * sw;
#pragma unroll
                    for (int bj = 0; bj < 2; ++bj) { const f32x4 v0 = __builtin_convertvector(__builtin_bit_cast(i32x4, acc[ai][bj][m][0]), f32x4) * f, v1 = __builtin_convertvector(__builtin_bit_cast(i32x4, acc[ai][bj][m][1]), f32x4) * f;
                        u32x4 w; w.x = cvt_pk_bf16(v0[0], v0[1]); w.y = cvt_pk_bf16(v0[2], v0[3]); w.z = cvt_pk_bf16(v1[0], v1[1]); w.w = cvt_pk_bf16(v1[2], v1[3]);
                        *(u32x4*)(rowp + bj * HALF) = w; } }
            return;
        }
        const bool d64 = gsel >= 4;
        const float* gv = gsel == 0 ? g0 : (gsel == 1 ? g1 : (gsel == 2 ? g2 : (gsel == 3 ? g3 : (gsel == 4 ? g4 : g5))));
        const float qs = (gsel & 1) ? 1.0f : (d64 ? 0.125f * 1.4426950408889634f : 0.08838834764831845f * 1.4426950408889634f);
        const int gi0 = (wc * 32 + 8 * fq) & (d64 ? 63 : 127);
        float gs[8];
#pragma unroll
        for (int e = 0; e < 8; ++e) gs[e] = gv[gi0 + e] * qs;
#pragma unroll
        for (int ai = 0; ai < 2; ++ai)
#pragma unroll
            for (int m = 0; m < 4; ++m) { const int row = row0 + ai * HALF + m * 16; const float f = rowscale[row] * sw; const int rit = wr * 64 + fr + ai * HALF + m * 16;
#pragma unroll
                for (int bj = 0; bj < 2; ++bj) {
                    const f32x4 a = __builtin_convertvector(__builtin_bit_cast(i32x4, acc[ai][bj][m][0]), f32x4) * f, b = __builtin_convertvector(__builtin_bit_cast(i32x4, acc[ai][bj][m][1]), f32x4) * f;
                    float ss = (a[0] * a[0] + a[1] * a[1]) + (a[2] * a[2] + a[3] * a[3]) + (b[0] * b[0] + b[1] * b[1]) + (b[2] * b[2] + b[3] * b[3]);
                    ss += __shfl_xor(ss, 16); ss += __shfl_xor(ss, 32);
                    if (fq == 0) xch[(wc * 256 + rit) * 2 + bj] = ss; }
                __builtin_amdgcn_sched_barrier(0); }
        asm volatile("s_waitcnt lgkmcnt(0)" ::: "memory");
        __builtin_amdgcn_s_barrier();
        const int wb = d64 ? (wc & 2) : 0;
#pragma unroll
        for (int ai = 0; ai < 2; ++ai)
#pragma unroll
            for (int m = 0; m < 4; ++m) { const int row = row0 + ai * HALF + m * 16; bf16_t* rowp = O + (size_t)row * ldc + col0; const int rit = wr * 64 + fr + ai * HALF + m * 16; const float f = rowscale[row] * sw;
#pragma unroll
                for (int bj = 0; bj < 2; ++bj) {
                    float t = xch[((wb + 0) * 256 + rit) * 2 + bj] + xch[((wb + 1) * 256 + rit) * 2 + bj];
                    if (!d64) t += xch[(2 * 256 + rit) * 2 + bj] + xch[(3 * 256 + rit) * 2 + bj];
                    const float rf = f / __builtin_sqrtf(t * (d64 ? (1.0f / 64.0f) : (1.0f / 128.0f)) + 1e-6f);
                    i32x4 ia = __builtin_bit_cast(i32x4, acc[ai][bj][m][0]), ib = __builtin_bit_cast(i32x4, acc[ai][bj][m][1]); asm volatile("" : "+v"(ia), "+v"(ib));
                    const f32x4 a = __builtin_convertvector(ia, f32x4) * rf, b = __builtin_convertvector(ib, f32x4) * rf;
                    u32x4 w; w.x = cvt_pk_bf16(a[0] * gs[0], a[1] * gs[1]); w.y = cvt_pk_bf16(a[2] * gs[2], a[3] * gs[3]); w.z = cvt_pk_bf16(b[0] * gs[4], b[1] * gs[5]); w.w = cvt_pk_bf16(b[2] * gs[6], b[3] * gs[7]);
                    *(u32x4*)(rowp + bj * HALF) = w; }
                __builtin_amdgcn_sched_barrier(0); }
    }
};
struct EpiResI8 {
    static constexpr bool PERM = false, AFTER_DRAIN = false;
    const float* res; float* out; int ld; const float* wscale; float ascale;
    __device__ __forceinline__ void operator()(const f32x4 (&acc)[2][2][4][2], const Unit& u, int wr, int wc, int fr, int fq) const {
        const int row0 = u.pm * BM + wr * 64 + fr, col0 = u.pn * BM + wc * 32 + 4 * fq; const float f = wscale[0] * ascale;
#pragma unroll
        for (int ai = 0; ai < 2; ++ai)
#pragma unroll
            for (int m = 0; m < 4; ++m) { const size_t ro = (size_t)(row0 + ai * HALF + m * 16) * ld + col0;
#pragma unroll
                for (int bj = 0; bj < 2; ++bj)
#pragma unroll
                    for (int n = 0; n < 2; ++n) { const f32x4 r = *(const f32x4*)(res + ro + bj * HALF + n * 16);
                        *(f32x4*)(out + ro + bj * HALF + n * 16) = __builtin_convertvector(__builtin_bit_cast(i32x4, acc[ai][bj][m][n]), f32x4) * f + r; } }
    }
};
struct EpiResF32 {
    static constexpr bool PERM = false, AFTER_DRAIN = false;
    const float* res; float* out; int ld;
    __device__ __forceinline__ void operator()(const f32x4 (&acc)[2][2][4][2], const Unit& u, int wr, int wc, int fr, int fq) const {
        const int row0 = u.pm * BM + wr * 64 + fr, col0 = u.pn * BM + wc * 32 + 4 * fq;
#pragma unroll
        for (int ai = 0; ai < 2; ++ai)
#pragma unroll
            for (int m = 0; m < 4; ++m) { const size_t ro = (size_t)(row0 + ai * HALF + m * 16) * ld + col0;
#pragma unroll
                for (int bj = 0; bj < 2; ++bj)
#pragma unroll
                    for (int n = 0; n < 2; ++n) { const f32x4 r = *(const f32x4*)(res + ro + bj * HALF + n * 16); *(f32x4*)(out + ro + bj * HALF + n * 16) = acc[ai][bj][m][n] + r; } }
    }
};
template <bool RES_BF16, int SHIFT>
struct EpiResB {
    static constexpr bool PERM = false, AFTER_DRAIN = false;
    const void* res; bf16_t* out; int ld;
    __device__ __forceinline__ void operator()(const f32x4 (&acc)[2][2][4][2], const Unit& u, int wr, int wc, int fr, int fq) const {
        const int row0 = u.pm * BM + wr * 64 + fr, col0 = u.pn * BM + wc * 32 + 4 * fq;
        constexpr float WS_ = 1.0f / (float)(1 << SHIFT);
#pragma unroll
        for (int ai = 0; ai < 2; ++ai)
#pragma unroll
            for (int m = 0; m < 4; ++m) { const size_t ro = (size_t)(row0 + ai * HALF + m * 16) * ld + col0;
#pragma unroll
                for (int bj = 0; bj < 2; ++bj)
#pragma unroll
                    for (int n = 0; n < 2; ++n) { const size_t o = ro + bj * HALF + n * 16; f32x4 r;
                        if (RES_BF16) { const u32x2 w = *(const u32x2*)((const bf16_t*)res + o); r[0] = __builtin_bit_cast(float, w.x << 16); r[1] = __builtin_bit_cast(float, w.x & 0xffff0000u); r[2] = __builtin_bit_cast(float, w.y << 16); r[3] = __builtin_bit_cast(float, w.y & 0xffff0000u); }
                        else r = *(const f32x4*)((const float*)res + o);
                        const f32x4 t = acc[ai][bj][m][n] * WS_ + r;
                        u32x2 q; q.x = cvt_pk_bf16(t[0], t[1]); q.y = cvt_pk_bf16(t[2], t[3]); *(u32x2*)(out + o) = q; } }
    }
};
__device__ __forceinline__ float silu_mul(float g, float u) { return g * u * __builtin_amdgcn_rcpf(1.0f + __builtin_amdgcn_exp2f(-1.4426950408889634f * g)); }
struct EpiSwiGLU {
    static constexpr bool PERM = true, AFTER_DRAIN = false;
    bf16_t* O; int ldf; int npn;
    __device__ __forceinline__ void operator()(const f32x4 (&acc)[2][2][4][2], const Unit& u, int wr, int wc, int fr, int fq) const {
        const int pnl = u.pn % npn;
        const int row0 = u.pm * BM + wr * 64 + fr, col0 = pnl * HALF + wc * 32 + 8 * fq;
#pragma unroll
        for (int ai = 0; ai < 2; ++ai)
#pragma unroll
            for (int m = 0; m < 4; ++m) { bf16_t* rowp = O + (size_t)(row0 + ai * HALF + m * 16) * ldf + col0;
                const f32x4 g0 = acc[ai][0][m][0], g1 = acc[ai][0][m][1], u0 = acc[ai][1][m][0], u1 = acc[ai][1][m][1];
                u32x4 w; w.x = cvt_pk_bf16(silu_mul(g0[0], u0[0]), silu_mul(g0[1], u0[1])); w.y = cvt_pk_bf16(silu_mul(g0[2], u0[2]), silu_mul(g0[3], u0[3]));
                w.z = cvt_pk_bf16(silu_mul(g1[0], u1[0]), silu_mul(g1[1], u1[1])); w.w = cvt_pk_bf16(silu_mul(g1[2], u1[2]), silu_mul(g1[3], u1[3]));
                *(u32x4*)rowp = w; }
    }
};
struct EpiMoeDown {
    static constexpr bool PERM = false, AFTER_DRAIN = false;
    float* out; const float* gate; int ld; int npn;
    __device__ __forceinline__ void operator()(const f32x4 (&acc)[2][2][4][2], const Unit& u, int wr, int wc, int fr, int fq) const {
        const int pnl = u.pn % npn;
        const int row0 = u.pm * BM + wr * 64 + fr, col0 = pnl * BM + wc * 32 + 4 * fq;
#pragma unroll
        for (int ai = 0; ai < 2; ++ai)
#pragma unroll
            for (int m = 0; m < 4; ++m) { const int row = row0 + ai * HALF + m * 16; const float gt = gate[row]; float* rowp = out + (size_t)row * ld + col0;
#pragma unroll
                for (int bj = 0; bj < 2; ++bj)
#pragma unroll
                    for (int n = 0; n < 2; ++n) *(f32x4*)(rowp + bj * HALF + n * 16) = acc[ai][bj][m][n] * gt; }
    }
};
constexpr int W8_SHIFT = 6;
__device__ __forceinline__ float clamp8(float v) { return __builtin_amdgcn_fmed3f(v, -448.0f, 448.0f); }
__device__ __forceinline__ unsigned pk4_fp8(float a, float b, float c, float d) { int w = __builtin_amdgcn_cvt_pk_fp8_f32(clamp8(a), clamp8(b), 0, false); w = __builtin_amdgcn_cvt_pk_fp8_f32(clamp8(c), clamp8(d), w, true); return (unsigned)w; }
template <bool W8> struct EpiSwiGLU8T {
    static constexpr bool PERM = true, AFTER_DRAIN = false;
    unsigned char* O; int ldf; int npn;
    __device__ __forceinline__ void operator()(const f32x4 (&acc)[2][2][4][2], const Unit& u, int wr, int wc, int fr, int fq) const {
        const int pnl = u.pn % npn;
        const int row0 = u.pm * BM + wr * 64 + fr, col0 = pnl * HALF + wc * 32 + 8 * fq;
#pragma unroll
        for (int ai = 0; ai < 2; ++ai)
#pragma unroll
            for (int m = 0; m < 4; ++m) { unsigned char* rowp = O + (size_t)(row0 + ai * HALF + m * 16) * ldf + col0;
                constexpr float WS_ = W8 ? 1.0f / (float)(1 << W8_SHIFT) : 1.0f;
                const f32x4 g0 = acc[ai][0][m][0] * WS_, g1 = acc[ai][0][m][1] * WS_, u0 = acc[ai][1][m][0] * WS_, u1 = acc[ai][1][m][1] * WS_;
                typedef unsigned u32x2_ __attribute__((ext_vector_type(2)));
                u32x2_ w; w.x = pk4_fp8(silu_mul(g0[0], u0[0]), silu_mul(g0[1], u0[1]), silu_mul(g0[2], u0[2]), silu_mul(g0[3], u0[3]));
                w.y = pk4_fp8(silu_mul(g1[0], u1[0]), silu_mul(g1[1], u1[1]), silu_mul(g1[2], u1[2]), silu_mul(g1[3], u1[3]));
                *(u32x2_*)rowp = w; }
    }
};
__device__ __forceinline__ void moe_slice_plan(int total, int G, int& n_full, int& sl) {
    n_full = (total / G) * G; const int r = total - n_full; sl = 1;
    if (r > 0) { if (r * 7 <= G) sl = 7; else if (r * 4 <= G) sl = 4; else if (r * 2 <= G) sl = 2; }
    if (sl == 1) n_full = total;
}
typedef EpiSwiGLU8T<true> EpiSwiGLU8;
__device__ __forceinline__ f32x4 i2f(const f32x4& a) { return __builtin_convertvector(__builtin_bit_cast(i32x4, a), f32x4); }
struct EpiSwiGLUi8 {
    static constexpr bool PERM = true, AFTER_DRAIN = false;
    unsigned char* O; int ldf; int npn; const float* rowscale; const float* wsg; const float* wsu;
    __device__ __forceinline__ void operator()(const f32x4 (&acc)[2][2][4][2], const Unit& u, int wr, int wc, int fr, int fq) const {
        const int e = u.pn / npn, pnl = u.pn - e * npn;
        const float sg = wsg[e], su = wsu[e];
        const int row0 = u.pm * BM + wr * 64 + fr, col0 = pnl * HALF + wc * 32 + 8 * fq;
#pragma unroll
        for (int ai = 0; ai < 2; ++ai)
#pragma unroll
            for (int m = 0; m < 4; ++m) { const int row = row0 + ai * HALF + m * 16; unsigned char* rowp = O + (size_t)row * ldf + col0;
                const float rs = rowscale[row], fg = rs * sg, fu = rs * su;
                const f32x4 g0 = i2f(acc[ai][0][m][0]) * fg, g1 = i2f(acc[ai][0][m][1]) * fg, u0 = i2f(acc[ai][1][m][0]) * fu, u1 = i2f(acc[ai][1][m][1]) * fu;
                typedef unsigned u32x2_ __attribute__((ext_vector_type(2)));
                u32x2_ w; w.x = pk4_fp8(silu_mul(g0[0], u0[0]), silu_mul(g0[1], u0[1]), silu_mul(g0[2], u0[2]), silu_mul(g0[3], u0[3]));
                w.y = pk4_fp8(silu_mul(g1[0], u1[0]), silu_mul(g1[1], u1[1]), silu_mul(g1[2], u1[2]), silu_mul(g1[3], u1[3]));
                *(u32x2_*)rowp = w; }
    }
};
#ifndef OUTM_BF16
#define OUTM_BF16 0
#endif
struct EpiMoeDown8 {
    static constexpr bool PERM = false, AFTER_DRAIN = false;
    float* out; const float* gate; int ld; int npn; float* outp;
    __device__ __forceinline__ void operator()(const f32x4 (&acc)[2][2][4][2], const Unit& u, int wr, int wc, int fr, int fq) const {
        const int pnl = u.pn % npn;
        const int row0 = u.pm * BM + wr * 64 + fr, col0 = pnl * BM + wc * 32 + 4 * fq;
#pragma unroll
        for (int ai = 0; ai < 2; ++ai)
#pragma unroll
            for (int m = 0; m < 4; ++m) { const int row = row0 + ai * HALF + m * 16; const float gt = gate[row] * (1.0f / (float)(1 << W8_SHIFT));
                float* rowp = u.sliced ? outp + (size_t)(u.sliced - 1) * (BM * BM) + (size_t)(wr * 64 + fr + ai * HALF + m * 16) * BM + wc * 32 + 4 * fq : out + (size_t)row * ld + col0;
#pragma unroll
                for (int bj = 0; bj < 2; ++bj)
#pragma unroll
                    for (int n = 0; n < 2; ++n) {
#if OUTM_BF16
                        if (!u.sliced) { const f32x4 t = acc[ai][bj][m][n] * gt; u32x2 q; q.x = cvt_pk_bf16(t[0], t[1]); q.y = cvt_pk_bf16(t[2], t[3]);
                            *(u32x2*)((bf16_t*)out + (size_t)row * ld + col0 + bj * HALF + n * 16) = q; continue; }
#endif
                        *(f32x4*)(rowp + bj * HALF + n * 16) = acc[ai][bj][m][n] * gt; } }
    }
};
struct EpiRes8 {
    static constexpr bool PERM = false, AFTER_DRAIN = false;
    const float* res; float* out; int ld;
    __device__ __forceinline__ void operator()(const f32x4 (&acc)[2][2][4][2], const Unit& u, int wr, int wc, int fr, int fq) const {
        const int row0 = u.pm * BM + wr * 64 + fr, col0 = u.pn * BM + wc * 32 + 4 * fq;
        constexpr float WS_ = 1.0f / (float)(1 << W8_SHIFT);
#pragma unroll
        for (int ai = 0; ai < 2; ++ai)
#pragma unroll
            for (int m = 0; m < 4; ++m) { const size_t ro = (size_t)(row0 + ai * HALF + m * 16) * ld + col0;
#pragma unroll
                for (int bj = 0; bj < 2; ++bj)
#pragma unroll
                    for (int n = 0; n < 2; ++n) { const f32x4 r = *(const f32x4*)(res + ro + bj * HALF + n * 16); *(f32x4*)(out + ro + bj * HALF + n * 16) = acc[ai][bj][m][n] * WS_ + r; } }
    }
};
struct MoeOrder {
    int rt0[9]; int npn, G, c;
    int ct;
    int n_full, sl, ktt;
    __device__ __forceinline__ bool next(int i, Unit& u) const {
        const int total = rt0[8] * npn, Lq = i * G + c;
        if (Lq >= n_full + (total - n_full) * sl) return false;
        int L = Lq;
        if (Lq >= n_full) { const int j = Lq - n_full; L = n_full + j / sl; const int part = j % sl; u.ktn = ktt / sl; u.kt0 = part * u.ktn; u.sliced = 1 + j; }
        int e = 0, rb = 0, nr = 1;
#pragma unroll
        for (int k = 0; k < 8; ++k) { const bool in = (L >= rt0[k] * npn) && (L < rt0[k + 1] * npn); e = in ? k : e; rb = in ? rt0[k] : rb; nr = in ? (rt0[k + 1] - rt0[k]) : nr; }
        const int j = L - rb * npn;
#ifdef MOE_ROWMAJOR
        u.pm = rb + (j / npn); u.pn = e * npn + (j % npn); return true;
#else
        u.pm = (ct > 0 ? e * ct : rb) + (j % nr); u.pn = e * npn + (j / nr); return true;
#endif
    }
    __device__ __forceinline__ void a_ready(const Unit&) const {}
    __device__ __forceinline__ void done(const Unit&) const {}
};
template <class Epi, class Sched, bool ALIGN_EPI = false, bool SP2 = false, int MODE = 0>
__device__ __forceinline__ void gemm_phase(PG8_LAS unsigned char* lds, const Gemm g, const Sched& S, const Epi& E) {
    constexpr bool FP8 = (MODE == 1);
    const int tid = threadIdx.x, wid = __builtin_amdgcn_readfirstlane(tid >> 6), lane = tid & 63, wr = wid >> 2, wc = wid & 3, fr = lane & 15, fq = lane >> 4;
    const int K = g.K, nt = K / BK;
    unsigned voffA[2], voffB[2];
#pragma unroll
    for (int i = 0; i < 2; ++i) { int R, C; stage_rc(tid * 16 + i * 8192, R, C); const int Rb = Epi::PERM ? ((R & ~31) + perm32(R & 31)) : R;
        voffA[i] = (unsigned)(R * K + C) * 2u; voffB[i] = (unsigned)(Rb * K + C) * 2u; }
    const size_t kstep = (size_t)(BK * 2);
    const size_t hstep = (size_t)HALF * K * 2;
    const size_t tstep = 2 * hstep;
    const unsigned ldsw = (unsigned)wid * 1024u;
    const int aoff = lds_byte(wr * 64 + fr, fq * 8), boff = lds_byte(wc * 32 + fr, fq * 8);
#define PG8_SA(b, h) (((b) * 2 + (h)) * HTB)
#define PG8_SB(b, h) ((4 + (b) * 2 + (h)) * HTB)
#define PG8_STAGE(bufoff, gbase, voff) do { _Pragma("unroll") for (int _i = 0; _i < 2; ++_i) \
        __builtin_amdgcn_global_load_lds((const unsigned*)((const char*)(gbase) + (voff)[_i]), (PG8_LAS unsigned*)(lds + (bufoff) + ldsw + _i * 8192), 16, 0, 0); } while (0)
#define PG8_LD16(off) (*(const PG8_LAS i32x4*)(lds + (off)))
#define PG8_LDA(dst, b, h) do { if constexpr (FP8) { _Pragma("unroll") for (int m = 0; m < 4; ++m) dst##8[m] = __builtin_shufflevector(PG8_LD16(PG8_SA(b, h) + aoff + m * 2048), PG8_LD16(PG8_SA(b, h) + aoff + m * 2048 + 1024), 0, 1, 2, 3, 4, 5, 6, 7); } \
        else { _Pragma("unroll") for (int m = 0; m < 4; ++m) _Pragma("unroll") for (int k = 0; k < 2; ++k) dst[m][k] = *(const PG8_LAS bf16x8*)(lds + PG8_SA(b, h) + aoff + m * 2048 + k * 1024); } } while (0)
#define PG8_LDB(dst, b, h) do { if constexpr (FP8) { _Pragma("unroll") for (int n = 0; n < 2; ++n) dst##8[n] = __builtin_shufflevector(PG8_LD16(PG8_SB(b, h) + boff + n * 2048), PG8_LD16(PG8_SB(b, h) + boff + n * 2048 + 1024), 0, 1, 2, 3, 4, 5, 6, 7); } \
        else { _Pragma("unroll") for (int n = 0; n < 2; ++n) _Pragma("unroll") for (int k = 0; k < 2; ++k) dst[n][k] = *(const PG8_LAS bf16x8*)(lds + PG8_SB(b, h) + boff + n * 2048 + k * 1024); } } while (0)
#define PG8_MMA(ai, bj, At, Bt) do { __builtin_amdgcn_s_setprio(1); \
        if constexpr (FP8) { _Pragma("unroll") for (int m = 0; m < 4; ++m) _Pragma("unroll") for (int n = 0; n < 2; ++n) \
            asm volatile("v_mfma_scale_f32_16x16x128_f8f6f4 %0, %1, %2, %0, %3, %3 op_sel_hi:[0,0,0]" : "+v"(acc[ai][bj][m][n]) : "v"(Bt##8[n]), "v"(At##8[m]), "v"(sc127)); } \
        else if constexpr (MODE == 2) { _Pragma("unroll") for (int m = 0; m < 4; ++m) _Pragma("unroll") for (int n = 0; n < 2; ++n) _Pragma("unroll") for (int k = 0; k < 2; ++k) \
            acc[ai][bj][m][n] = __builtin_bit_cast(f32x4, __builtin_amdgcn_mfma_i32_16x16x64_i8(__builtin_bit_cast(i32x4, Bt[n][k]), __builtin_bit_cast(i32x4, At[m][k]), __builtin_bit_cast(i32x4, acc[ai][bj][m][n]), 0, 0, 0)); } \
        else { _Pragma("unroll") for (int m = 0; m < 4; ++m) _Pragma("unroll") for (int n = 0; n < 2; ++n) _Pragma("unroll") for (int k = 0; k < 2; ++k) \
            acc[ai][bj][m][n] = __builtin_amdgcn_mfma_f32_16x16x32_bf16(Bt[n][k], At[m][k], acc[ai][bj][m][n], 0, 0, 0); } \
        __builtin_amdgcn_s_setprio(0); } while (0)
#define PG8_WAIT_V(n) asm volatile("s_waitcnt vmcnt(" #n ")" ::: "memory")
#define PG8_WAIT_L(n) asm volatile("s_waitcnt lgkmcnt(" #n ")" ::: "memory")
#define PG8_BAR __builtin_amdgcn_s_barrier()
#define PG8_SCHED __builtin_amdgcn_sched_barrier(0)
    Unit cur, nxt; int ui = 0;
    cur.kt0 = 0; cur.ktn = nt; cur.sliced = 0;
    if (!S.next(0, cur)) return;
    f32x4 acc[2][2][4][2];
#pragma unroll
    for (int a = 0; a < 2; ++a)
#pragma unroll
        for (int b = 0; b < 2; ++b)
#pragma unroll
            for (int m = 0; m < 4; ++m)
#pragma unroll
                for (int n = 0; n < 2; ++n) acc[a][b][m][n] = (f32x4){0.f, 0.f, 0.f, 0.f};
    int sc127 = 127; asm volatile("" : "+v"(sc127));
    bf16x8 At[4][2], B0[2][2], B1[2][2]; i32x8 At8[4], B08[2], B18[2];
    const char* cA = (const char*)g.A + (size_t)cur.pm * tstep + (size_t)cur.kt0 * kstep; const char* cB = (const char*)g.Bt + (size_t)cur.pn * tstep + (size_t)cur.kt0 * kstep;
    S.a_ready(cur);
    if constexpr (SP2) {
        PG8_STAGE(PG8_SB(0, 0), cB, voffB); PG8_STAGE(PG8_SB(0, 1), cB + hstep, voffB); PG8_STAGE(PG8_SA(0, 0), cA, voffA); PG8_STAGE(PG8_SA(0, 1), cA + hstep, voffA);
        if (wr == 1) PG8_BAR;
        PG8_WAIT_V(2); PG8_BAR;
        PG8_STAGE(PG8_SB(1, 0), cB + kstep, voffB); PG8_STAGE(PG8_SA(1, 0), cA + kstep, voffA); PG8_STAGE(PG8_SB(1, 1), cB + hstep + kstep, voffB);
        PG8_WAIT_V(6); PG8_BAR;
    } else {
        PG8_STAGE(PG8_SB(0, 0), cB, voffB); PG8_STAGE(PG8_SA(0, 0), cA, voffA); PG8_STAGE(PG8_SB(0, 1), cB + hstep, voffB); PG8_STAGE(PG8_SA(0, 1), cA + hstep, voffA);
        if (wr == 1) PG8_BAR;
        PG8_WAIT_V(4); PG8_BAR;
        PG8_STAGE(PG8_SB(1, 0), cB + kstep, voffB); PG8_STAGE(PG8_SA(1, 0), cA + kstep, voffA); PG8_STAGE(PG8_SB(1, 1), cB + hstep + kstep, voffB);
        PG8_WAIT_V(6); PG8_BAR;
    }
    for (;;) {
        nxt.kt0 = 0; nxt.ktn = nt; nxt.sliced = 0;
        const bool has_next = S.next(ui + 1, nxt);
        const int ntu = cur.ktn;
        const char* nA = has_next ? (const char*)g.A + (size_t)nxt.pm * tstep + (size_t)nxt.kt0 * kstep : cA; const char* nB = has_next ? (const char*)g.Bt + (size_t)nxt.pn * tstep + (size_t)nxt.kt0 * kstep : cB;
        for (int t = 0; t < ntu; t += 2) {
            const bool last = (t == ntu - 2);
            const char* a1 = cA + (size_t)(t + 1) * kstep;
            const char* a2 = last ? nA : cA + (size_t)(t + 2) * kstep; const char* b2 = last ? nB : cB + (size_t)(t + 2) * kstep;
            const char* a3 = a2 + kstep; const char* b3 = b2 + kstep;
            if (last && has_next) S.a_ready(nxt);
            if constexpr (SP2) {
            PG8_LDB(B0, 0, 0); PG8_LDB(B1, 0, 1); PG8_SCHED; PG8_LDA(At, 0, 0); PG8_STAGE(PG8_SA(1, 1), a1 + hstep, voffA);
            PG8_WAIT_V(8); PG8_WAIT_L(0); PG8_BAR; PG8_MMA(0, 0, At, B0); PG8_MMA(0, 1, At, B1); PG8_BAR; PG8_SCHED;
            PG8_LDA(At, 0, 1); PG8_STAGE(PG8_SB(0, 0), b2, voffB); PG8_STAGE(PG8_SB(0, 1), b2 + hstep, voffB); PG8_STAGE(PG8_SA(0, 0), a2, voffA);
            PG8_WAIT_V(8); PG8_WAIT_L(0); PG8_BAR; PG8_MMA(1, 0, At, B0); PG8_MMA(1, 1, At, B1); PG8_BAR; PG8_SCHED;
            PG8_LDB(B0, 1, 0); PG8_LDB(B1, 1, 1); PG8_SCHED; PG8_LDA(At, 1, 0); PG8_STAGE(PG8_SA(0, 1), a2 + hstep, voffA);
            PG8_WAIT_V(8); PG8_WAIT_L(0); PG8_BAR; PG8_MMA(0, 0, At, B0); PG8_MMA(0, 1, At, B1); PG8_BAR; PG8_SCHED;
            PG8_LDA(At, 1, 1); PG8_STAGE(PG8_SB(1, 0), b3, voffB); PG8_STAGE(PG8_SB(1, 1), b3 + hstep, voffB); PG8_STAGE(PG8_SA(1, 0), a3, voffA);
            PG8_WAIT_V(8); PG8_WAIT_L(0); PG8_BAR; PG8_MMA(1, 0, At, B0); PG8_MMA(1, 1, At, B1); PG8_BAR; PG8_SCHED;
            } else {
            PG8_LDB(B0, 0, 0); PG8_SCHED; PG8_LDA(At, 0, 0); PG8_STAGE(PG8_SA(1, 1), a1 + hstep, voffA);
            PG8_WAIT_L(8); PG8_BAR; PG8_WAIT_L(0); PG8_MMA(0, 0, At, B0); PG8_BAR; PG8_SCHED;
            PG8_LDB(B1, 0, 1); PG8_STAGE(PG8_SB(0, 0), b2, voffB);
            PG8_BAR; PG8_WAIT_L(0); PG8_MMA(0, 1, At, B1); PG8_BAR;
            PG8_LDA(At, 0, 1); PG8_STAGE(PG8_SA(0, 0), a2, voffA);
            PG8_BAR; PG8_WAIT_L(0); PG8_MMA(1, 0, At, B0); PG8_BAR; PG8_SCHED;
            PG8_STAGE(PG8_SB(0, 1), b2 + hstep, voffB);
            PG8_WAIT_V(6); PG8_BAR; PG8_MMA(1, 1, At, B1); PG8_BAR;
            PG8_LDB(B0, 1, 0); PG8_SCHED; PG8_LDA(At, 1, 0); PG8_STAGE(PG8_SA(0, 1), a2 + hstep, voffA);
            PG8_WAIT_L(8); PG8_BAR; PG8_WAIT_L(0); PG8_MMA(0, 0, At, B0); PG8_BAR; PG8_SCHED;
            PG8_LDB(B1, 1, 1); PG8_STAGE(PG8_SB(1, 0), b3, voffB);
            PG8_BAR; PG8_WAIT_L(0); PG8_MMA(0, 1, At, B1); PG8_BAR;
            PG8_LDA(At, 1, 1); PG8_STAGE(PG8_SA(1, 0), a3, voffA);
            PG8_BAR; PG8_WAIT_L(0); PG8_MMA(1, 0, At, B0); PG8_BAR; PG8_SCHED;
            PG8_STAGE(PG8_SB(1, 1), b3 + hstep, voffB);
            PG8_WAIT_V(6); PG8_BAR; PG8_MMA(1, 1, At, B1); PG8_BAR;
            }
        }
        if constexpr (FP8) asm volatile("s_nop 15\n\ts_nop 7" ::: "memory");
        if constexpr (ALIGN_EPI) { if (wr == 0) PG8_BAR; }
        if constexpr (!Epi::AFTER_DRAIN) { E(acc, cur, wr, wc, fr, fq); S.done(cur); }
        if (!has_next) break;
#pragma unroll
        for (int a = 0; a < 2; ++a)
#pragma unroll
            for (int b = 0; b < 2; ++b)
#pragma unroll
                for (int m = 0; m < 4; ++m)
#pragma unroll
                    for (int n = 0; n < 2; ++n) acc[a][b][m][n] = (f32x4){0.f, 0.f, 0.f, 0.f};
        cur = nxt; cA = nA; cB = nB; ++ui;
        if constexpr (ALIGN_EPI) { if (wr == 1) PG8_BAR; }
    }
    PG8_WAIT_V(0);
    if constexpr (!ALIGN_EPI) { if (wr == 0) PG8_BAR; }
    PG8_BAR;
    if constexpr (Epi::AFTER_DRAIN) { E.fused(acc, cur, wr, wc, fr, fq, lds, wid, lane); S.done(cur); }
#undef PG8_SA
#undef PG8_SB
#undef PG8_STAGE
#undef PG8_LD16
#undef PG8_LDA
#undef PG8_LDB
#undef PG8_MMA
#undef PG8_WAIT_V
#undef PG8_WAIT_L
#undef PG8_BAR
#undef PG8_SCHED
}
}

constexpr int NWAVES = 8;
constexpr int S = 8192, D = 2048, NIN = 7248, NINP = 7424, DFF = 5632, DFFE = 7168, NE = 8, DEPTH = 2;
constexpr int PITCH = NINP;
constexpr int C_QA = 0, C_KA = 512, C_VA = 1024, C_QI = 1536, C_QB = 2560, C_KB = 3328, C_VB = 4096, C_QC = 4864, C_KC = 5632, C_VC = 6400, C_KI = 7168, C_WI = 7232;
#ifndef GATHER_FUSED
#define GATHER_FUSED 0
#endif
constexpr int MOE_CT = 10, MOE_CAP = 256 * MOE_CT;
constexpr int MAXSLOT = GATHER_FUSED ? NE * MOE_CAP : 18432;
constexpr float RMS_EPS = 1e-6f;
constexpr float LOG2E = 1.4426950408889634f;
constexpr int TBL_N = 2304, TBL_OFF = 64;
constexpr int DFAR = 2112;

constexpr size_t MiB = 1u << 20;
constexpr size_t WS_CTL = 0, CTL_ZERO_BYTES = 1 * MiB;
constexpr size_t WS_TBL = 1 * MiB, WS_ROUTE = 2 * MiB;
constexpr size_t WS_WIN = 3 * MiB, WS_WOUT = WS_WIN + 58 * MiB, WS_WGU = WS_WOUT + 16 * MiB, WS_WDN = WS_WGU + 44 * MiB, WS_WMGU = WS_WDN + 22 * MiB, WS_WMDN = WS_WMGU + 448 * MiB;
constexpr size_t WS_H = WS_WMDN + 224 * MiB, WS_P = WS_H + 32 * MiB, WS_SC = WS_P + 116 * MiB, WS_WM = WS_SC + 256 * MiB, WS_MIX = WS_WM + 8 * MiB, WS_XB = WS_MIX + 32 * MiB;
constexpr size_t WS_ACT = WS_XB + 64 * MiB, WS_HS = WS_ACT + 252 * MiB, WS_END = WS_HS + 72 * MiB;
constexpr size_t WS_OUTM = WS_SC;
constexpr size_t WS_OUTP = WS_P;
static_assert((size_t)2 * NINP * D * 2 <= 58 * MiB && (size_t)2 * DFF * D * 2 <= 44 * MiB && (size_t)NE * 2 * DFFE * D * 2 <= 448 * MiB && (size_t)MAXSLOT * DFFE <= 252 * MiB && (size_t)MAXSLOT * D * 4 <= 256 * MiB, "ws map");
constexpr size_t RT_TOKE = 0, RT_TOKR = 65536, RT_TOKG = 131072, RT_TOKS = 196608, RT_SLOTG = 262144, RT_ROWS = 393216, RT_SLOTS = 458752;
constexpr size_t WS_WSC = WS_TBL + 512 * 1024;

constexpr int CW_TMO = 0, CW_CODE = 1, CW_BAR = 4096, CW_CNT = 8192, CW_Q = 12288;

constexpr int RING_OFF = 0, RING_BYTES = 131072;
constexpr int XPOSE_SCR = 64 * 65 * 4;
constexpr int LDSCTL_OFF = 8 * XPOSE_SCR, MISC_OFF = LDSCTL_OFF + 320;
constexpr int LDS_TBL_OFF = 134144;
constexpr int LDS_BYTES = 147456;
static_assert(LDS_TBL_OFF + TBL_N * 4 <= LDS_BYTES && MISC_OFF + 128 <= LDS_TBL_OFF && LDSCTL_OFF >= RING_BYTES && LDS_TBL_OFF % 16 == 0, "LDS map");

#define GAS __attribute__((address_space(1)))
#define LAS __attribute__((address_space(3)))
#define DI __device__ __forceinline__
typedef unsigned short bf16;
typedef unsigned v4u __attribute__((ext_vector_type(4)));
typedef unsigned v2u __attribute__((ext_vector_type(2)));
typedef float f32x4 __attribute__((ext_vector_type(4)));
typedef float f32x16 __attribute__((ext_vector_type(16)));
typedef short bf16x8 __attribute__((ext_vector_type(8)));
typedef short s16x4 __attribute__((ext_vector_type(4)));
typedef GAS unsigned gu32;
#define RLX_AGENT __ATOMIC_RELAXED, __HIP_MEMORY_SCOPE_AGENT
#define LDS_WAIT() asm volatile("s_waitcnt lgkmcnt(0)" ::: "memory")
#define VM_WAIT() asm volatile("s_waitcnt vmcnt(0)" ::: "memory")
DI unsigned f2bf(float f) { unsigned u = __builtin_bit_cast(unsigned, f); return (u + 0x7fffu + ((u >> 16) & 1u)) >> 16; }
DI unsigned pk2(float lo, float hi) { unsigned r; asm volatile("v_cvt_pk_bf16_f32 %0, %1, %2" : "=v"(r) : "v"(lo), "v"(hi)); return r; }
DI float bflo(unsigned w) { return __builtin_bit_cast(float, w << 16); }
DI float bfhi(unsigned w) { return __builtin_bit_cast(float, w & 0xffff0000u); }
DI float wave_sum(float v) {
#pragma unroll
    for (int o = 1; o < 64; o <<= 1) v += __shfl_xor(v, o);
    return v;
}
#define XB_TMO      128
#define XB_XCNT(j)  (256  + 64 * (j))
#define XB_XSUB(j)  (1280 + 64 * (j))
#define XB_XGEN(j)  (2304 + 64 * (j))
#define XB_TOP      3328
#define XB_TOPGEN   3392
#define XCD_BAR_WORDS 3456
#define XB_SPIN_CAP (1u << 18)

__device__ __forceinline__ unsigned xb_ld(unsigned* p)              { return __hip_atomic_load(p, __ATOMIC_RELAXED, __HIP_MEMORY_SCOPE_AGENT); }
__device__ __forceinline__ unsigned xb_add(unsigned* p, unsigned v) { return __hip_atomic_fetch_add(p, v, __ATOMIC_RELAXED, __HIP_MEMORY_SCOPE_AGENT); }
__device__ __forceinline__ unsigned xb_xcc_id() { return (unsigned)__builtin_amdgcn_s_getreg((3 << 11) | 20) & 0xFu; }
#define XB_SPIN(cond, bar) do { unsigned _sp = 0; while (cond) { __builtin_amdgcn_s_sleep(1); \
    if ((++_sp & 255u) == 0u) { if (xb_ld(&(bar)[XB_TMO])) break; if (_sp > XB_SPIN_CAP) { atomicAdd(&(bar)[XB_TMO], 1u); break; } } } } while (0)

struct XcdBarrier {
    unsigned* bar; unsigned x;
    volatile LAS unsigned* st;
};

__device__ __forceinline__ XcdBarrier xcd_barrier_post(unsigned* bar, volatile LAS unsigned* st) {
    XcdBarrier b; b.bar = bar; b.x = xb_xcc_id(); b.st = st;
    if (threadIdx.x == 0) (void)xb_add(&bar[XB_XCNT(b.x)], 1u);
    return b;
}
__device__ __forceinline__ void xcd_barrier_complete(unsigned* bar, unsigned x, unsigned& nloc, unsigned& nx) {
    const unsigned G = gridDim.x * gridDim.y * gridDim.z;
    unsigned sum, cnt, mine, sp = 0u;
    for (;;) {
        sum = 0u; cnt = 0u; mine = 0u;
#pragma unroll
        for (unsigned j = 0; j < 16; ++j) { const unsigned c = xb_ld(&bar[XB_XCNT(j)]); sum += c; cnt += (c > 0u) ? 1u : 0u; mine = (j == x) ? c : mine; }
        if (sum == G) break;
        __builtin_amdgcn_s_sleep(1);
        if ((++sp & 255u) == 0u) { if (xb_ld(&bar[XB_TMO])) break; if (sp > XB_SPIN_CAP) { atomicAdd(&bar[XB_TMO], 1u); break; } }
    }
    nloc = mine > 0u ? mine : 1u; nx = cnt > 0u ? cnt : 1u;
}

__device__ __forceinline__ void xcd_barrier(const XcdBarrier& b) {
    asm volatile("s_waitcnt vmcnt(0)" ::: "memory");
    __syncthreads();
    if (threadIdx.x == 0) {
        unsigned* bar = b.bar;
        __builtin_amdgcn_s_waitcnt(0);
        unsigned nloc = b.st[0], nx = b.st[1];
        if (nloc == 0u) { xcd_barrier_complete(bar, b.x, nloc, nx); b.st[0] = nloc; b.st[1] = nx; }
        const unsigned old = xb_add(&bar[XB_XSUB(b.x)], 1u);
        const unsigned gen = old / nloc;
        if (old + 1u == (gen + 1u) * nloc) {
            __builtin_amdgcn_fence(__ATOMIC_RELEASE, "agent");
            asm volatile("s_waitcnt vmcnt(0)" ::: "memory");
            const unsigned og = xb_add(&bar[XB_TOP], 1u);
            const unsigned tg = og / nx;
            if (og + 1u == (tg + 1u) * nx) xb_add(&bar[XB_TOPGEN], 1u);
            else XB_SPIN(xb_ld(&bar[XB_TOPGEN]) == tg, bar);
            __builtin_amdgcn_fence(__ATOMIC_ACQUIRE, "agent");
            xb_add(&bar[XB_XGEN(b.x)], 1u);
            asm volatile("s_waitcnt vmcnt(0)" ::: "memory");
        } else {
            XB_SPIN(xb_ld(&bar[XB_XGEN(b.x)]) == gen, bar);
            __builtin_amdgcn_fence(__ATOMIC_ACQUIRE, "agent");
            asm volatile("s_waitcnt vmcnt(0)" ::: "memory");
        }
    }
    __syncthreads();
}


struct Args { const float* in[24]; float* out; unsigned char* ws; int ph_lo, ph_hi; };
struct Frame {
    LAS unsigned char* lds;
    volatile LAS unsigned* MISC;
    gu32* ctl;
    unsigned char* ws;
    const Args* a; float* out;
    int tid, lane, wave, vcu, G;
};

DI int rowmap(int map, int n) {
    if (map == 1) return n < 2560 ? n : (n < 2640 ? n + (C_KI - 2560) : n - 80);
    if (map == 2) return ((n >> 7) << 8) + (n & 127);
    if (map == 3) return ((n >> 7) << 8) + 128 + (n & 127);
    return n;
}
DI void xpose_item(const float* __restrict__ W, int K, int N, bf16* __restrict__ WT, int map, LAS float* scr, int item, int lane) {
    const int nblk = (N + 63) >> 6, kb = item / nblk, nb = item - kb * nblk, k0 = kb << 6, n0 = nb << 6;
    const int kk = lane >> 4, nq = (lane & 15) << 2;
    const bool okc = (n0 + nq) < N;
    f32x4 v[16];
#pragma unroll
    for (int i = 0; i < 16; ++i) { v[i] = (f32x4){0.f, 0.f, 0.f, 0.f}; if (okc) v[i] = __builtin_nontemporal_load((const GAS f32x4*)(W + (size_t)(k0 + 4 * i + kk) * N + n0 + nq)); }
#pragma unroll
    for (int i = 0; i < 16; ++i) { LAS float* d = scr + (4 * i + kk) * 65 + nq; d[0] = v[i].x; d[1] = v[i].y; d[2] = v[i].z; d[3] = v[i].w; }
    LDS_WAIT(); asm volatile("" ::: "memory");
    const int c = lane & 7;
#pragma unroll
    for (int j = 0; j < 8; ++j) { const int n = (lane >> 3) + 8 * j; const LAS float* s = scr + (8 * c) * 65 + n;
        v4u o; o.x = pk2(s[0 * 65], s[1 * 65]); o.y = pk2(s[2 * 65], s[3 * 65]); o.z = pk2(s[4 * 65], s[5 * 65]); o.w = pk2(s[6 * 65], s[7 * 65]);
        if (n0 + n < N) __builtin_nontemporal_store(o, (GAS v4u*)(WT + (size_t)rowmap(map, n0 + n) * K + k0 + 8 * c)); }
    LDS_WAIT(); asm volatile("" ::: "memory");
}
DI void xpose_item8(const float* __restrict__ W, int K, int N, unsigned char* __restrict__ WT, int map, LAS float* scr, int item, int lane) {
    const int nblk = (N + 63) >> 6, kb = item / nblk, nb = item - kb * nblk, k0 = kb << 6, n0 = nb << 6;
    const int kk = lane >> 4, nq = (lane & 15) << 2;
    const bool okc = (n0 + nq) < N;
    f32x4 v[16];
#pragma unroll
    for (int i = 0; i < 16; ++i) { v[i] = (f32x4){0.f, 0.f, 0.f, 0.f}; if (okc) v[i] = __builtin_nontemporal_load((const GAS f32x4*)(W + (size_t)(k0 + 4 * i + kk) * N + n0 + nq)); }
    constexpr float SC8 = (float)(1 << pg8::W8_SHIFT);
#pragma unroll
    for (int i = 0; i < 16; ++i) { LAS float* d = scr + (4 * i + kk) * 65 + nq; d[0] = v[i].x * SC8; d[1] = v[i].y * SC8; d[2] = v[i].z * SC8; d[3] = v[i].w * SC8; }
    LDS_WAIT(); asm volatile("" ::: "memory");
    const int c = lane & 3;
#pragma unroll
    for (int j = 0; j < 4; ++j) { const int n = (lane >> 2) + 16 * j; const LAS float* s = scr + (16 * c) * 65 + n;
        v4u o; o.x = pg8::pk4_fp8(s[0 * 65], s[1 * 65], s[2 * 65], s[3 * 65]); o.y = pg8::pk4_fp8(s[4 * 65], s[5 * 65], s[6 * 65], s[7 * 65]);
        o.z = pg8::pk4_fp8(s[8 * 65], s[9 * 65], s[10 * 65], s[11 * 65]); o.w = pg8::pk4_fp8(s[12 * 65], s[13 * 65], s[14 * 65], s[15 * 65]);
        if (n0 + n < N) __builtin_nontemporal_store(o, (GAS v4u*)(WT + (size_t)rowmap(map, n0 + n) * K + k0 + 16 * c)); }
    LDS_WAIT(); asm volatile("" ::: "memory");
}
DI int t5_bucket(int n) {
    if (n < 16) return n;
    const int large = 16 + (int)(logf((float)n / 16.0f) / 4.852030263919617f * 16.0f);
    return large < 31 ? large : 31;
}
DI void rms_row_to_bf16(const float* xrow, const f32x4 (&g)[8], bf16* orow, int lane) {
    const GAS f32x4* xr = (const GAS f32x4*)xrow + lane;
    f32x4 v[8]; float s = 0.f;
#pragma unroll
    for (int j = 0; j < 8; ++j) { v[j] = xr[64 * j]; s += (v[j].x * v[j].x + v[j].y * v[j].y) + (v[j].z * v[j].z + v[j].w * v[j].w); }
    const float rstd = 1.0f / sqrtf(wave_sum(s) * (1.0f / D) + RMS_EPS);
    GAS v2u* o8 = (GAS v2u*)orow + lane;
#pragma unroll
    for (int j = 0; j < 8; ++j) { v2u o; o.x = pk2(v[j].x * rstd * g[j].x, v[j].y * rstd * g[j].y); o.y = pk2(v[j].z * rstd * g[j].z, v[j].w * rstd * g[j].w); o8[64 * j] = o; }
}
template <bool B16> struct XRow;
template <> struct XRow<true>  { v2u r[8];
    DI void load(const void* row, int lane) {
#pragma unroll
        for (int j = 0; j < 8; ++j) r[j] = ((const GAS v2u*)row)[lane + 64 * j]; }
    DI f32x4 get(int j) const { return (f32x4){bflo(r[j].x), bfhi(r[j].x), bflo(r[j].y), bfhi(r[j].y)}; } };
template <> struct XRow<false> { f32x4 r[8];
    DI void load(const void* row, int lane) {
#pragma unroll
        for (int j = 0; j < 8; ++j) r[j] = ((const GAS f32x4*)row)[lane + 64 * j]; }
    DI f32x4 get(int j) const { return r[j]; } };
#ifndef THIN_PIPE
#define THIN_PIPE 1
#endif
template <bool B16> DI f32x4 xrow4(const void* row, int idx) {
    if (B16) { const v2u w = ((const GAS v2u*)row)[idx]; return (f32x4){bflo(w.x), bfhi(w.x), bflo(w.y), bfhi(w.y)}; }
    return ((const GAS f32x4*)row)[idx];
}
DI void rms_phase(Frame& F, const float* x, const float* gvec, bf16* H) {
    const int gw = F.vcu * NWAVES + F.wave, NGW = F.G * NWAVES;
    f32x4 g[8];
#pragma unroll
    for (int j = 0; j < 8; ++j) g[j] = ((const GAS f32x4*)gvec)[F.lane + 64 * j];
    for (int m = gw; m < S; m += NGW) rms_row_to_bf16(x + (size_t)m * D, g, H + (size_t)m * D, F.lane);
}
DI void rms_phase8(Frame& F, const float* x, const float* gvec, unsigned char* H8) {
    const int gw = F.vcu * NWAVES + F.wave, NGW = F.G * NWAVES, lane = F.lane;
    f32x4 g[8];
#pragma unroll
    for (int j = 0; j < 8; ++j) g[j] = ((const GAS f32x4*)gvec)[lane + 64 * j];
    for (int m = gw; m < S; m += NGW) {
        const GAS f32x4* xr = (const GAS f32x4*)(x + (size_t)m * D) + lane;
        f32x4 v[8]; float s = 0.f;
#pragma unroll
        for (int j = 0; j < 8; ++j) { v[j] = xr[64 * j]; s += (v[j].x * v[j].x + v[j].y * v[j].y) + (v[j].z * v[j].z + v[j].w * v[j].w); }
        const float rstd = 1.0f / sqrtf(wave_sum(s) * (1.0f / D) + RMS_EPS);
        GAS unsigned* o4 = (GAS unsigned*)(H8 + (size_t)m * D) + lane;
#pragma unroll
        for (int j = 0; j < 8; ++j) o4[64 * j] = pg8::pk4_fp8(v[j].x * rstd * g[j].x, v[j].y * rstd * g[j].y, v[j].z * rstd * g[j].z, v[j].w * rstd * g[j].w);
    }
}
constexpr int I_IN = (D / 64) * ((NIN + 63) / 64), I_OUT = (D / 64) * (D / 64), I_G = (D / 64) * (DFF / 64), I_DN = (DFF / 64) * (D / 64), I_MG = (D / 64) * (DFFE / 64), I_MD = (DFFE / 64) * (D / 64);
constexpr int NBG = I_OUT + 2 * I_G + I_DN + I_IN + I_OUT + 16 * I_MG + 8 * I_MD;
#ifndef BG_QUOTA
#define BG_QUOTA 0
#endif
constexpr int BG_N1 = 96 * BG_QUOTA, BG_N10 = 96 * BG_QUOTA, BG_N7 = 128 * BG_QUOTA;
constexpr int BG_A0 = (NBG - BG_N1 - BG_N10 - BG_N7) / 2, BG_I1 = BG_A0 + BG_N1, BG_A1 = NBG - BG_N10 - BG_N7, BG_I10 = NBG - BG_N7;
static_assert(BG_A0 >= 2 * I_OUT + 2 * I_G + I_DN + I_IN && BG_A0 % 8 == 0 && BG_I1 % 8 == 0 && BG_A1 % 8 == 0 && BG_I10 % 8 == 0, "everything layer 0's FFN and layer 1's projections need is converted during layer 0's attention phase");
#ifndef DENSE_GU_FP8
#define DENSE_GU_FP8 1
#endif
#ifndef DENSE_DOWN_FP8
#define DENSE_DOWN_FP8 1
#endif
struct XItem { const float* W; unsigned char* WT; int K, N, map, item, fp8  ; float inv; };
#ifndef OUTPROJ_INT8
#define OUTPROJ_INT8 0
#endif
constexpr float MIX_CLIP = 8.0f;
#ifndef INPROJ_INT8
#define INPROJ_INT8 1
#endif
#ifndef GU_INT8
#define GU_INT8 1
#endif
DI XItem bg_decode(Frame& F, int it) {
    unsigned char* WIN = F.ws + WS_WIN; unsigned char* WOUT = F.ws + WS_WOUT; unsigned char* WGU = F.ws + WS_WGU; unsigned char* WDN = F.ws + WS_WDN;
    unsigned char* WMGU = F.ws + WS_WMGU; unsigned char* WMDN = F.ws + WS_WMDN;
    int r = it; XItem x; const float* wsc = (const float*)(F.ws + WS_WSC);
    if (r < I_OUT) { x = OUTPROJ_INT8 ? XItem{F.a->in[2], WOUT, D, D, 0, r, 2, wsc[32 + 2]} : XItem{F.a->in[2], WOUT, D, D, 0, r, 0, 1.f}; return x; } r -= I_OUT;
    if (r < I_G) { x = XItem{F.a->in[17], WGU, D, DFF, 2, r, DENSE_GU_FP8 ? (GU_INT8 ? 2 : 1) : 0, GU_INT8 ? wsc[32 + 4] : 1.f}; return x; } r -= I_G;
    if (r < I_G) { x = XItem{F.a->in[18], WGU, D, DFF, 3, r, DENSE_GU_FP8 ? (GU_INT8 ? 2 : 1) : 0, GU_INT8 ? wsc[32 + 5] : 1.f}; return x; } r -= I_G;
    if (r < I_DN) { x = XItem{F.a->in[19], WDN, DFF, D, 0, r, DENSE_DOWN_FP8, 1.f}; return x; } r -= I_DN;
    if (r < I_IN) { x = INPROJ_INT8 ? XItem{F.a->in[1] + (size_t)D * NIN, WIN + (size_t)NINP * D, D, NIN, 1, r, 2, wsc[32 + 1]} : XItem{F.a->in[1] + (size_t)D * NIN, WIN + (size_t)NINP * D * 2, D, NIN, 1, r, 0, 1.f}; return x; } r -= I_IN;
    if (r < I_OUT) { x = OUTPROJ_INT8 ? XItem{F.a->in[2] + (size_t)D * D, WOUT + (size_t)D * D, D, D, 0, r, 2, wsc[32 + 3]} : XItem{F.a->in[2] + (size_t)D * D, WOUT + (size_t)D * D * 2, D, D, 0, r, 0, 1.f}; return x; } r -= I_OUT;
    if (r < 8 * I_MG) { const int e = r / I_MG; x = XItem{F.a->in[21] + (size_t)e * D * DFFE, WMGU + (size_t)e * 2 * DFFE * D, D, DFFE, 2, r - e * I_MG, GU_INT8 ? 2 : 1, GU_INT8 ? wsc[32 + 6 + e] : 1.f}; return x; } r -= 8 * I_MG;
    if (r < 8 * I_MG) { const int e = r / I_MG; x = XItem{F.a->in[22] + (size_t)e * D * DFFE, WMGU + (size_t)e * 2 * DFFE * D, D, DFFE, 3, r - e * I_MG, GU_INT8 ? 2 : 1, GU_INT8 ? wsc[32 + 14 + e] : 1.f}; return x; } r -= 8 * I_MG;
    { const int e = r / I_MD; x = XItem{F.a->in[23] + (size_t)e * DFFE * D, WMDN + (size_t)e * D * DFFE, DFFE, D, 0, r - e * I_MD, 1, 1.f}; return x; }
}
template <int I0 = 0, int I1 = 16>
DI void xi_load(const XItem& x, f32x4 (&v)[16], int lane) {
    const int nblk = (x.N + 63) >> 6, kb = x.item / nblk, nb = x.item - kb * nblk, k0 = kb << 6, n0 = nb << 6;
    const int kk = lane >> 4, nq = (lane & 15) << 2;
    const bool okc = (n0 + nq) < x.N;
#pragma unroll
    for (int i = I0; i < I1; ++i) { v[i] = (f32x4){0.f, 0.f, 0.f, 0.f}; if (okc) v[i] = __builtin_nontemporal_load((const GAS f32x4*)(x.W + (size_t)(k0 + 4 * i + kk) * x.N + n0 + nq)); }
}
DI void xi_finish(const XItem& x, const f32x4 (&v)[16], LAS float* scr, int lane_) {
    int lane = lane_; asm volatile("" : "+v"(lane));
    const int nblk = (x.N + 63) >> 6, kb = x.item / nblk, nb = x.item - kb * nblk, k0 = kb << 6, n0 = nb << 6;
    const int kk = lane >> 4, nq = (lane & 15) << 2;
    const float sc = x.fp8 == 1 ? (float)(1 << pg8::W8_SHIFT) : (x.fp8 == 2 ? x.inv : 1.0f);
#pragma unroll
    for (int i = 0; i < 16; ++i) { LAS float* d = scr + (4 * i + kk) * 65 + nq; d[0] = v[i].x * sc; d[1] = v[i].y * sc; d[2] = v[i].z * sc; d[3] = v[i].w * sc; }
    LDS_WAIT(); asm volatile("" ::: "memory");
    if (x.fp8 == 2) {
        const int c = lane & 3;
#pragma unroll
        for (int j = 0; j < 4; ++j) { const int n = (lane >> 2) + 16 * j; const LAS float* s = scr + (16 * c) * 65 + n; v4u o;
#pragma unroll
            for (int d = 0; d < 4; ++d) { unsigned w = 0u;
#pragma unroll
                for (int b = 0; b < 4; ++b) w = __builtin_amdgcn_cvt_pk_u8_f32(rintf(s[(4 * d + b) * 65]) + 128.0f, b, w);
                o[d] = w ^ 0x80808080u; }
            if (n0 + n < x.N) __builtin_nontemporal_store(o, (GAS v4u*)(x.WT + (size_t)rowmap(x.map, n0 + n) * x.K + k0 + 16 * c)); }
    } else if (x.fp8) {
        const int c = lane & 3;
#pragma unroll
        for (int j = 0; j < 4; ++j) { const int n = (lane >> 2) + 16 * j; const LAS float* s = scr + (16 * c) * 65 + n;
            v4u o; o.x = pg8::pk4_fp8(s[0 * 65], s[1 * 65], s[2 * 65], s[3 * 65]); o.y = pg8::pk4_fp8(s[4 * 65], s[5 * 65], s[6 * 65], s[7 * 65]);
            o.z = pg8::pk4_fp8(s[8 * 65], s[9 * 65], s[10 * 65], s[11 * 65]); o.w = pg8::pk4_fp8(s[12 * 65], s[13 * 65], s[14 * 65], s[15 * 65]);
            if (n0 + n < x.N) __builtin_nontemporal_store(o, (GAS v4u*)(x.WT + (size_t)rowmap(x.map, n0 + n) * x.K + k0 + 16 * c)); }
    } else {
        const int c = lane & 7;
#pragma unroll
        for (int j = 0; j < 8; ++j) { const int n = (lane >> 3) + 8 * j; const LAS float* s = scr + (8 * c) * 65 + n;
            v4u o; o.x = pk2(s[0 * 65], s[1 * 65]); o.y = pk2(s[2 * 65], s[3 * 65]); o.z = pk2(s[4 * 65], s[5 * 65]); o.w = pk2(s[6 * 65], s[7 * 65]);
            if (n0 + n < x.N) __builtin_nontemporal_store(o, (GAS v4u*)(x.WT + ((size_t)rowmap(x.map, n0 + n) * x.K + k0 + 8 * c) * 2)); }
    }
    LDS_WAIT(); asm volatile("" ::: "memory");
}
#ifndef BG_P3
#define BG_P3 16
#endif
#ifndef BG_DEPTH3
#define BG_DEPTH3 0
#endif
DI void bg_convert(Frame& F, int lo, int hi, int rank, int nconv) {
    LAS float* scr = (LAS float*)(F.lds + F.wave * XPOSE_SCR);
    const int step = 8 * nconv;
    int ia = lo + 8 * rank + F.wave;
#if BG_DEPTH3
    f32x4 va[16], vb[16], vc[16];
    if (ia < hi) {
        int ib = ia + step, ic = ib + step;
        XItem xa = bg_decode(F, ia); xi_load(xa, va, F.lane);
        XItem xb = bg_decode(F, ib < hi ? ib : hi - 1); if (ib < hi) xi_load(xb, vb, F.lane);
        for (;;) {
            XItem xc = bg_decode(F, ic < hi ? ic : hi - 1); if (ic < hi) xi_load<0, BG_P3>(xc, vc, F.lane);
            xi_finish(xa, va, scr, F.lane);
            if (ic < hi) xi_load<BG_P3, 16>(xc, vc, F.lane);
            if (ib >= hi) break;
            ia = ic + step; xa = bg_decode(F, ia < hi ? ia : hi - 1); if (ia < hi) xi_load<0, BG_P3>(xa, va, F.lane);
            xi_finish(xb, vb, scr, F.lane);
            if (ia < hi) xi_load<BG_P3, 16>(xa, va, F.lane);
            if (ic >= hi) break;
            ib = ia + step; xb = bg_decode(F, ib < hi ? ib : hi - 1); if (ib < hi) xi_load<0, BG_P3>(xb, vb, F.lane);
            xi_finish(xc, vc, scr, F.lane);
            if (ib < hi) xi_load<BG_P3, 16>(xb, vb, F.lane);
            if (ia >= hi) break;
            ic = ib + step;
        }
    }
#else
    f32x4 va[16], vb[16];
    if (ia < hi) {
        XItem xa = bg_decode(F, ia); xi_load(xa, va, F.lane);
        for (;;) {
            const int ib = ia + step;
            XItem xb = bg_decode(F, ib < hi ? ib : hi - 1); if (ib < hi) xi_load(xb, vb, F.lane);
            xi_finish(xa, va, scr, F.lane);
            if (ib >= hi) break;
            ia = ib + step;
            xa = bg_decode(F, ia < hi ? ia : hi - 1); if (ia < hi) xi_load(xa, va, F.lane);
            xi_finish(xb, vb, scr, F.lane);
            if (ia >= hi) break;
        }
    }
#endif
    __syncthreads();
}
DI unsigned pk4_i8(float a, float b, float c, float d) {
    unsigned w = __builtin_amdgcn_cvt_pk_u8_f32(rintf(a) + 128.0f, 0, 0u); w = __builtin_amdgcn_cvt_pk_u8_f32(rintf(b) + 128.0f, 1, w);
    w = __builtin_amdgcn_cvt_pk_u8_f32(rintf(c) + 128.0f, 2, w); w = __builtin_amdgcn_cvt_pk_u8_f32(rintf(d) + 128.0f, 3, w); return w ^ 0x80808080u;
}
DI float wave_max(float v) {
#pragma unroll
    for (int o = 1; o < 64; o <<= 1) v = fmaxf(v, __shfl_xor(v, o));
    return v;
}
template <bool B16 = false>
DI void rms_phase_i8(Frame& F, const void* x, const float* gvec, unsigned char* H8, float* rowscale) {
    const int gw = F.vcu * NWAVES + F.wave, NGW = F.G * NWAVES, lane = F.lane;
    f32x4 g[8];
#pragma unroll
    for (int j = 0; j < 8; ++j) g[j] = ((const GAS f32x4*)gvec)[lane + 64 * j];
    XRow<B16> nx; if (THIN_PIPE && gw < S) nx.load((const unsigned char*)x + (size_t)gw * D * (B16 ? 2 : 4), lane);
    for (int m = gw; m < S; m += NGW) {
        XRow<B16> cu;
        if (THIN_PIPE) { cu = nx; if (m + NGW < S) nx.load((const unsigned char*)x + (size_t)(m + NGW) * D * (B16 ? 2 : 4), lane); }
        else cu.load((const unsigned char*)x + (size_t)m * D * (B16 ? 2 : 4), lane);
        f32x4 v[8]; float s = 0.f;
#pragma unroll
        for (int j = 0; j < 8; ++j) { v[j] = cu.get(j); s += (v[j].x * v[j].x + v[j].y * v[j].y) + (v[j].z * v[j].z + v[j].w * v[j].w); }
        const float rstd = 1.0f / sqrtf(wave_sum(s) * (1.0f / D) + RMS_EPS);
        float am = 0.f;
#pragma unroll
        for (int j = 0; j < 8; ++j) { v[j].x *= rstd * g[j].x; v[j].y *= rstd * g[j].y; v[j].z *= rstd * g[j].z; v[j].w *= rstd * g[j].w;
            am = fmaxf(fmaxf(am, fmaxf(fabsf(v[j].x), fabsf(v[j].y))), fmaxf(fabsf(v[j].z), fabsf(v[j].w))); }
        am = fmaxf(wave_max(am), 1e-20f);
        const float inv = 127.0f / am;
        GAS unsigned* o4 = (GAS unsigned*)(H8 + (size_t)m * D) + lane;
#pragma unroll
        for (int j = 0; j < 8; ++j) o4[64 * j] = pk4_i8(v[j].x * inv, v[j].y * inv, v[j].z * inv, v[j].w * inv);
        if (lane == 0) rowscale[m] = am * (1.0f / 127.0f);
    }
}
DI void p0_prologue(Frame& F) {
    LAS float* scr = (LAS float*)(F.lds + F.wave * XPOSE_SCR);
    const int gw = F.vcu * NWAVES + F.wave, NGW = F.G * NWAVES;
    unsigned char* WIN = F.ws + WS_WIN;
#if INPROJ_INT8
    float inv0;
    { float ss = 0.f;
#pragma unroll
      for (int j = 0; j < 16; ++j) { const f32x4 v = *(const GAS f32x4*)(F.a->in[1] + (size_t)F.lane * NIN + 4 * j); ss += (v.x * v.x + v.y * v.y) + (v.z * v.z + v.w * v.w); }
      inv0 = 127.0f / fmaxf(5.0f * sqrtf(wave_sum(ss) * (1.0f / 4096.0f)), 1e-20f); }
    { f32x4 va[16];
      for (int it = gw; it < I_IN; it += NGW) { const XItem x{F.a->in[1], WIN, D, NIN, 1, it, 2, inv0}; xi_load(x, va, F.lane); xi_finish(x, va, scr, F.lane); } }
    constexpr int WIN_ROWB = D;
#else
    for (int it = gw; it < I_IN; it += NGW) xpose_item(F.a->in[1], D, NIN, (bf16*)WIN, 1, scr, it, F.lane);
    constexpr int WIN_ROWB = 2 * D;
#endif
    { const int gt = (F.vcu * NWAVES + F.wave) * 64 + F.lane, NGT = F.G * NWAVES * 64; constexpr int PADV = (NINP - NIN) * WIN_ROWB / 16;
      for (int i = gt; i < 2 * PADV; i += NGT) { const int l = i / PADV, j = i - l * PADV; *((GAS v4u*)(WIN + (size_t)l * NINP * WIN_ROWB + (size_t)NIN * WIN_ROWB) + j) = (v4u){0u, 0u, 0u, 0u}; }
      float* TBL = (float*)(F.ws + WS_TBL); const float* rel_bias = F.a->in[16];
      for (int i = gt; i < 16 * TBL_N; i += NGT) { const int hd = i / TBL_N, d = (i - hd * TBL_N) - TBL_OFF; float v = 0.f;
          if (d >= 0) { const float e = __expf(rel_bias[t5_bucket(d) * 16 + hd]);
              if (hd >= 4 && hd < 10) { const int mult = (d <= 128 ? 1 : 0) + (((d & 3) == 0 && d <= 512) ? 1 : 0) + (((d & 15) == 0 && d <= 2048) ? 1 : 0); v = e * (float)mult; }
              else v = e; }
          TBL[i] = v; } }
    { const int gwv = F.vcu * NWAVES + F.wave;
      if (gwv < 22) { const float* Wm; int N;
          if (gwv < 2) { Wm = F.a->in[1] + (size_t)gwv * D * NIN; N = NIN; } else if (gwv < 4) { Wm = F.a->in[2] + (size_t)(gwv - 2) * D * D; N = D; } else if (gwv == 4) { Wm = F.a->in[17]; N = DFF; } else if (gwv == 5) { Wm = F.a->in[18]; N = DFF; }
          else if (gwv < 14) { Wm = F.a->in[21] + (size_t)(gwv - 6) * D * DFFE; N = DFFE; } else { Wm = F.a->in[22] + (size_t)(gwv - 14) * D * DFFE; N = DFFE; }
          float ss = 0.f;
#pragma unroll
          for (int j = 0; j < 16; ++j) { const f32x4 v = *(const GAS f32x4*)(Wm + (size_t)F.lane * N + 4 * j); ss += (v.x * v.x + v.y * v.y) + (v.z * v.z + v.w * v.w); }
          const float clip = fmaxf(5.0f * sqrtf(wave_sum(ss) * (1.0f / 4096.0f)), 1e-20f);
          if (F.lane == 0) { float* wsc = (float*)(F.ws + WS_WSC); wsc[gwv] = clip * (1.0f / 127.0f); wsc[32 + gwv] = 127.0f / clip; } } }
#if INPROJ_INT8
    rms_phase_i8(F, F.a->in[0], F.a->in[3], F.ws + WS_H, (float*)(F.ws + WS_ROUTE + RT_ROWS));
#else
    rms_phase(F, F.a->in[0], F.a->in[3], (bf16*)(F.ws + WS_H));
#endif
}

DI void pn_phase(Frame& F, int layer) {
    const int gw = F.vcu * NWAVES + F.wave, NGW = F.G * NWAVES, lane = F.lane;
    bf16* P = (bf16*)(F.ws + WS_P);
    float gs[8][8];
#pragma unroll
    for (int j = 0; j < 8; ++j) {
        const int cc = lane + 64 * j; int col, gi; const float* gv; float sc = 1.0f;
        if (j < 2) { col = 8 * cc; gi = col & 127; if (col < C_KA) { gv = F.a->in[5] + layer * 128; sc = 0.08838834764831845f * LOG2E; } else gv = F.a->in[6] + layer * 128; }
        else if (j < 5) { col = C_QB + 8 * (cc - 128); gi = (col - C_QB) & 127; if (col < C_KB) { gv = F.a->in[7] + layer * 128; sc = 0.08838834764831845f * LOG2E; } else gv = F.a->in[8] + layer * 128; }
        else { col = C_QC + 8 * (cc - 320); gi = (col - C_QC) & 63; if (col < C_KC) { gv = F.a->in[9] + layer * 64; sc = 0.125f * LOG2E; } else gv = F.a->in[10] + layer * 64; }
#pragma unroll
        for (int e = 0; e < 8; ++e) gs[j][e] = gv[gi + e] * sc;
    }
    for (int m = gw; m < S; m += NGW) {
        bf16* row = P + (size_t)m * PITCH;
        v4u raw[8];
#pragma unroll
        for (int j = 0; j < 8; ++j) { const int cc = lane + 64 * j; const int col = j < 2 ? 8 * cc : (j < 5 ? C_QB + 8 * (cc - 128) : C_QC + 8 * (cc - 320)); raw[j] = *(const GAS v4u*)(row + col); }
#pragma unroll
        for (int j = 0; j < 8; ++j) { const int cc = lane + 64 * j; const int col = j < 2 ? 8 * cc : (j < 5 ? C_QB + 8 * (cc - 128) : C_QC + 8 * (cc - 320));
            float x[8]; x[0] = bflo(raw[j].x); x[1] = bfhi(raw[j].x); x[2] = bflo(raw[j].y); x[3] = bfhi(raw[j].y); x[4] = bflo(raw[j].z); x[5] = bfhi(raw[j].z); x[6] = bflo(raw[j].w); x[7] = bfhi(raw[j].w);
            float ss = 0.f;
#pragma unroll
            for (int e = 0; e < 8; ++e) ss += x[e] * x[e];
            ss += __shfl_xor(ss, 1); ss += __shfl_xor(ss, 2); ss += __shfl_xor(ss, 4);
            float rstd;
            if (j < 5) { ss += __shfl_xor(ss, 8); rstd = 1.0f / sqrtf(ss * (1.0f / 128.0f) + RMS_EPS); } else rstd = 1.0f / sqrtf(ss * (1.0f / 64.0f) + RMS_EPS);
            v4u o; o.x = pk2(x[0] * rstd * gs[j][0], x[1] * rstd * gs[j][1]); o.y = pk2(x[2] * rstd * gs[j][2], x[3] * rstd * gs[j][3]);
            o.z = pk2(x[4] * rstd * gs[j][4], x[5] * rstd * gs[j][5]); o.w = pk2(x[6] * rstd * gs[j][6], x[7] * rstd * gs[j][7]);
            *(GAS v4u*)(row + col) = o; }
    }
}

template <bool B16 = false>
DI void rms_router_phase(Frame& F, const void* x, const float* gvec, const float* wr  , bf16* H) {
    const int gw = F.vcu * NWAVES + F.wave, NGW = F.G * NWAVES, lane = F.lane;
    LAS float* wrT = (LAS float*)(F.lds + RING_OFF);
    for (int i = F.tid; i < D * 8; i += NWAVES * 64) wrT[(i & 7) * D + (i >> 3)] = wr[i];
    __syncthreads();
    f32x4 g[8];
#pragma unroll
    for (int j = 0; j < 8; ++j) g[j] = ((const GAS f32x4*)gvec)[lane + 64 * j];
    int* tok_e = (int*)(F.ws + WS_ROUTE + RT_TOKE); int* tok_r = (int*)(F.ws + WS_ROUTE + RT_TOKR); float* tok_g = (float*)(F.ws + WS_ROUTE + RT_TOKG);
    volatile LAS unsigned* cntL = (volatile LAS unsigned*)(F.lds + RING_OFF + 65536);
    if (F.tid < 16) cntL[F.tid] = 0u;
    __syncthreads();
    int my_m = -1, my_e1 = 0, my_e2 = 0, my_l1 = 0, my_l2 = 0, kk = 0; float my_g1 = 0.f, my_g2 = 0.f;
    XRow<B16> nx; if (THIN_PIPE && gw < S) nx.load((const unsigned char*)x + (size_t)gw * D * (B16 ? 2 : 4), lane);
    for (int m = gw; m < S; m += NGW, ++kk) {
        XRow<B16> cu;
        if (THIN_PIPE) { cu = nx; if (m + NGW < S) nx.load((const unsigned char*)x + (size_t)(m + NGW) * D * (B16 ? 2 : 4), lane); }
        else cu.load((const unsigned char*)x + (size_t)m * D * (B16 ? 2 : 4), lane);
        f32x4 v[8]; float s = 0.f;
#pragma unroll
        for (int j = 0; j < 8; ++j) { v[j] = cu.get(j); s += (v[j].x * v[j].x + v[j].y * v[j].y) + (v[j].z * v[j].z + v[j].w * v[j].w); }
        const float rstd = 1.0f / sqrtf(wave_sum(s) * (1.0f / D) + RMS_EPS);
        GAS v2u* o8 = (GAS v2u*)(H + (size_t)m * D) + lane;
        float lg[8];
#pragma unroll
        for (int e = 0; e < 8; ++e) lg[e] = 0.f;
#pragma unroll
        for (int j = 0; j < 8; ++j) { v[j].x *= rstd * g[j].x; v[j].y *= rstd * g[j].y; v[j].z *= rstd * g[j].z; v[j].w *= rstd * g[j].w;
            v2u o; o.x = pk2(v[j].x, v[j].y); o.y = pk2(v[j].z, v[j].w); o8[64 * j] = o;
#pragma unroll
            for (int e = 0; e < 8; ++e) { const f32x4 w = *(const LAS f32x4*)(wrT + e * D + 4 * (lane + 64 * j)); lg[e] += (v[j].x * w.x + v[j].y * w.y) + (v[j].z * w.z + v[j].w * w.w); } }
#pragma unroll
        for (int e = 0; e < 8; ++e) lg[e] = wave_sum(lg[e]);
        int e1 = 0; float v1 = lg[0];
#pragma unroll
        for (int e = 1; e < 8; ++e) if (lg[e] > v1) { v1 = lg[e]; e1 = e; }
        int e2 = -1; float v2 = 0.f;
#pragma unroll
        for (int e = 0; e < 8; ++e) if (e != e1 && (e2 < 0 || lg[e] > v2)) { v2 = lg[e]; e2 = e; }
        if (lane == (kk & 63)) {
            const float ex = __expf(v2 - v1); my_g1 = 1.0f / (1.0f + ex); my_g2 = ex * my_g1; my_m = m; my_e1 = e1; my_e2 = e2;
            my_l1 = (int)__hip_atomic_fetch_add((LAS unsigned*)(F.lds + RING_OFF + 65536) + e1, 1u, __ATOMIC_RELAXED, __HIP_MEMORY_SCOPE_WORKGROUP);
            my_l2 = (int)__hip_atomic_fetch_add((LAS unsigned*)(F.lds + RING_OFF + 65536) + e2, 1u, __ATOMIC_RELAXED, __HIP_MEMORY_SCOPE_WORKGROUP);
        }
    }
    __syncthreads();
    if (F.tid < 8) cntL[8 + F.tid] = __hip_atomic_fetch_add((unsigned*)(F.ctl + CW_CNT + 64 * F.tid), cntL[F.tid], RLX_AGENT);
    __syncthreads();
#if GATHER_FUSED == 1
    {
        int* tok_s = (int*)(F.ws + WS_ROUTE + RT_TOKS); float* slot_g = (float*)(F.ws + WS_ROUTE + RT_SLOTG); float* slot_s = (float*)(F.ws + WS_ROUTE + RT_SLOTS);
        unsigned char* HS = F.ws + WS_HS;
        VM_WAIT();
        __builtin_amdgcn_fence(__ATOMIC_RELEASE, "agent"); __builtin_amdgcn_fence(__ATOMIC_ACQUIRE, "agent");
        VM_WAIT();
        for (int r = 0; r < kk; ++r) {
            const int m = __shfl(my_m, r), e1 = __shfl(my_e1, r), e2 = __shfl(my_e2, r);
            const int s1 = e1 * MOE_CAP + (int)cntL[8 + e1] + __shfl(my_l1, r), s2 = e2 * MOE_CAP + (int)cntL[8 + e2] + __shfl(my_l2, r);
            const float g1 = __shfl(my_g1, r), g2 = __shfl(my_g2, r);
            const GAS v4u* src = (const GAS v4u*)(H + (size_t)m * D) + 4 * lane;
            v4u o[2]; float xv[32]; float am = 0.f;
#pragma unroll
            for (int j = 0; j < 4; ++j) { const v4u a = src[j];
                xv[8 * j] = bflo(a.x); xv[8 * j + 1] = bfhi(a.x); xv[8 * j + 2] = bflo(a.y); xv[8 * j + 3] = bfhi(a.y); xv[8 * j + 4] = bflo(a.z); xv[8 * j + 5] = bfhi(a.z); xv[8 * j + 6] = bflo(a.w); xv[8 * j + 7] = bfhi(a.w); }
#pragma unroll
            for (int j = 0; j < 32; ++j) am = fmaxf(am, fabsf(xv[j]));
            am = fmaxf(wave_max(am), 1e-20f);
            const float inv = 127.0f / am;
#pragma unroll
            for (int j = 0; j < 2; ++j) { o[j].x = pk4_i8(xv[16 * j] * inv, xv[16 * j + 1] * inv, xv[16 * j + 2] * inv, xv[16 * j + 3] * inv); o[j].y = pk4_i8(xv[16 * j + 4] * inv, xv[16 * j + 5] * inv, xv[16 * j + 6] * inv, xv[16 * j + 7] * inv);
                o[j].z = pk4_i8(xv[16 * j + 8] * inv, xv[16 * j + 9] * inv, xv[16 * j + 10] * inv, xv[16 * j + 11] * inv); o[j].w = pk4_i8(xv[16 * j + 12] * inv, xv[16 * j + 13] * inv, xv[16 * j + 14] * inv, xv[16 * j + 15] * inv); }
            GAS v4u* d1 = (GAS v4u*)(HS + (size_t)s1 * D) + 2 * lane; GAS v4u* d2 = (GAS v4u*)(HS + (size_t)s2 * D) + 2 * lane;
            d1[0] = o[0]; d1[1] = o[1]; d2[0] = o[0]; d2[1] = o[1];
            if (lane == 0) { tok_s[2 * m] = s1; tok_s[2 * m + 1] = s2; slot_g[s1] = g1; slot_g[s2] = g2; slot_s[s1] = am * (1.0f / 127.0f); slot_s[s2] = am * (1.0f / 127.0f); }
        }
    }
#else
    if (my_m >= 0) { tok_e[2 * my_m] = my_e1; tok_e[2 * my_m + 1] = my_e2; tok_r[2 * my_m] = (int)cntL[8 + my_e1] + my_l1; tok_r[2 * my_m + 1] = (int)cntL[8 + my_e2] + my_l2;
        tok_g[2 * my_m] = my_g1; tok_g[2 * my_m + 1] = my_g2; }
#endif
    __syncthreads();
}
DI void moe_offsets(Frame& F, int (&off)[9]) {
    int acc = 0;
#pragma unroll
    for (int e = 0; e < 8; ++e) { off[e] = acc; const int c = (int)__hip_atomic_load((unsigned*)(F.ctl + CW_CNT + 64 * e), RLX_AGENT); acc += (c + 255) & ~255; }
    off[8] = acc;
}
DI void gather_phase(Frame& F) {
    const int gw = F.vcu * NWAVES + F.wave, NGW = F.G * NWAVES, lane = F.lane;
    int off[9]; moe_offsets(F, off);
    const int* tok_e = (const int*)(F.ws + WS_ROUTE + RT_TOKE); const int* tok_r = (const int*)(F.ws + WS_ROUTE + RT_TOKR); const float* tok_g = (const float*)(F.ws + WS_ROUTE + RT_TOKG);
    int* tok_s = (int*)(F.ws + WS_ROUTE + RT_TOKS); float* slot_g = (float*)(F.ws + WS_ROUTE + RT_SLOTG);
    const bf16* H = (const bf16*)(F.ws + WS_H); unsigned char* HS = F.ws + WS_HS;
    v4u nraw[4]; int ne1 = 0, ne2 = 0, nr1 = 0, nr2 = 0; float ng1 = 0.f, ng2 = 0.f;
    if (gw < S) { ne1 = tok_e[2 * gw]; ne2 = tok_e[2 * gw + 1]; nr1 = tok_r[2 * gw]; nr2 = tok_r[2 * gw + 1]; ng1 = tok_g[2 * gw]; ng2 = tok_g[2 * gw + 1];
#pragma unroll
        for (int j = 0; j < 4; ++j) nraw[j] = ((const GAS v4u*)(H + (size_t)gw * D) + 4 * lane)[j]; }
    for (int m = gw; m < S; m += NGW) {
        const int e1 = ne1, e2 = ne2, r1 = nr1, r2 = nr2; const float tg1 = ng1, tg2 = ng2;
        v4u raw[4];
#pragma unroll
        for (int j = 0; j < 4; ++j) raw[j] = nraw[j];
        if (m + NGW < S) { const int mn = m + NGW; ne1 = tok_e[2 * mn]; ne2 = tok_e[2 * mn + 1]; nr1 = tok_r[2 * mn]; nr2 = tok_r[2 * mn + 1]; ng1 = tok_g[2 * mn]; ng2 = tok_g[2 * mn + 1];
#pragma unroll
            for (int j = 0; j < 4; ++j) nraw[j] = ((const GAS v4u*)(H + (size_t)mn * D) + 4 * lane)[j]; }
        int o1 = 0, o2 = 0;
#pragma unroll
        for (int e = 0; e < 8; ++e) { o1 = (e == e1) ? (GATHER_FUSED ? e * MOE_CAP : off[e]) : o1; o2 = (e == e2) ? (GATHER_FUSED ? e * MOE_CAP : off[e]) : o2; }
        const int s1 = o1 + r1, s2 = o2 + r2;
        v4u o[2];
#if GU_INT8
        float xv[32]; float am = 0.f;
#pragma unroll
        for (int j = 0; j < 4; ++j) { const v4u a = raw[j];
            xv[8 * j] = bflo(a.x); xv[8 * j + 1] = bfhi(a.x); xv[8 * j + 2] = bflo(a.y); xv[8 * j + 3] = bfhi(a.y); xv[8 * j + 4] = bflo(a.z); xv[8 * j + 5] = bfhi(a.z); xv[8 * j + 6] = bflo(a.w); xv[8 * j + 7] = bfhi(a.w); }
#pragma unroll
        for (int j = 0; j < 32; ++j) am = fmaxf(am, fabsf(xv[j]));
        am = fmaxf(wave_max(am), 1e-20f);
        const float inv = 127.0f / am;
#pragma unroll
        for (int j = 0; j < 2; ++j) { o[j].x = pk4_i8(xv[16 * j] * inv, xv[16 * j + 1] * inv, xv[16 * j + 2] * inv, xv[16 * j + 3] * inv); o[j].y = pk4_i8(xv[16 * j + 4] * inv, xv[16 * j + 5] * inv, xv[16 * j + 6] * inv, xv[16 * j + 7] * inv);
            o[j].z = pk4_i8(xv[16 * j + 8] * inv, xv[16 * j + 9] * inv, xv[16 * j + 10] * inv, xv[16 * j + 11] * inv); o[j].w = pk4_i8(xv[16 * j + 12] * inv, xv[16 * j + 13] * inv, xv[16 * j + 14] * inv, xv[16 * j + 15] * inv); }
        if (lane == 0) { float* slot_s = (float*)(F.ws + WS_ROUTE + RT_SLOTS); slot_s[s1] = am * (1.0f / 127.0f); slot_s[s2] = am * (1.0f / 127.0f); }
#else
#pragma unroll
        for (int j = 0; j < 2; ++j) { const v4u a = src[2 * j], b = src[2 * j + 1];
            o[j].x = pg8::pk4_fp8(bflo(a.x), bfhi(a.x), bflo(a.y), bfhi(a.y)); o[j].y = pg8::pk4_fp8(bflo(a.z), bfhi(a.z), bflo(a.w), bfhi(a.w));
            o[j].z = pg8::pk4_fp8(bflo(b.x), bfhi(b.x), bflo(b.y), bfhi(b.y)); o[j].w = pg8::pk4_fp8(bflo(b.z), bfhi(b.z), bflo(b.w), bfhi(b.w)); }
#endif
        GAS v4u* d1 = (GAS v4u*)(HS + (size_t)s1 * D) + 2 * lane; GAS v4u* d2 = (GAS v4u*)(HS + (size_t)s2 * D) + 2 * lane;
        d1[0] = o[0]; d1[1] = o[1]; d2[0] = o[0]; d2[1] = o[1];
        if (lane == 0) { tok_s[2 * m] = s1; tok_s[2 * m + 1] = s2; slot_g[s1] = tg1; slot_g[s2] = tg2; }
    }
    for (int p = gw; p < off[8]; p += NGW) {
        int e = 0;
#pragma unroll
        for (int k = 1; k < 8; ++k) e += (p >= off[k]) ? 1 : 0;
        int oe = 0;
#pragma unroll
        for (int k = 0; k < 8; ++k) oe = (k == e) ? off[k] : oe;
        const int c = (int)__hip_atomic_load((unsigned*)(F.ctl + CW_CNT + 64 * e), RLX_AGENT);
        if (p >= oe + c) { const int ps = GATHER_FUSED ? e * MOE_CAP + (p - oe) : p;
            GAS v4u* d = (GAS v4u*)(HS + (size_t)ps * D) + 2 * lane; d[0] = (v4u){0u, 0u, 0u, 0u}; d[1] = (v4u){0u, 0u, 0u, 0u};
            if (lane == 0) { slot_g[ps] = 0.f; ((float*)(F.ws + WS_ROUTE + RT_SLOTS))[ps] = 0.f; } }
    }
}
DI f32x4 moe_row_piece(const float* OUTM, const float* OUTP, const int (&rt0)[9], int n_full, int sl, int slot, int jj, int lane) {
#if GATHER_FUSED
    const int pmf = slot >> 8, ef = pmf / MOE_CT; int rb = 0, nr = 1;
#pragma unroll
    for (int k = 0; k < 8; ++k) { rb = (k == ef) ? rt0[k] : rb; nr = (k == ef) ? (rt0[k + 1] - rt0[k]) : nr; }
    const int pm = rb + (pmf - ef * MOE_CT);
#else
    const int pm = slot >> 8; int rb = 0, nr = 1;
#pragma unroll
    for (int k = 0; k < 8; ++k) { const bool in = (pm >= rt0[k]) && (pm < rt0[k + 1]); rb = in ? rt0[k] : rb; nr = in ? (rt0[k + 1] - rt0[k]) : nr; }
#endif
#ifdef MOE_ROWMAJOR
    const int L = rb * (D / 256) + (pm - rb) * (D / 256) + jj;
#else
    const int L = rb * (D / 256) + jj * nr + (pm - rb);
#endif
#if OUTM_BF16
    if (L < n_full) return xrow4<true>((const bf16*)OUTM + (size_t)slot * D + jj * 256, lane);
#else
    if (L < n_full) return *((const GAS f32x4*)(OUTM + (size_t)slot * D + jj * 256) + lane);
#endif
    f32x4 a = (f32x4){0.f, 0.f, 0.f, 0.f}; const int j = L - n_full;
    for (int p = 0; p < sl; ++p) a += *((const GAS f32x4*)(OUTP + (size_t)(j * sl + p) * 65536 + (size_t)(slot & 255) * 256) + lane);
    return a;
}
#ifndef XB_BF16
#define XB_BF16 1
#endif
DI void combine_phase(Frame& F) {
    const int gw = F.vcu * NWAVES + F.wave, NGW = F.G * NWAVES, lane = F.lane;
    const int* tok_s = (const int*)(F.ws + WS_ROUTE + RT_TOKS); const float* XB = (const float*)(F.ws + WS_XB); const float* OUTM = (const float*)(F.ws + WS_OUTM); const float* OUTP = (const float*)(F.ws + WS_OUTP);
    int off[9]; moe_offsets(F, off); int rt0[9];
#pragma unroll
    for (int e = 0; e < 9; ++e) rt0[e] = off[e] >> 8;
    int n_full, sl; pg8::moe_slice_plan(rt0[8] * (D / 256), F.G, n_full, sl);
#if THIN_PIPE
    for (int m = gw; m < S; m += 2 * NGW) {
        const int mb = (m + NGW < S) ? m + NGW : m;
        const int sa1 = tok_s[2 * m], sa2 = tok_s[2 * m + 1], sb1 = tok_s[2 * mb], sb2 = tok_s[2 * mb + 1];
        const unsigned char* aa = (const unsigned char*)XB + (size_t)m * D * (XB_BF16 ? 2 : 4); const unsigned char* ab = (const unsigned char*)XB + (size_t)mb * D * (XB_BF16 ? 2 : 4);
        f32x4 ra[8], rb[8];
#pragma unroll
        for (int jj = 0; jj < 8; ++jj) ra[jj] = (xrow4<XB_BF16 != 0>(aa, lane + 64 * jj) + moe_row_piece(OUTM, OUTP, rt0, n_full, sl, sa1, jj, lane)) + moe_row_piece(OUTM, OUTP, rt0, n_full, sl, sa2, jj, lane);
#pragma unroll
        for (int jj = 0; jj < 8; ++jj) rb[jj] = (xrow4<XB_BF16 != 0>(ab, lane + 64 * jj) + moe_row_piece(OUTM, OUTP, rt0, n_full, sl, sb1, jj, lane)) + moe_row_piece(OUTM, OUTP, rt0, n_full, sl, sb2, jj, lane);
        GAS f32x4* oa = (GAS f32x4*)(F.out + (size_t)m * D) + lane; GAS f32x4* ob = (GAS f32x4*)(F.out + (size_t)mb * D) + lane;
#pragma unroll
        for (int jj = 0; jj < 8; ++jj) oa[64 * jj] = ra[jj];
        if (mb != m) {
#pragma unroll
            for (int jj = 0; jj < 8; ++jj) ob[64 * jj] = rb[jj]; }
    }
#else
    for (int m = gw; m < S; m += NGW) {
        const int s1 = tok_s[2 * m], s2 = tok_s[2 * m + 1];
        const unsigned char* a = (const unsigned char*)XB + (size_t)m * D * (XB_BF16 ? 2 : 4);
        GAS f32x4* o = (GAS f32x4*)(F.out + (size_t)m * D) + lane;
#pragma unroll
        for (int jj = 0; jj < 8; ++jj) o[64 * jj] = (xrow4<XB_BF16 != 0>(a, lane + 64 * jj) + moe_row_piece(OUTM, OUTP, rt0, n_full, sl, s1, jj, lane)) + moe_row_piece(OUTM, OUTP, rt0, n_full, sl, s2, jj, lane);
    }
#endif
}

#ifndef SC_NT
#define SC_NT 0
#endif
DI void i1_unit(Frame& F, int u, int kb_lo, int kb_hi) {
    const int lane = F.lane, tid = F.tid, r = lane & 31, hf = lane >> 5;
    const bf16* P = (const bf16*)(F.ws + WS_P); float* SC = (float*)(F.ws + WS_SC);
    const int aq = (r >> 2) & 1, ah = ((r >> 3) << 2) | (r & 3);
    const int t0 = 32 * u + 4 * F.wave;
    LAS unsigned char* ring = F.lds + RING_OFF;
    bf16x8 af[2][4]; float wv[2][16];
#pragma unroll
    for (int mb = 0; mb < 2; ++mb) {
#pragma unroll
        for (int s = 0; s < 4; ++s) af[mb][s] = *(const GAS bf16x8*)(P + (size_t)(t0 + 2 * mb + aq) * PITCH + C_QI + ah * 64 + 16 * s + 8 * hf);
        const GAS v4u* wp = (const GAS v4u*)(P + (size_t)(t0 + 2 * mb + hf) * PITCH + C_WI); const v4u w0 = wp[0], w1 = wp[1];
        wv[mb][0] = bflo(w0.x); wv[mb][1] = bfhi(w0.x); wv[mb][2] = bflo(w0.y); wv[mb][3] = bfhi(w0.y); wv[mb][4] = bflo(w0.z); wv[mb][5] = bfhi(w0.z); wv[mb][6] = bflo(w0.w); wv[mb][7] = bfhi(w0.w);
        wv[mb][8] = bflo(w1.x); wv[mb][9] = bfhi(w1.x); wv[mb][10] = bflo(w1.y); wv[mb][11] = bfhi(w1.y); wv[mb][12] = bflo(w1.z); wv[mb][13] = bfhi(w1.z); wv[mb][14] = bflo(w1.w); wv[mb][15] = bfhi(w1.w);
#pragma unroll
        for (int i = 0; i < 16; ++i) wv[mb][i] *= 0.03125f;
    }
    if (kb_hi <= kb_lo) return;
    const int c_lo = kb_lo >> 3, c_hi = (kb_hi + 7) >> 3;
    v4u st[4];
#define I1_ISSUE(c) do { _Pragma("unroll") for (int i_ = 0; i_ < 4; ++i_) { const int p_ = tid + 512 * i_; int key_ = 256 * (c) + (p_ >> 3); key_ = key_ < S ? key_ : S - 1; \
        st[i_] = *(const GAS v4u*)(P + (size_t)key_ * PITCH + C_KI + 8 * (p_ & 7)); } } while (0)
#define I1_WRITE(b) do { _Pragma("unroll") for (int i_ = 0; i_ < 4; ++i_) { const int p_ = tid + 512 * i_, k_ = p_ >> 3; \
        *(LAS v4u*)(ring + (b) * 32768 + k_ * 128 + (((p_ & 7) ^ (k_ & 7)) << 4)) = st[i_]; } } while (0)
    I1_ISSUE(c_lo); I1_WRITE(c_lo & 1);
    __syncthreads();
    for (int c = c_lo; c < c_hi; ++c) {
        const bool more = (c + 1 < c_hi);
        if (more) I1_ISSUE(c + 1);
        const LAS unsigned char* buf = ring + (c & 1) * 32768;
        const int kbs = (kb_lo - 8 * c) > 0 ? (kb_lo - 8 * c) : 0, kbe = (kb_hi - 8 * c) < 8 ? (kb_hi - 8 * c) : 8;
        for (int kb = kbs; kb < kbe; ++kb) {
            const LAS unsigned char* kp = buf + (kb * 32 + r) * 128;
            bf16x8 bc[4];
#pragma unroll
            for (int s = 0; s < 4; ++s) bc[s] = *(const LAS bf16x8*)(kp + (((2 * s + hf) ^ (r & 7)) << 4));
#pragma unroll
            for (int mb = 0; mb < 2; ++mb) {
                f32x16 acc;
#pragma unroll
                for (int i = 0; i < 16; ++i) acc[i] = 0.f;
#pragma unroll
                for (int s = 0; s < 4; ++s) acc = __builtin_amdgcn_mfma_f32_32x32x16_bf16(af[mb][s], bc[s], acc, 0, 0, 0);
                float sc = 0.f;
#pragma unroll
                for (int i = 0; i < 16; ++i) sc += wv[mb][i] * fmaxf(acc[i], 0.f);
#if SC_NT
                __builtin_nontemporal_store(sc, (GAS float*)SC + ((size_t)(t0 + 2 * mb + hf) * S + 256 * c + 32 * kb + r));
#else
                SC[(size_t)(t0 + 2 * mb + hf) * S + 256 * c + 32 * kb + r] = sc;
#endif
            }
        }
        if (more) I1_WRITE((c + 1) & 1);
        __syncthreads();
    }
#undef I1_ISSUE
#undef I1_WRITE
}
DI void i1_phase(Frame& F) {
    const int c = F.vcu;
    if (F.G == 256) {
        if (c < 128) { i1_unit(F, c, 0, c + 1); i1_unit(F, 255 - c, 0, 127 - c); }
        else i1_unit(F, c, c - 128, c + 1);
    } else for (int u = c; u < S / 32; u += F.G) i1_unit(F, u, 0, u + 1);
}

DI int wave_sum_i(int v) {
#pragma unroll
    for (int o = 1; o < 64; o <<= 1) v += __shfl_xor(v, o);
    return v;
}
#define WRITELANE(x, v, L) asm volatile("s_nop 1\n\tv_writelane_b32 %0, %1, %2" : "+v"(x) : "s"(v), "n"(L))
template <int NREG>
DI void i2_select(const float* srow, unsigned* wrow, int t, int lane, LAS unsigned* cbuf  ) {
    constexpr int K = 256, CAP = 128;
    unsigned key[NREG];
    const GAS float* sp = (const GAS float*)srow + lane;
    const int limit = t - lane;
#pragma unroll
    for (int i = 0; i < NREG; ++i) { const unsigned u = __builtin_bit_cast(unsigned, SC_NT ? __builtin_nontemporal_load(sp + 64 * i) : sp[64 * i]); const unsigned k = (u & 0x80000000u) ? ~u : (u | 0x80000000u); key[i] = (limit >= 64 * i) ? k : 0u; }
    unsigned T = 0u; int cT = t + 1, cU = 0, bit = 31;
    if (t >= 1024) {
        unsigned mx = 0u;
#pragma unroll
        for (int i = 0; i < NREG; ++i) mx = key[i] > mx ? key[i] : mx;
#pragma unroll
        for (int o = 1; o < 64; o <<= 1) { const unsigned other = (unsigned)__shfl_xor((int)mx, o); mx = other > mx ? other : mx; }
        unsigned Th = mx & 0xFF800000u; int cprev = 0;
        for (int step = 0; step < 6; ++step) {
            int cl = 0;
#pragma unroll
            for (int i = 0; i < NREG; ++i) cl += (key[i] >= Th) ? 1 : 0;
            const int c = wave_sum_i(cl);
            if (c >= K) { T = Th; cT = c; cU = cprev; bit = 22; break; }
            cprev = c;
            if (Th < 0x00800000u) break;
            Th -= 0x00800000u;
        }
    }
    for (; bit >= 0; --bit) {
        if (cT - cU <= CAP) break;
        const unsigned cand = T | (1u << bit);
        int cl = 0;
#pragma unroll
        for (int i = 0; i < NREG; ++i) cl += (key[i] >= cand) ? 1 : 0;
        const int c = wave_sum_i(cl);
        if (c >= K) { T = cand; cT = c; } else cU = c;
    }
    if (bit >= 0) {
        const unsigned width = (bit == 31) ? 0xFFFFFFFFu : ((2u << bit) - 1u);
        int pos = 0;
#pragma unroll
        for (int i = 0; i < NREG; ++i) {
            const bool inb = (key[i] != 0u) && ((key[i] - T) <= width);
            const unsigned long long m = __ballot(inb);
            if (m != 0ull) { const int idx = pos + (int)__builtin_amdgcn_mbcnt_hi((unsigned)(m >> 32), __builtin_amdgcn_mbcnt_lo((unsigned)m, 0u)); if (inb && idx < CAP) cbuf[idx] = key[i]; pos += __popcll(m); }
        }
        LDS_WAIT(); asm volatile("" ::: "memory");
        const unsigned c0 = (lane < pos) ? cbuf[lane] : 0u, c1 = (lane + 64 < pos) ? cbuf[lane + 64] : 0u;
        LDS_WAIT(); asm volatile("" ::: "memory");
        for (; bit >= 0; --bit) {
            const unsigned cand = T | (1u << bit);
            const int c = cU + __popcll(__ballot(c0 >= cand)) + __popcll(__ballot(c1 >= cand));
            if (c >= K) { T = cand; cT = c; }
        }
    }
    unsigned lo0 = 0u, hi0 = 0u, lo1 = 0u, hi1 = 0u;
    if (cT == K && T != 0u) {
#pragma unroll
        for (int i = 0; i < NREG; ++i) {
            const unsigned long long sm = __ballot(key[i] >= T);
            if (i < 64) { WRITELANE(lo0, (unsigned)sm, i & 63); WRITELANE(hi0, (unsigned)(sm >> 32), i & 63); }
            else { WRITELANE(lo1, (unsigned)sm, i & 63); WRITELANE(hi1, (unsigned)(sm >> 32), i & 63); }
        }
    } else {
    int cg = 0;
#pragma unroll
    for (int i = 0; i < NREG; ++i) cg += __popcll(__ballot(key[i] > T));
    const int need = K - cg;
    unsigned T1 = T + 1u; asm volatile("" : "+v"(T1));
    int running = 0;
#pragma unroll
    for (int i = 0; i < NREG; ++i) {
        const bool nz = key[i] != 0u;
        const bool eq = nz && (key[i] == T);
        const unsigned long long eqm = __ballot(eq);
        const int myrank = running + (int)__builtin_amdgcn_mbcnt_hi((unsigned)(eqm >> 32), __builtin_amdgcn_mbcnt_lo((unsigned)eqm, 0u));
        const bool sel = nz && ((key[i] >= T1) || (eq && myrank < need));
        const unsigned long long sm = __ballot(sel);
        running += __popcll(eqm);
        if (i < 64) { WRITELANE(lo0, (unsigned)sm, i & 63); WRITELANE(hi0, (unsigned)(sm >> 32), i & 63); }
        else { WRITELANE(lo1, (unsigned)sm, i & 63); WRITELANE(hi1, (unsigned)(sm >> 32), i & 63); }
    }
    }
    if (NREG <= 64) { if (lane < NREG) *(GAS v2u*)(wrow + 2 * lane) = (v2u){lo0, hi0}; }
    else { *(GAS v2u*)(wrow + 2 * lane) = (v2u){lo0, hi0}; if (lane < NREG - 64) *(GAS v2u*)(wrow + 128 + 2 * lane) = (v2u){lo1, hi1}; }
}
DI void i2_phase(Frame& F) {
    const int gw = F.vcu * NWAVES + F.wave, NGW = F.G * NWAVES;
    const float* SC = (const float*)(F.ws + WS_SC); unsigned* WM = (unsigned*)(F.ws + WS_WM);
    LAS unsigned* cbuf = (LAS unsigned*)(F.lds + RING_OFF) + F.wave * 128;
    for (int t = gw; t < 2048; t += NGW) i2_select<32>(SC + (size_t)t * S, WM + (size_t)t * 256, t, F.lane, cbuf);
    for (int t = 2048 + gw; t < 4096; t += NGW) i2_select<64>(SC + (size_t)t * S, WM + (size_t)t * 256, t, F.lane, cbuf);
    for (int t = 4096 + gw; t < 6144; t += NGW) i2_select<96>(SC + (size_t)t * S, WM + (size_t)t * 256, t, F.lane, cbuf);
    for (int t = 6144 + gw; t < 8192; t += NGW) i2_select<128>(SC + (size_t)t * S, WM + (size_t)t * 256, t, F.lane, cbuf);
}

typedef __bf16 bf16x2_t __attribute__((ext_vector_type(2)));
typedef float f32x2_t __attribute__((ext_vector_type(2)));
typedef short v4i16_t __attribute__((ext_vector_type(4)));
DI unsigned cvtpk_s(float lo, float hi) { f32x2_t v = {lo, hi}; bf16x2_t b = __builtin_convertvector(v, bf16x2_t); return __builtin_bit_cast(unsigned, b); }
DI s16x4 vtr(const LAS unsigned char* p) { return __builtin_bit_cast(s16x4, __builtin_amdgcn_ds_read_tr16_b64_v4i16((LAS v4i16_t*)p)); }
DI unsigned off_a(unsigned row, unsigned ch) { return 2048u * (row >> 3) + 512u * (ch >> 2) + 64u * (row & 7) + 16u * ((ch & 3) ^ ((row >> 2) & 3)); }

#ifndef DBG_NOMASK
#define DBG_NOMASK 0
#endif
DI float and_mask_f(float v, int m) { return __builtin_bit_cast(float, __builtin_bit_cast(int, v) & m); }
#define SBAR() __builtin_amdgcn_sched_barrier(0)
#ifndef ATT_SEG
#define ATT_SEG 0
#endif
#ifndef ATT_SGB
#define ATT_SGB 0
#endif
#if ATT_SGB
#define SBF() do { } while (0)
#else
#define SBF() __builtin_amdgcn_sched_barrier(0)
#endif
#define SGB(mask, n) __builtin_amdgcn_sched_group_barrier((mask), (n), 0);
#ifndef ATT_L2_TOUCH
#define ATT_L2_TOUCH 0
#endif
#ifndef FARSPEC
#define FARSPEC 0
#endif
#ifndef ATT_STAGGER
#define ATT_STAGGER 0
#endif
#ifndef ATT_QBMAJOR
#define ATT_QBMAJOR 0
#endif
#ifndef ATT_WIDE
#define ATT_WIDE 0
#endif
#ifndef ATT_PREF
#define ATT_PREF 0
#endif
#ifndef PREF_AB
#define PREF_AB 0
#endif
#ifndef PREF_KB
#define PREF_KB 0
#endif
#ifndef PREF_VA
#define PREF_VA 0
#endif
#ifndef PREF_VB
#define PREF_VB 0
#endif
#ifndef KIND2_FUSED
#define KIND2_FUSED 1
#endif
constexpr int AT_SLOT = 32768, AT_BUF = 65536;


template <int KIND, int I, bool FAR> DI void at_sm_el(f32x16& Sx, const float (&tv)[16], int mm, float& lsum) {
    float p = __builtin_amdgcn_exp2f(Sx[I]); if (!FAR) p *= tv[I];
    if (KIND == 0 && !DBG_NOMASK) p = and_mask_f(p, __builtin_amdgcn_sbfe(mm, (I & 3) + 8 * (I >> 2), 1));
    Sx[I] = p; lsum += p;
}
DI void at_pack(const f32x16& Sx, bf16x8 (&pb)[2]) {
#pragma unroll
    for (int s2 = 0; s2 < 2; ++s2) { v4u pw; pw.x = cvtpk_s(Sx[8 * s2], Sx[8 * s2 + 1]); pw.y = cvtpk_s(Sx[8 * s2 + 2], Sx[8 * s2 + 3]);
        pw.z = cvtpk_s(Sx[8 * s2 + 4], Sx[8 * s2 + 5]); pw.w = cvtpk_s(Sx[8 * s2 + 6], Sx[8 * s2 + 7]); pb[s2] = __builtin_bit_cast(bf16x8, pw); }
}
struct AttnShared { float m2[3]; float lam; float post; };

template <int KIND>
DI void attn_unit(Frame& F, int layer, int head, int qb, const AttnShared& sh) {
    int tid = F.tid; asm volatile("" : "+v"(tid));
    constexpr bool WIDE = (KIND != 2) && ATT_WIDE;
    const int lane = tid & 63, w = F.wave, g = WIDE ? 0 : (w >> 2), wq = WIDE ? w : (w & 3), r = lane & 31, hf = lane >> 5;
    const bf16* P = (const bf16*)(F.ws + WS_P);
    const int colQ = (KIND == 0 ? C_QA : (KIND == 1 ? C_QB : C_QC)) + 128 * head;
    const int colK = (KIND == 0 ? C_KA : (KIND == 1 ? C_KB : C_KC)) + 128 * head;
    const int colV = (KIND == 0 ? C_VA : (KIND == 1 ? C_VB : C_VC)) + 128 * head;
    const int outc = (KIND == 0 ? 0 : (KIND == 1 ? 512 : 1280)) + 128 * head;
    const int tblh = (KIND == 0 ? 0 : (KIND == 1 ? 4 : 10)) + head;
    const int q0 = (WIDE ? 256 : 128) * qb, kbeg = (KIND == 1) ? (q0 > 2048 ? q0 - 2048 : 0) : 0, nss = (q0 + (WIDE ? 256 : 128) - kbeg) >> 7;
    const int qrow0 = q0 + 32 * wq, myq = qrow0 + r;
    constexpr int NQS = (KIND == 2) ? 4 : 8;
    LAS unsigned char* ring = F.lds + RING_OFF;
    LAS float* tblL = (LAS float*)(F.lds + LDS_TBL_OFF);
    { unsigned char* wsp_ = F.ws; asm volatile("" : "+s"(wsp_));
      const float* TB = (const float*)(wsp_ + WS_TBL) + tblh * TBL_N; for (int i = tid; i < TBL_N; i += NWAVES * 64) tblL[i] = TB[i]; }
    bf16x8 qf[NQS];
#pragma unroll
    for (int s = 0; s < NQS; ++s) qf[s] = *(const GAS bf16x8*)(P + (size_t)myq * PITCH + colQ + (KIND == 2 ? 64 * g : 0) + 16 * s + 8 * hf);
    const int ld_o = 16 * tid, ld_row = ((ld_o >> 11) << 3) | ((ld_o >> 6) & 7), ld_ch = (((ld_o >> 9) & 3) << 2) | (((ld_o >> 4) & 3) ^ ((ld_row >> 2) & 3));
    const bf16* ld_src = P + (size_t)ld_row * PITCH + 8 * ld_ch;
#define AT_ISSUE(ss, b) do { _Pragma("unroll") for (int i_ = 0; i_ < 8; ++i_) \
        __builtin_amdgcn_global_load_lds((const unsigned*)(ld_src + (size_t)(kbeg + 128 * (ss) + 64 * (i_ >> 2) + 32 * (i_ & 1)) * PITCH + (((i_ >> 1) & 1) ? colV : colK)), \
                                         (LAS unsigned*)(ring + (b) * AT_BUF + i_ * 8192 + w * 1024), 16, 0, 0); } while (0)
    AT_ISSUE(0, 0);
    const unsigned* WM = (const unsigned*)(F.ws + WS_WM);
    v4u mw = (v4u){0u, 0u, 0u, 0u}, mwn = (v4u){0u, 0u, 0u, 0u};
    if (KIND == 0) { if (WIDE) mw = *(const GAS v4u*)(WM + (size_t)myq * 256); else { const v2u t_ = *(const GAS v2u*)(WM + (size_t)myq * 256 + (2 * g)); mw.x = t_.x; mw.y = t_.y; } }
    __syncthreads();
    const unsigned kbase_e = 2048u * (r >> 3) + 64u * (r & 7) + 16u * ((unsigned)hf ^ ((r >> 2) & 3)) + (KIND == 2 ? 1024u * g : 0u);
    const unsigned kbase_o = 2048u * (r >> 3) + 64u * (r & 7) + 16u * ((2u + hf) ^ ((r >> 2) & 3)) + (KIND == 2 ? 1024u * g : 0u);
    const unsigned i16 = lane & 15, tq = i16 >> 2, tp = i16 & 3, blk = (lane >> 4) & 1;
    const unsigned vbase0 = 64u * (4 * hf + tq) + 16u * ((2 * blk + (tp >> 1)) ^ (unsigned)hf) + 8u * (tp & 1);
    const unsigned vbase1 = 64u * (4 * hf + tq) + 16u * ((2 * blk + (tp >> 1)) ^ (2u + hf)) + 8u * (tp & 1);
    f32x16 O[4];
#pragma unroll
    for (int b = 0; b < 4; ++b)
#pragma unroll
        for (int i = 0; i < 16; ++i) O[b][i] = 0.f;
    float lsum = 0.f;
    const float sinit = -sh.m2[KIND];
    const float sinit_far = (KIND != 1) ? __builtin_bit_cast(float, __builtin_amdgcn_readfirstlane(__builtin_bit_cast(int, sinit + __builtin_amdgcn_logf(tblL[TBL_N - 1])))) : sinit;

#define AT_BLOCK(Kimg, Vimg, k0_, mword) do { \
        const int k0 = (k0_); \
        if (k0 <= qrow0 + 31 && !(KIND == 1 && qrow0 - (k0 + 31) > 2048)) { \
            f32x16 Sx; _Pragma("unroll") for (int i = 0; i < 16; ++i) Sx[i] = sinit; \
            _Pragma("unroll") for (int s = 0; s < NQS; ++s) { const bf16x8 kf = *(const LAS bf16x8*)((Kimg) + ((s & 1) ? kbase_o : kbase_e) + 512 * (s >> 1)); \
                Sx = __builtin_amdgcn_mfma_f32_32x32x16_bf16(kf, qf[s], Sx, 0, 0, 0); } \
            { const LAS float* tp_ = tblL + ((KIND != 1 && qrow0 - (k0 + 31) >= DFAR) ? (TBL_N - 28) : (myq - k0 - 4 * hf + TBL_OFF - 27));     \
                _Pragma("unroll") for (int i = 0; i < 16; ++i) Sx[i] = __builtin_amdgcn_exp2f(Sx[i]) * tp_[27 - ((i & 3) + 8 * (i >> 2))]; \
            } \
            if (KIND == 0 && !DBG_NOMASK) { const int mm = (int)((mword) >> (4 * hf)); \
                _Pragma("unroll") for (int i = 0; i < 16; ++i) { const float pv_ = Sx[i]; Sx[i] = and_mask_f(pv_, __builtin_amdgcn_sbfe(mm, (i & 3) + 8 * (i >> 2), 1)); } } \
            _Pragma("unroll") for (int i = 0; i < 16; ++i) lsum += Sx[i]; \
            bf16x8 pb[2]; \
            _Pragma("unroll") for (int s2 = 0; s2 < 2; ++s2) { v4u pw; pw.x = cvtpk_s(Sx[8 * s2], Sx[8 * s2 + 1]); pw.y = cvtpk_s(Sx[8 * s2 + 2], Sx[8 * s2 + 3]); \
                pw.z = cvtpk_s(Sx[8 * s2 + 4], Sx[8 * s2 + 5]); pw.w = cvtpk_s(Sx[8 * s2 + 6], Sx[8 * s2 + 7]); pb[s2] = __builtin_bit_cast(bf16x8, pw); } \
            _Pragma("unroll") for (int b = 0; b < 4; ++b) \
                _Pragma("unroll") for (int s2 = 0; s2 < 2; ++s2) { \
                    const s16x4 lo = vtr((Vimg) + vbase0 + 2048 * (2 * s2) + 512 * b), hi = vtr((Vimg) + vbase1 + 2048 * (2 * s2 + 1) + 512 * b); \
                    const bf16x8 vf = __builtin_shufflevector(lo, hi, 0, 1, 2, 3, 4, 5, 6, 7); \
                    O[b] = __builtin_amdgcn_mfma_f32_32x32x16_bf16(vf, pb[s2], O[b], 0, 0, 0); } \
        } } while (0)


#define AT_TV(tv, k0) float tv[16]; if (!FARV) { const LAS float* tp__##tv = tblL + ((KIND != 1 && qrow0 - ((k0) + 31) >= DFAR) ? (TBL_N - 28) : (myq - (k0) - 4 * hf + TBL_OFF - 27)); \
        _Pragma("unroll") for (int i = 0; i < 16; ++i) tv[i] = tp__##tv[27 - ((i & 3) + 8 * (i >> 2))]; } SBF();
#define AT_KLD(kf, Kimg) bf16x8 kf[NQS]; _Pragma("unroll") for (int s_ = 0; s_ < NQS; ++s_) kf[s_] = *(const LAS bf16x8*)((Kimg) + ((s_ & 1) ? kbase_o : kbase_e) + 512 * (s_ >> 1)); SBF();
#define AT_VLD(vf, Vimg) bf16x8 vf[8]; _Pragma("unroll") for (int j_ = 0; j_ < 4; ++j_) { const s16x4 lo_ = vtr((Vimg) + vbase0 + 2048 * (2 * (j_ & 1)) + 512 * (j_ >> 1)), hi_ = vtr((Vimg) + vbase1 + 2048 * (2 * (j_ & 1) + 1) + 512 * (j_ >> 1)); \
        vf[j_] = __builtin_shufflevector(lo_, hi_, 0, 1, 2, 3, 4, 5, 6, 7); } SBF();
#define AT_VLD2(vf, Vimg) _Pragma("unroll") for (int j_ = 4; j_ < 8; ++j_) { const s16x4 lo_ = vtr((Vimg) + vbase0 + 2048 * (2 * (j_ & 1)) + 512 * (j_ >> 1)), hi_ = vtr((Vimg) + vbase1 + 2048 * (2 * (j_ & 1) + 1) + 512 * (j_ >> 1)); \
        vf[j_] = __builtin_shufflevector(lo_, hi_, 0, 1, 2, 3, 4, 5, 6, 7); } SBF();
#ifdef ATT_PRIO
#define AT_P1 __builtin_amdgcn_s_setprio(1);
#define AT_P0 __builtin_amdgcn_s_setprio(0);
#else
#define AT_P1
#define AT_P0
#endif
#define AT_QKS(Sx, kf, s) { AT_P1 Sx = __builtin_amdgcn_mfma_f32_32x32x16_bf16(kf[s], qf[s], Sx, 0, 0, 0); AT_P0 }
#define AT_PVS(pb, vf, j) { AT_P1 O[(j) >> 1] = __builtin_amdgcn_mfma_f32_32x32x16_bf16(vf[j], pb[(j) & 1], O[(j) >> 1], 0, 0, 0); AT_P0 }
#define AT_SM2(Sx, tv, mm, i) { at_sm_el<KIND, (i), FARV>(Sx, tv, mm, lsum); at_sm_el<KIND, (i) + 1, FARV>(Sx, tv, mm, lsum); SBF(); }
#define AT_SM4(Sx, tv, mm, i) { AT_SM2(Sx, tv, mm, i) AT_SM2(Sx, tv, mm, (i) + 2) }
#define AT_SINIT(Sx) f32x16 Sx; _Pragma("unroll") for (int i = 0; i < 16; ++i) Sx[i] = FARV ? sinit_far : sinit;
#define AT_QK_ALONE(Sx, Kimg) { AT_KLD(kf_, Kimg) if (NQS == 8) { AT_QKS(Sx, kf_, 0) AT_QKS(Sx, kf_, 1) AT_QKS(Sx, kf_, 2) AT_QKS(Sx, kf_, 3) AT_QKS(Sx, kf_, NQS - 4) AT_QKS(Sx, kf_, NQS - 3) AT_QKS(Sx, kf_, NQS - 2) AT_QKS(Sx, kf_, NQS - 1) } \
        else { AT_QKS(Sx, kf_, 0) AT_QKS(Sx, kf_, 1) AT_QKS(Sx, kf_, 2) AT_QKS(Sx, kf_, 3) } }
#define AT_QK_SM(Sn, KimgN, Sp, tvp, mmp) { AT_KLD(kf_, KimgN) if (NQS == 8) { \
        AT_QKS(Sn, kf_, 0) AT_SM2(Sp, tvp, mmp, 0) AT_QKS(Sn, kf_, 1) AT_SM2(Sp, tvp, mmp, 2) AT_QKS(Sn, kf_, 2) AT_SM2(Sp, tvp, mmp, 4) AT_QKS(Sn, kf_, 3) AT_SM2(Sp, tvp, mmp, 6) \
        AT_QKS(Sn, kf_, NQS - 4) AT_SM2(Sp, tvp, mmp, 8) AT_QKS(Sn, kf_, NQS - 3) AT_SM2(Sp, tvp, mmp, 10) AT_QKS(Sn, kf_, NQS - 2) AT_SM2(Sp, tvp, mmp, 12) AT_QKS(Sn, kf_, NQS - 1) AT_SM2(Sp, tvp, mmp, 14) } \
        else { AT_QKS(Sn, kf_, 0) AT_SM4(Sp, tvp, mmp, 0) AT_QKS(Sn, kf_, 1) AT_SM4(Sp, tvp, mmp, 4) AT_QKS(Sn, kf_, 2) AT_SM4(Sp, tvp, mmp, 8) AT_QKS(Sn, kf_, 3) AT_SM4(Sp, tvp, mmp, 12) } }
#define AT_PV_ALONE(pb, Vimg) { AT_VLD(vf_, Vimg) AT_PVS(pb, vf_, 0) AT_PVS(pb, vf_, 1) AT_VLD2(vf_, Vimg) AT_PVS(pb, vf_, 2) AT_PVS(pb, vf_, 3) AT_PVS(pb, vf_, 4) AT_PVS(pb, vf_, 5) AT_PVS(pb, vf_, 6) AT_PVS(pb, vf_, 7) }
#define AT_PV_SM(pb, Vimg, Sn, tvn, mmn) { AT_VLD(vf_, Vimg) AT_PVS(pb, vf_, 0) AT_SM2(Sn, tvn, mmn, 0) AT_PVS(pb, vf_, 1) AT_VLD2(vf_, Vimg) AT_SM2(Sn, tvn, mmn, 2) AT_PVS(pb, vf_, 2) AT_SM2(Sn, tvn, mmn, 4) AT_PVS(pb, vf_, 3) AT_SM2(Sn, tvn, mmn, 6) \
        AT_PVS(pb, vf_, 4) AT_SM2(Sn, tvn, mmn, 8) AT_PVS(pb, vf_, 5) AT_SM2(Sn, tvn, mmn, 10) AT_PVS(pb, vf_, 6) AT_SM2(Sn, tvn, mmn, 12) AT_PVS(pb, vf_, 7) AT_SM2(Sn, tvn, mmn, 14) }

    for (int ss = 0; ss < nss; ++ss) {
        const int b = ss & 1; const bool more = (ss + 1 < nss);
#if ATT_STAGGER
        if (w < 4) __builtin_amdgcn_s_sleep(ATT_STAGGER);
#endif
#if ATT_L2_TOUCH
        unsigned touch_ = 0u;
        if (ss + 2 < nss) { const bf16* tb2_ = P + (size_t)(kbeg + 128 * (ss + 2)) * PITCH;
            int tt_ = F.tid; asm volatile("" : "+v"(tt_));
            const unsigned touch_off = (unsigned)((((tt_ >> 1) & 127) * PITCH + ((tt_ >> 8) ? colV : colK) + 64 * (tt_ & 1)) * 2);
            asm volatile("global_load_dword %0, %1, %2" : "=v"(touch_) : "v"(touch_off), "s"(tb2_) : "memory"); }
#endif
        if (more) { AT_ISSUE(ss + 1, b ^ 1);
#ifdef DBG_DOUBLE_DMA
            AT_ISSUE(ss + 1, b ^ 1);
#endif
            if (KIND == 0) { if (WIDE) mwn = *(const GAS v4u*)(WM + (size_t)myq * 256 + 4 * (ss + 1)); else { const v2u t_ = *(const GAS v2u*)(WM + (size_t)myq * 256 + (4 * (ss + 1) + 2 * g)); mwn.x = t_.x; mwn.y = t_.y; } } }
        LAS unsigned char* base = ring + b * AT_BUF;
        const int kss = kbeg + 128 * ss;
#if ATT_PREF
#define AT_VLD8(vf, Vimg) bf16x8 vf[8]; _Pragma("unroll") for (int j_ = 0; j_ < 8; ++j_) { const s16x4 lo_ = vtr((Vimg) + vbase0 + 2048 * (2 * (j_ & 1)) + 512 * (j_ >> 1)), hi_ = vtr((Vimg) + vbase1 + 2048 * (2 * (j_ & 1) + 1) + 512 * (j_ >> 1)); \
        vf[j_] = __builtin_shufflevector(lo_, hi_, 0, 1, 2, 3, 4, 5, 6, 7); } SBF();
#define AT_QKC(Sx, kf) { if (NQS == 8) { AT_QKS(Sx, kf, 0) AT_QKS(Sx, kf, 1) AT_QKS(Sx, kf, 2) AT_QKS(Sx, kf, 3) AT_QKS(Sx, kf, NQS - 4) AT_QKS(Sx, kf, NQS - 3) AT_QKS(Sx, kf, NQS - 2) AT_QKS(Sx, kf, NQS - 1) } \
        else { AT_QKS(Sx, kf, 0) AT_QKS(Sx, kf, 1) AT_QKS(Sx, kf, 2) AT_QKS(Sx, kf, 3) } SBF(); }
#define AT_QKC_SM(Sn, kf, Sp, tvp, mmp) { if (NQS == 8) { \
        AT_QKS(Sn, kf, 0) AT_SM2(Sp, tvp, mmp, 0) AT_QKS(Sn, kf, 1) AT_SM2(Sp, tvp, mmp, 2) AT_QKS(Sn, kf, 2) AT_SM2(Sp, tvp, mmp, 4) AT_QKS(Sn, kf, 3) AT_SM2(Sp, tvp, mmp, 6) \
        AT_QKS(Sn, kf, NQS - 4) AT_SM2(Sp, tvp, mmp, 8) AT_QKS(Sn, kf, NQS - 3) AT_SM2(Sp, tvp, mmp, 10) AT_QKS(Sn, kf, NQS - 2) AT_SM2(Sp, tvp, mmp, 12) AT_QKS(Sn, kf, NQS - 1) AT_SM2(Sp, tvp, mmp, 14) } \
        else { AT_QKS(Sn, kf, 0) AT_SM4(Sp, tvp, mmp, 0) AT_QKS(Sn, kf, 1) AT_SM4(Sp, tvp, mmp, 4) AT_QKS(Sn, kf, 2) AT_SM4(Sp, tvp, mmp, 8) AT_QKS(Sn, kf, 3) AT_SM4(Sp, tvp, mmp, 12) } }
#define AT_PVC(pb, vf) { AT_PVS(pb, vf, 0) AT_PVS(pb, vf, 1) AT_PVS(pb, vf, 2) AT_PVS(pb, vf, 3) AT_PVS(pb, vf, 4) AT_PVS(pb, vf, 5) AT_PVS(pb, vf, 6) AT_PVS(pb, vf, 7) SBF(); }
#define AT_PVC_SM(pb, vf, Sn, tvn, mmn) { AT_PVS(pb, vf, 0) AT_SM2(Sn, tvn, mmn, 0) AT_PVS(pb, vf, 1) AT_SM2(Sn, tvn, mmn, 2) AT_PVS(pb, vf, 2) AT_SM2(Sn, tvn, mmn, 4) AT_PVS(pb, vf, 3) AT_SM2(Sn, tvn, mmn, 6) \
        AT_PVS(pb, vf, 4) AT_SM2(Sn, tvn, mmn, 8) AT_PVS(pb, vf, 5) AT_SM2(Sn, tvn, mmn, 10) AT_PVS(pb, vf, 6) AT_SM2(Sn, tvn, mmn, 12) AT_PVS(pb, vf, 7) AT_SM2(Sn, tvn, mmn, 14) }
#define AT_KLD_IF(c, kf, Kimg) bf16x8 kf[NQS]; if (c) { _Pragma("unroll") for (int s_ = 0; s_ < NQS; ++s_) kf[s_] = *(const LAS bf16x8*)((Kimg) + ((s_ & 1) ? kbase_o : kbase_e) + 512 * (s_ >> 1)); } SBF();
#define AT_KLD_IF2(c, kf, Kimg) if (c) { _Pragma("unroll") for (int s_ = 0; s_ < NQS; ++s_) kf[s_] = *(const LAS bf16x8*)((Kimg) + ((s_ & 1) ? kbase_o : kbase_e) + 512 * (s_ >> 1)); } SBF();
#define AT_VLDR(c, vf, Vimg, j0, j1) if (c) { _Pragma("unroll") for (int j_ = (j0); j_ < (j1); ++j_) { const s16x4 lo_ = vtr((Vimg) + vbase0 + 2048 * (2 * (j_ & 1)) + 512 * (j_ >> 1)), hi_ = vtr((Vimg) + vbase1 + 2048 * (2 * (j_ & 1) + 1) + 512 * (j_ >> 1)); \
        vf[j_] = __builtin_shufflevector(lo_, hi_, 0, 1, 2, 3, 4, 5, 6, 7); } } SBF();
#define AT_FUSED2N(Ka, Va, Kb, Vb, k0a, k0b, mma, mmb, FAR_) do { \
            constexpr bool FARV = (FAR_); constexpr bool PKB = (KIND == 2) || PREF_KB, PVA = (KIND == 2) || PREF_VA, PVB = (KIND == 2) || PREF_VB; \
            AT_SINIT(S0) \
            AT_KLD(kfa_, Ka) AT_KLD_IF(PKB, kfb_, Kb) \
            AT_TV(tv0, k0a) \
            AT_QKC(S0, kfa_) \
            AT_SINIT(S1) \
            AT_KLD_IF2(!PKB, kfb_, Kb) \
            bf16x8 vfa_[8], vfb_[8]; \
            AT_VLDR(PVA, vfa_, Va, 0, 4) \
            AT_QKC_SM(S1, kfb_, S0, tv0, mma) \
            bf16x8 pb[2]; at_pack(S0, pb); \
            AT_TV(tv1, k0b) \
            AT_VLDR(!PVA, vfa_, Va, 0, 4) \
            AT_VLDR(true, vfa_, Va, 4, 8) \
            AT_VLDR(PVB, vfb_, Vb, 0, 8) \
            AT_PVC_SM(pb, vfa_, S1, tv1, mmb) \
            at_pack(S1, pb); \
            AT_VLDR(!PVB, vfb_, Vb, 0, 8) \
            AT_PVC(pb, vfb_) } while (0)
#endif
#if ATT_SGB
#define SGB_QKA SGB(0x008, 1) SGB(0x100, 1)
#define SGB_QKB(TR, VA) SGB(0x008, 1) SGB(0x400, TR) SGB(0x002, VA) SGB(0x100, 2)
#define SGB_PVA(VA) SGB(0x008, 1) SGB(0x400, 2) SGB(0x002, VA) SGB(0x100, 2)
#define AT_PIPE() { constexpr int VE = FARV ? (KIND == 0 ? 3 : 1) : (KIND == 0 ? 4 : 2);     \
        SGB(0x100, NQS + 8) \
        if (NQS == 8) { SGB_QKA SGB_QKA SGB_QKA SGB_QKA SGB_QKA SGB_QKA SGB_QKA SGB_QKA \
            SGB_QKB(2, 2 * VE) SGB_QKB(2, 2 * VE) SGB_QKB(2, 2 * VE) SGB_QKB(2, 2 * VE) SGB_QKB(2, 2 * VE) SGB_QKB(2, 2 * VE) SGB_QKB(2, 2 * VE) SGB_QKB(2, 2 * VE) } \
        else { SGB_QKA SGB_QKA SGB_QKA SGB_QKA SGB_QKB(4, 4 * VE) SGB_QKB(4, 4 * VE) SGB_QKB(4, 4 * VE) SGB_QKB(4, 4 * VE) } \
        SGB(0x002, 8) \
        SGB_PVA(2 * VE) SGB_PVA(2 * VE) SGB_PVA(2 * VE) SGB_PVA(2 * VE) SGB_PVA(2 * VE) SGB_PVA(2 * VE) SGB_PVA(2 * VE) SGB_PVA(2 * VE) \
        SGB(0x002, 8) \
        SGB(0x008, 8) }
#else
#define AT_PIPE() { }
#endif
#if ATT_SEG
#define AT_HQK(Sx, kf) { if (NQS == 8) { AT_QKS(Sx, kf, 0) AT_QKS(Sx, kf, 1) AT_QKS(Sx, kf, 2) AT_QKS(Sx, kf, 3) AT_QKS(Sx, kf, 4) AT_QKS(Sx, kf, 5) AT_QKS(Sx, kf, 6) AT_QKS(Sx, kf, 7) } \
        else { AT_QKS(Sx, kf, 0) AT_QKS(Sx, kf, 1) AT_QKS(Sx, kf, 2) AT_QKS(Sx, kf, 3) } }
#define AT_HSM(Sx, tv, mm) { AT_SM4(Sx, tv, mm, 0) AT_SM4(Sx, tv, mm, 4) AT_SM4(Sx, tv, mm, 8) AT_SM4(Sx, tv, mm, 12) }
#define AT_HPV(pb, vf) { AT_PVS(pb, vf, 0) AT_PVS(pb, vf, 1) AT_PVS(pb, vf, 2) AT_PVS(pb, vf, 3) AT_PVS(pb, vf, 4) AT_PVS(pb, vf, 5) AT_PVS(pb, vf, 6) AT_PVS(pb, vf, 7) }
#define AT_HVLD(vf, Vimg) bf16x8 vf[8]; _Pragma("unroll") for (int j_ = 0; j_ < 8; ++j_) { const s16x4 lo_ = vtr((Vimg) + vbase0 + 2048 * (2 * (j_ & 1)) + 512 * (j_ >> 1)), hi_ = vtr((Vimg) + vbase1 + 2048 * (2 * (j_ & 1) + 1) + 512 * (j_ >> 1)); \
        vf[j_] = __builtin_shufflevector(lo_, hi_, 0, 1, 2, 3, 4, 5, 6, 7); }
#define AT_FUSED2H(Ka, Va, Kb, Vb, k0a, k0b, mma, mmb, FAR_) do { \
            constexpr bool FARV = (FAR_); \
            AT_SINIT(S0) AT_SINIT(S1) \
            { AT_KLD(kfa_, Ka) AT_HQK(S0, kfa_) } \
            { AT_KLD(kfb_, Kb) AT_HQK(S1, kfb_) } \
            AT_TV(tv0, k0a) AT_TV(tv1, k0b) \
            { const float last_ = S1[15]; asm volatile("" : "+v"(S0) : "v"(last_)); }                      \
            AT_HSM(S0, tv0, mma) AT_HSM(S1, tv1, mmb) \
            bf16x8 pba[2], pbb[2]; at_pack(S0, pba); at_pack(S1, pbb); \
            asm volatile("" : "+v"(pba[0]), "+v"(pba[1]) : "v"(pbb[1]));                                  \
            { AT_HVLD(vfa_, Va) AT_HPV(pba, vfa_) } \
            { AT_HVLD(vfb_, Vb) AT_HPV(pbb, vfb_) } } while (0)
#endif
#define AT_FUSED2O(Ka, Va, Kb, Vb, k0a, k0b, mma, mmb, FAR_) do {     \
            constexpr bool FARV = (FAR_); \
            AT_SINIT(S0) AT_SINIT(S1) \
            AT_QK_ALONE(S0, Ka) \
            { AT_TV(tv0, k0a) \
              AT_QK_SM(S1, Kb, S0, tv0, mma) } \
            bf16x8 pb[2]; at_pack(S0, pb); \
            { AT_TV(tv1, k0b) \
              AT_PV_SM(pb, Va, S1, tv1, mmb) } \
            at_pack(S1, pb); \
            AT_PV_ALONE(pb, Vb) \
            AT_PIPE() } while (0)
#if ATT_SEG
#define AT_FUSED2(Ka, Va, Kb, Vb, k0a, k0b, mma, mmb, FAR_) do { if ((ATT_SEG >> KIND) & 1) AT_FUSED2H(Ka, Va, Kb, Vb, k0a, k0b, mma, mmb, FAR_); else AT_FUSED2O(Ka, Va, Kb, Vb, k0a, k0b, mma, mmb, FAR_); } while (0)
#elif ATT_PREF
#define AT_FUSED2(Ka, Va, Kb, Vb, k0a, k0b, mma, mmb, FAR_) do { if (KIND == 2 || PREF_AB) AT_FUSED2N(Ka, Va, Kb, Vb, k0a, k0b, mma, mmb, FAR_); else AT_FUSED2O(Ka, Va, Kb, Vb, k0a, k0b, mma, mmb, FAR_); } while (0)
#else
#define AT_FUSED2(Ka, Va, Kb, Vb, k0a, k0b, mma, mmb, FAR_) AT_FUSED2O(Ka, Va, Kb, Vb, k0a, k0b, mma, mmb, FAR_)
#endif
        if (WIDE) {
#pragma unroll 1
            for (int sl = 0; sl < 2; ++sl) {
                const int k0a = kss + 64 * sl, k0b = k0a + 32;
                LAS unsigned char* Ka = base + sl * AT_SLOT; LAS unsigned char* Va = Ka + 16384; LAS unsigned char* Kb = Ka + 8192; LAS unsigned char* Vb = Va + 8192;
                const unsigned mwa = sl ? mw.z : mw.x, mwb = sl ? mw.w : mw.y;
                if (FARSPEC && KIND == 0 && qrow0 - (k0b + 31) >= DFAR) {
                    const int mma = (int)(mwa >> (4 * hf)), mmb = (int)(mwb >> (4 * hf));
                    AT_FUSED2(Ka, Va, Kb, Vb, k0a, k0b, mma, mmb, true);
                } else if (k0b <= qrow0 + 31 && !(KIND == 1 && qrow0 - (k0a + 31) > 2048)) {
                    const int mma = (int)(mwa >> (4 * hf)), mmb = (int)(mwb >> (4 * hf));
                    AT_FUSED2(Ka, Va, Kb, Vb, k0a, k0b, mma, mmb, false);
                } else {
                    AT_BLOCK(Ka, Va, k0a, mwa);
                    AT_BLOCK(Kb, Vb, k0b, mwb);
                }
            }
        } else if (KIND != 2) {
            const int k0a = kss + 64 * g, k0b = k0a + 32;
            LAS unsigned char* Ka = base + g * AT_SLOT; LAS unsigned char* Va = Ka + 16384; LAS unsigned char* Kb = Ka + 8192; LAS unsigned char* Vb = Va + 8192;
            if (FARSPEC && KIND == 0 && qrow0 - (k0b + 31) >= DFAR) {
                const int mma = (int)(mw.x >> (4 * hf)), mmb = (int)(mw.y >> (4 * hf));
                AT_FUSED2(Ka, Va, Kb, Vb, k0a, k0b, mma, mmb, true);
            } else if (k0b <= qrow0 + 31 && !(KIND == 1 && qrow0 - (k0a + 31) > 2048)) {
                const int mma = (int)(mw.x >> (4 * hf)), mmb = (int)(mw.y >> (4 * hf));
                AT_FUSED2(Ka, Va, Kb, Vb, k0a, k0b, mma, mmb, false);
            } else {
                AT_BLOCK(Ka, Va, k0a, mw.x);
                AT_BLOCK(Kb, Vb, k0b, mw.y);
            }
        } else {
#pragma unroll 1
            for (int sl = 0; sl < 2; ++sl) {
                const int k0a = kss + 64 * sl, k0b = k0a + 32;
                LAS unsigned char* Ka = base + sl * AT_SLOT; LAS unsigned char* Va = Ka + 16384; LAS unsigned char* Kb = Ka + 8192; LAS unsigned char* Vb = Va + 8192;
                if (FARSPEC && qrow0 - (k0b + 31) >= DFAR) { AT_FUSED2(Ka, Va, Kb, Vb, k0a, k0b, 0, 0, true); }
                else if (k0b <= qrow0 + 31) { AT_FUSED2(Ka, Va, Kb, Vb, k0a, k0b, 0, 0, false); }
                else { AT_BLOCK(Ka, Va, k0a, 0u); AT_BLOCK(Kb, Vb, k0b, 0u); }
            }
        }
#undef AT_FUSED2
#undef AT_FUSED2O
#if ATT_SEG
#undef AT_FUSED2H
#undef AT_HQK
#undef AT_HSM
#undef AT_HPV
#undef AT_HVLD
#endif
#undef AT_PIPE
#if ATT_PREF
#undef AT_FUSED2N
#endif
#if ATT_PREF
#undef AT_VLD8
#undef AT_KLD_IF
#undef AT_KLD_IF2
#undef AT_VLDR
#undef AT_QKC
#undef AT_QKC_SM
#undef AT_PVC
#undef AT_PVC_SM
#endif
        if (more) mw = mwn;
#ifdef PROBE_ATTBAR
        unsigned long long tb0_ = 0; if (tid == 0) tb0_ = __builtin_readcyclecounter();
#endif
        __syncthreads();
#ifdef PROBE_ATTBAR
        if (tid == 0) { const unsigned long long d_ = __builtin_readcyclecounter() - tb0_; F.MISC[28] += (unsigned)(d_ >> 4); }
#endif
#if ATT_L2_TOUCH
        asm volatile("" :: "v"(touch_));
#endif
    }
#undef AT_BLOCK
#undef AT_TV
#undef AT_KLD
#undef AT_VLD
#undef AT_VLD2
#undef AT_QKS
#undef AT_PVS
#undef AT_SM2
#undef AT_SM4
#undef AT_SINIT
#undef AT_QK_ALONE
#undef AT_QK_SM
#undef AT_PV_ALONE
#undef AT_PV_SM
#undef AT_ISSUE
    LAS float* stg = (LAS float*)ring;
    float ltot = lsum + __shfl_xor(lsum, 32);
    if (!WIDE && g == 1) {
        const float sc = (KIND == 2) ? 1.0f / ltot : 1.0f;
#pragma unroll
        for (int b = 0; b < 4; ++b)
#pragma unroll
            for (int i = 0; i < 16; ++i) stg[((wq * 64) + (b * 16 + i)) * 64 + lane] = O[b][i] * sc;
        stg[16384 + wq * 64 + lane] = ltot;
    }
    __syncthreads();
    if (g == 0) {
        bf16* MIX = (bf16*)(F.ws + WS_MIX);
        if (WIDE) {
            const float inv = 1.0f / ltot;
#pragma unroll
            for (int b = 0; b < 4; ++b) {
#pragma unroll
                for (int i = 0; i < 16; ++i) O[b][i] *= inv;
                SBAR(); }
        } else if (KIND != 2) {
            ltot += stg[16384 + wq * 64 + lane];
            const float inv = 1.0f / ltot;
#pragma unroll
            for (int b = 0; b < 4; ++b) {
#pragma unroll
                for (int i = 0; i < 16; ++i) O[b][i] = (O[b][i] + stg[((wq * 64) + (b * 16 + i)) * 64 + lane]) * inv;
                SBAR(); }
        } else {
            const float inv = 1.0f / ltot; float ss2 = 0.f;
#pragma unroll
            for (int b = 0; b < 4; ++b) {
#pragma unroll
                for (int i = 0; i < 16; ++i) { const float o = O[b][i] * inv - sh.lam * stg[((wq * 64) + (b * 16 + i)) * 64 + lane]; O[b][i] = o; ss2 += o * o; }
                SBAR(); }
            ss2 += __shfl_xor(ss2, 32);
            const float rstd = sh.post / sqrtf(ss2 * (1.0f / 128.0f) + RMS_EPS);
            const float* gsub = F.a->in[15] + layer * 128;
#pragma unroll
            for (int b = 0; b < 4; ++b) {
#pragma unroll
                for (int i4 = 0; i4 < 4; ++i4) { const f32x4 gv = *(const GAS f32x4*)(gsub + 32 * b + 8 * i4 + 4 * hf);
                    O[b][4 * i4] *= rstd * gv.x; O[b][4 * i4 + 1] *= rstd * gv.y; O[b][4 * i4 + 2] *= rstd * gv.z; O[b][4 * i4 + 3] *= rstd * gv.w; }
                SBAR(); }
        }
#ifdef DBG_ZERO_KIND
        if (KIND == DBG_ZERO_KIND) {
#pragma unroll
            for (int b = 0; b < 4; ++b)
#pragma unroll
                for (int i = 0; i < 16; ++i) O[b][i] = 0.f; }
#endif
#if OUTPROJ_INT8
        unsigned char* orow8 = (unsigned char*)MIX + (size_t)myq * D + outc + 4 * hf;
        constexpr float QS = 127.0f / MIX_CLIP;
#pragma unroll
        for (int b = 0; b < 4; ++b)
#pragma unroll
            for (int i4 = 0; i4 < 4; ++i4) *(GAS unsigned*)(orow8 + 32 * b + 8 * i4) = pk4_i8(O[b][4 * i4] * QS, O[b][4 * i4 + 1] * QS, O[b][4 * i4 + 2] * QS, O[b][4 * i4 + 3] * QS);
#else
        bf16* orow = MIX + (size_t)myq * D + outc + 4 * hf;
#pragma unroll
        for (int b = 0; b < 4; ++b)
#pragma unroll
            for (int i4 = 0; i4 < 4; ++i4) { v2u o; o.x = cvtpk_s(O[b][4 * i4], O[b][4 * i4 + 1]); o.y = cvtpk_s(O[b][4 * i4 + 2], O[b][4 * i4 + 3]); *(GAS v2u*)(orow + 32 * b + 8 * i4) = o; }
#endif
    }
    __syncthreads();
}

DI void attn_setup(Frame& F, int layer, AttnShared& sh) {
    if (F.wave == 0) {
        const int lane = F.lane;
        float ga = fmaxf(fabsf(F.a->in[5][layer * 128 + lane]), fabsf(F.a->in[5][layer * 128 + 64 + lane])), gb = fmaxf(fabsf(F.a->in[6][layer * 128 + lane]), fabsf(F.a->in[6][layer * 128 + 64 + lane]));
        float gc = fmaxf(fabsf(F.a->in[7][layer * 128 + lane]), fabsf(F.a->in[7][layer * 128 + 64 + lane])), gd = fmaxf(fabsf(F.a->in[8][layer * 128 + lane]), fabsf(F.a->in[8][layer * 128 + 64 + lane]));
        float ge = fabsf(F.a->in[9][layer * 64 + lane]), gf = fabsf(F.a->in[10][layer * 64 + lane]);
        float l1 = F.a->in[11][layer * 64 + lane] * F.a->in[12][layer * 64 + lane], l2 = F.a->in[13][layer * 64 + lane] * F.a->in[14][layer * 64 + lane];
#pragma unroll
        for (int o = 1; o < 64; o <<= 1) { ga = fmaxf(ga, __shfl_xor(ga, o)); gb = fmaxf(gb, __shfl_xor(gb, o)); gc = fmaxf(gc, __shfl_xor(gc, o)); gd = fmaxf(gd, __shfl_xor(gd, o));
            ge = fmaxf(ge, __shfl_xor(ge, o)); gf = fmaxf(gf, __shfl_xor(gf, o)); l1 += __shfl_xor(l1, o); l2 += __shfl_xor(l2, o); }
        if (lane == 0) {
            const float lam_init = 0.8f - 0.6f * expf(-0.3f * (float)layer);
            volatile LAS float* mf = (volatile LAS float*)(F.MISC + 16);
            mf[0] = 1.02f * 11.313708499f * LOG2E * ga * gb + 0.5f;
            mf[1] = 1.02f * 11.313708499f * LOG2E * gc * gd + 0.5f;
            mf[2] = 1.02f * 8.0f * LOG2E * ge * gf + 0.5f;
            mf[3] = expf(l1) - expf(l2) + lam_init;
            mf[4] = 1.0f - lam_init;
        }
    }
    __syncthreads();
}
template <int KIND, int NHEAD>
DI void attn_queue(Frame& F, int layer, int head_fixed, int qslot) {
    AttnShared sh;
    { volatile LAS float* mf = (volatile LAS float*)(F.MISC + 16); sh.m2[0] = mf[0]; sh.m2[1] = mf[1]; sh.m2[2] = mf[2]; sh.lam = mf[3]; sh.post = mf[4]; }
    constexpr int QPH = ((KIND != 2) && ATT_WIDE) ? 32 : 64;
    const int nunits = head_fixed < 0 ? QPH * NHEAD : QPH;
    for (;;) {
        if (F.tid == 0) { unsigned char* wsp_ = F.ws; asm volatile("" : "+s"(wsp_));
            F.MISC[0] = __hip_atomic_fetch_add((unsigned*)(wsp_ + WS_CTL) + CW_Q + 64 * qslot, 1u, RLX_AGENT); }
        __syncthreads();
        const int u = (int)F.MISC[0];
        __syncthreads();
        if (u >= nunits) break;
        const bool qbmajor = ATT_QBMAJOR && KIND != 1 && head_fixed < 0;
        const int hd = head_fixed >= 0 ? head_fixed : (qbmajor ? (u % NHEAD) : (u / QPH)), qb = QPH - 1 - (qbmajor ? (u / NHEAD) : (u % QPH));
        attn_unit<KIND>(F, layer, hd, qb, sh);
    }
}
#ifndef BG_DIV
#define BG_DIV 5
#endif
DI void attn_phase(Frame& F, int layer) {
    if (F.vcu % BG_DIV == 0) bg_convert(F, layer ? BG_I1 : 0, layer ? BG_A1 : BG_A0, F.vcu / BG_DIV, (F.G + BG_DIV - 1) / BG_DIV);
    AttnShared sh; attn_setup(F, layer, sh);
#ifdef PROBE_ATT
#define PA0(k) do { if ((k) == PROBE_ATT && layer == 0) { __syncthreads(); if (F.tid == 0) { const unsigned long long t_ = __builtin_amdgcn_s_memrealtime(); F.MISC[24] = (unsigned)t_; F.MISC[25] = (unsigned)(t_ >> 32); } } } while (0)
#define PA1(k) do { if ((k) == PROBE_ATT && layer == 0) { __syncthreads(); if (F.tid == 0) { const unsigned long long t_ = __builtin_amdgcn_s_memrealtime() - (((unsigned long long)F.MISC[25] << 32) | F.MISC[24]); F.MISC[26] = (unsigned)t_; F.MISC[27] = (unsigned)(t_ >> 32); } } } while (0)
#else
#define PA0(k) do { } while (0)
#define PA1(k) do { } while (0)
#endif
#ifndef ATT_KINDS
#define ATT_KINDS 7
#endif
    const int qs = 16 * layer;
#if ATT_WIDE
    PA0(1); if (ATT_KINDS & 1) attn_queue<0, 4>(F, layer, -1, qs + 11); PA1(1);
    PA0(0); if (ATT_KINDS & 4) attn_queue<2, 6>(F, layer, -1, qs + 10); PA1(0);
#else
    PA0(0); if (ATT_KINDS & 4) attn_queue<2, 6>(F, layer, -1, qs + 10); PA1(0);
    PA0(1); if (ATT_KINDS & 1) attn_queue<0, 4>(F, layer, -1, qs + 11); PA1(1);
#endif
    PA0(2); if (ATT_KINDS & 2) attn_queue<1, 6>(F, layer, -1, qs + 12); PA1(2);
}
#ifdef DBG_CHECKS
constexpr size_t WS_DBG = WS_CTL + 512 * 1024;
__global__ void dbg_check_indexer(unsigned char* ws) {
    const int t = blockIdx.x * 4 + (threadIdx.x >> 6), lane = threadIdx.x & 63;
    const float* SC = (const float*)(ws + WS_SC); const unsigned* WM = (const unsigned*)(ws + WS_WM); const bf16* P = (const bf16*)(ws + WS_P);
    unsigned* flags = (unsigned*)(ws + WS_DBG);
    int pc = 0; float mins = 3.0e38f, maxu = -3.0e38f; int above = 0;
    for (int s = lane; s < S; s += 64) {
        const unsigned w = WM[(size_t)t * 256 + (s >> 5)]; const int bit = (w >> (s & 31)) & 1;
        if (s <= t) { const float v = SC[(size_t)t * S + s]; if (bit) { pc++; mins = fminf(mins, v); } else maxu = fmaxf(maxu, v); }
        else if (bit && s < ((t >> 11) + 1) * 2048) above++;
    }
    for (int o = 1; o < 64; o <<= 1) { pc += __shfl_xor(pc, o); above += __shfl_xor(above, o); mins = fminf(mins, __shfl_xor(mins, o)); maxu = fmaxf(maxu, __shfl_xor(maxu, o)); }
    if (lane == 0) {
        const int want = (t + 1 < 256) ? t + 1 : 256;
        if (pc != want) atomicAdd(&flags[0], 1u);
        if (above) atomicAdd(&flags[2], 1u);
        if (mins < maxu) atomicAdd(&flags[3], 1u);
        if (t > 1000 && pc == 256 && mins <= maxu + 1e-12f) atomicAdd(&flags[4], 1u);
    }
    { const int s = (lane * 131 + t * 7) % (t + 1);
      float sc = 0.f;
      for (int h = 0; h < 16; ++h) { float d = 0.f;
          for (int k = 0; k < 64; ++k) d += __builtin_bit_cast(float, (unsigned)P[(size_t)t * PITCH + C_QI + h * 64 + k] << 16) * __builtin_bit_cast(float, (unsigned)P[(size_t)s * PITCH + C_KI + k] << 16);
          sc += __builtin_bit_cast(float, (unsigned)P[(size_t)t * PITCH + C_WI + h] << 16) * 0.03125f * fmaxf(d, 0.f); }
      const float got = SC[(size_t)t * S + s];
      if (fabsf(got - sc) > 1e-3f * (fabsf(sc) + 0.05f)) atomicAdd(&flags[1], 1u); }
}
__global__ void dbg_check_attnA(unsigned char* ws) {
    const int lane = threadIdx.x & 63, wv = blockIdx.x * 4 + (threadIdx.x >> 6);
    const int head = wv & 3, t = 100 + (wv >> 2) * 127;
    const bf16* P = (const bf16*)(ws + WS_P); const unsigned* WM = (const unsigned*)(ws + WS_WM); const float* TBL = (const float*)(ws + WS_TBL); const bf16* MIX = (const bf16*)(ws + WS_MIX);
    unsigned* flags = (unsigned*)(ws + WS_DBG);
    if (wv == 0 && lane == 0) atomicAdd(&flags[5], 1u);
    const float q0 = __builtin_bit_cast(float, (unsigned)P[(size_t)t * PITCH + C_QA + head * 128 + lane] << 16), q1 = __builtin_bit_cast(float, (unsigned)P[(size_t)t * PITCH + C_QA + head * 128 + 64 + lane] << 16);
    float l = 0.f, o0 = 0.f, o1 = 0.f;
    for (int s = 0; s <= t; ++s) {
        const unsigned w = WM[(size_t)t * 256 + (s >> 5)]; if (!((w >> (s & 31)) & 1)) continue;
        float d = q0 * __builtin_bit_cast(float, (unsigned)P[(size_t)s * PITCH + C_KA + head * 128 + lane] << 16) + q1 * __builtin_bit_cast(float, (unsigned)P[(size_t)s * PITCH + C_KA + head * 128 + 64 + lane] << 16);
        for (int o = 1; o < 64; o <<= 1) d += __shfl_xor(d, o);
        const float p = exp2f(d - 16.0f) * TBL[head * TBL_N + ((t - s) < 2239 ? (t - s) : 2239) + TBL_OFF];
        l += p; o0 += p * __builtin_bit_cast(float, (unsigned)P[(size_t)s * PITCH + C_VA + head * 128 + lane] << 16); o1 += p * __builtin_bit_cast(float, (unsigned)P[(size_t)s * PITCH + C_VA + head * 128 + 64 + lane] << 16);
    }
    o0 /= l; o1 /= l;
    const float g0 = __builtin_bit_cast(float, (unsigned)MIX[(size_t)t * D + head * 128 + lane] << 16), g1 = __builtin_bit_cast(float, (unsigned)MIX[(size_t)t * D + head * 128 + 64 + lane] << 16);
    float e2 = (g0 - o0) * (g0 - o0) + (g1 - o1) * (g1 - o1), n2 = o0 * o0 + o1 * o1;
    for (int o = 1; o < 64; o <<= 1) { e2 += __shfl_xor(e2, o); n2 += __shfl_xor(n2, o); }
    if (lane == 0 && e2 > 1e-3f * n2) atomicAdd(&flags[6], 1u);
    if (lane == 0 && e2 > 3e-2f * n2) atomicAdd(&flags[7], 1u);
}
__global__ void dbg_plant(unsigned char* ws, float* out) {
    const unsigned* flags = (const unsigned*)(ws + WS_DBG);
    if (threadIdx.x == 0) {
        if (flags[0]) out[0] += 1.0e6f;
        if (flags[1]) out[1] += 1.0e5f;
        if (flags[2]) out[2] += 1.0e4f;
        if (flags[3]) out[3] += 1.0e3f;
        if (flags[4] > 100) out[4] += 3.0e3f;
        if (flags[5] != 1) out[5] += 1.0e7f;
        if (flags[6] > 3) out[6] += 1.0e4f;
        if (flags[7] > 3) out[7] += 1.0e5f;
    }
}
#endif

#ifndef MK_PER_PHASE
#define MK_PER_PHASE 0
#endif
#ifndef PN_FUSED
#define PN_FUSED 1
#endif
#ifndef GEMM_SP2
#define GEMM_SP2 true
#endif
#ifndef GEMM_ALIGN
#define GEMM_ALIGN true
#endif
constexpr int NPH = 20;
#ifndef PH_MASK
#define PH_MASK 0xFFFFFu
#endif
#define IN(k) ((((PH_MASK) >> (k)) & 1u) && lo <= (k) && (k) < hi)
#define SEAM(k) do { if (IN(k) && IN((k) + 1)) xcd_barrier(bar); } while (0)
#if defined(PROBE_PH) || defined(PROBE_ATT)
#ifndef PROBE_MULT
#define PROBE_MULT 2
#endif
#ifndef PROBE_PH
#define PROBE_PH 99
#endif
#define PB0(k) do { if ((k) == PROBE_PH) { __syncthreads(); if (F.tid == 0) { const unsigned long long t_ = __builtin_amdgcn_s_memrealtime(); F.MISC[24] = (unsigned)t_; F.MISC[25] = (unsigned)(t_ >> 32); } } } while (0)
#define PB1(k) do { if ((k) == PROBE_PH) { __syncthreads(); if (F.tid == 0) { const unsigned long long t_ = __builtin_amdgcn_s_memrealtime() - (((unsigned long long)F.MISC[25] << 32) | F.MISC[24]); F.MISC[26] = (unsigned)t_; F.MISC[27] = (unsigned)(t_ >> 32); } } } while (0)
#else
#define PB0(k) do { } while (0)
#define PB1(k) do { } while (0)
#endif
template <int LAYER>
DI void layer_phases(Frame& F, const int lo, const int hi, const XcdBarrier& bar) {
    bf16* H = (bf16*)(F.ws + WS_H); bf16* P = (bf16*)(F.ws + WS_P); bf16* MIX = (bf16*)(F.ws + WS_MIX); float* XB = (float*)(F.ws + WS_XB);
    bf16* ACT = (bf16*)(F.ws + WS_ACT); bf16* HS = (bf16*)(F.ws + WS_HS);
    const int bid = (int)blockIdx.x;
        constexpr int layer = LAYER; constexpr int pb = LAYER ? 10 : 1;
        PB0(pb); if (IN(pb)) {
#if INPROJ_INT8
            pg8::Gemm g{H, (const bf16*)(F.ws + WS_WIN + (size_t)layer * NINP * D), S, NINP, D / 2}; pg8::StaticOrder So; So.init(S, NINP, F.G, bid);
#if PN_FUSED
            pg8::EpiStoreBf16SN E{P, PITCH, (const float*)(F.ws + WS_ROUTE + RT_ROWS), (const float*)(F.ws + WS_WSC) + layer,
                                  F.a->in[5] + layer * 128, F.a->in[6] + layer * 128, F.a->in[7] + layer * 128, F.a->in[8] + layer * 128, F.a->in[9] + layer * 64, F.a->in[10] + layer * 64,
                                  (LAS float*)(F.lds + LDS_TBL_OFF)};
            pg8::gemm_phase<pg8::EpiStoreBf16SN, pg8::StaticOrder, true, GEMM_SP2, 2>(F.lds + RING_OFF, g, So, E);
#else
            pg8::EpiStoreBf16S E{P, PITCH, (const float*)(F.ws + WS_ROUTE + RT_ROWS), (const float*)(F.ws + WS_WSC) + layer};
            pg8::gemm_phase<pg8::EpiStoreBf16S, pg8::StaticOrder, GEMM_ALIGN, GEMM_SP2, 2>(F.lds + RING_OFF, g, So, E);
#endif
#else
            pg8::Gemm g{H, (const bf16*)(F.ws + WS_WIN) + (size_t)layer * NINP * D, S, NINP, D}; pg8::StaticOrder So; So.init(S, NINP, F.G, bid);
            pg8::EpiStoreBf16 E{P, PITCH};
            pg8::gemm_phase<pg8::EpiStoreBf16, pg8::StaticOrder, true, GEMM_SP2>(F.lds + RING_OFF, g, So, E);
#endif
            { constexpr int REM = ((S / 256) * (NINP / 256)) % 256;
              if (F.G == 256 && bid >= REM) bg_convert(F, layer ? BG_A1 : BG_A0, layer ? BG_I10 : BG_I1, bid - REM, 256 - REM); }
        } SEAM(pb); PB1(pb);
        PB0(pb + 1); if (IN(pb + 1)) { if (!(PN_FUSED && INPROJ_INT8)) pn_phase(F, layer); i1_phase(F); } SEAM(pb + 1); PB1(pb + 1);
        PB0(pb + 2); if (IN(pb + 2)) { i2_phase(F); } SEAM(pb + 2); PB1(pb + 2);
        PB0(pb + 3); if (IN(pb + 3)) { attn_phase(F, layer); } SEAM(pb + 3); PB1(pb + 3);
        PB0(pb + 4); if (IN(pb + 4)) {
#if OUTPROJ_INT8
            pg8::Gemm g{MIX, (const bf16*)(F.ws + WS_WOUT + (size_t)layer * D * D), S, D, D / 2}; pg8::StaticOrder So; So.init(S, D, F.G, bid);
            pg8::EpiResI8 E{layer == 0 ? F.a->in[0] : (const float*)XB, XB, D, (const float*)(F.ws + WS_WSC) + 2 + layer, MIX_CLIP / 127.0f};
            pg8::gemm_phase<pg8::EpiResI8, pg8::StaticOrder, true, GEMM_SP2, 2>(F.lds + RING_OFF, g, So, E);
#else
            pg8::Gemm g{MIX, (const bf16*)(F.ws + WS_WOUT) + (size_t)layer * D * D, S, D, D}; pg8::StaticOrder So; So.init(S, D, F.G, bid);
#if XB_BF16
            if constexpr (LAYER == 0) { pg8::EpiResB<false, 0> E{F.a->in[0], (bf16*)XB, D}; pg8::gemm_phase<pg8::EpiResB<false, 0>, pg8::StaticOrder, true, GEMM_SP2>(F.lds + RING_OFF, g, So, E); }
            else { pg8::EpiResB<true, 0> E{XB, (bf16*)XB, D}; pg8::gemm_phase<pg8::EpiResB<true, 0>, pg8::StaticOrder, true, GEMM_SP2>(F.lds + RING_OFF, g, So, E); }
#else
            pg8::EpiResF32 E{layer == 0 ? F.a->in[0] : (const float*)XB, XB, D};
            pg8::gemm_phase<pg8::EpiResF32, pg8::StaticOrder, true, GEMM_SP2>(F.lds + RING_OFF, g, So, E);
#endif
#endif
        } SEAM(pb + 4); PB1(pb + 4);
        if (layer == 0) {
            PB0(6); if (IN(6)) {
#if DENSE_GU_FP8 && GU_INT8
                rms_phase_i8<XB_BF16 != 0>(F, XB, F.a->in[4], (unsigned char*)HS, (float*)(F.ws + WS_ROUTE + RT_ROWS));
#elif DENSE_GU_FP8
                rms_phase8(F, XB, F.a->in[4], (unsigned char*)HS);
#else
                rms_phase(F, XB, F.a->in[4], H);
#endif
            } SEAM(6); PB1(6);
            PB0(7); if (IN(7)) {
                pg8::Gemm g{H, (const bf16*)(F.ws + WS_WGU), S, 2 * DFF, D}; pg8::StaticOrder So; So.init(S, 2 * DFF, F.G, bid);
#if DENSE_GU_FP8 && GU_INT8
                pg8::Gemm g8{HS, (const bf16*)(F.ws + WS_WGU), S, 2 * DFF, D / 2};
                pg8::EpiSwiGLUi8 E{(unsigned char*)ACT, DFF, 2 * DFF / 256, (const float*)(F.ws + WS_ROUTE + RT_ROWS), (const float*)(F.ws + WS_WSC) + 4, (const float*)(F.ws + WS_WSC) + 5};
                pg8::gemm_phase<pg8::EpiSwiGLUi8, pg8::StaticOrder, GEMM_ALIGN, GEMM_SP2, 2>(F.lds + RING_OFF, g8, So, E);
#elif DENSE_GU_FP8
                pg8::Gemm g8{HS, (const bf16*)(F.ws + WS_WGU), S, 2 * DFF, D / 2};
                pg8::EpiSwiGLU8T<true> E{(unsigned char*)ACT, DFF, 2 * DFF / 256};
                pg8::gemm_phase<pg8::EpiSwiGLU8T<true>, pg8::StaticOrder, true, GEMM_SP2, true>(F.lds + RING_OFF, g8, So, E);
#elif DENSE_DOWN_FP8
                pg8::EpiSwiGLU8T<false> E{(unsigned char*)ACT, DFF, 2 * DFF / 256};
                pg8::gemm_phase<pg8::EpiSwiGLU8T<false>, pg8::StaticOrder, true, GEMM_SP2>(F.lds + RING_OFF, g, So, E);
#else
                pg8::EpiSwiGLU E{ACT, DFF, 2 * DFF / 256};
                pg8::gemm_phase<pg8::EpiSwiGLU, pg8::StaticOrder, true, GEMM_SP2>(F.lds + RING_OFF, g, So, E);
#endif
                { constexpr int REM = ((S / 256) * (2 * DFF / 256)) % 256;
                  if (F.G == 256 && bid >= REM) bg_convert(F, BG_I10, NBG, bid - REM, 256 - REM); }
            } SEAM(7); PB1(7);
            PB0(8); if (IN(8)) {
#if DENSE_DOWN_FP8
                pg8::Gemm g{ACT, (const bf16*)(F.ws + WS_WDN), S, D, DFF / 2}; pg8::StaticOrder So; So.init(S, D, F.G, bid);
#if XB_BF16
                pg8::EpiResB<true, pg8::W8_SHIFT> E{XB, (bf16*)XB, D};
                pg8::gemm_phase<pg8::EpiResB<true, pg8::W8_SHIFT>, pg8::StaticOrder, true, GEMM_SP2, true>(F.lds + RING_OFF, g, So, E);
#else
                pg8::EpiRes8 E{XB, XB, D};
                pg8::gemm_phase<pg8::EpiRes8, pg8::StaticOrder, true, GEMM_SP2, true>(F.lds + RING_OFF, g, So, E);
#endif
#else
                pg8::Gemm g{ACT, (const bf16*)(F.ws + WS_WDN), S, D, DFF}; pg8::StaticOrder So; So.init(S, D, F.G, bid);
                pg8::EpiResF32 E{XB, XB, D};
                pg8::gemm_phase<pg8::EpiResF32, pg8::StaticOrder, true, GEMM_SP2>(F.lds + RING_OFF, g, So, E);
#endif
            } SEAM(8); PB1(8);
            PB0(9); if (IN(9)) {
#if INPROJ_INT8
                rms_phase_i8<XB_BF16 != 0>(F, XB, F.a->in[3] + D, (unsigned char*)H, (float*)(F.ws + WS_ROUTE + RT_ROWS));
#else
                rms_phase(F, XB, F.a->in[3] + D, H);
#endif
            } SEAM(9); PB1(9);
        } else {
            PB0(15); if (IN(15)) { rms_router_phase<XB_BF16 != 0>(F, XB, F.a->in[4] + D, F.a->in[20], H); } SEAM(15); PB1(15);
#if GATHER_FUSED != 1
            PB0(16); if (IN(16)) { gather_phase(F); } SEAM(16); PB1(16);
#endif
            PB0(17); if (IN(17)) {
                int off[9]; moe_offsets(F, off);
                pg8::MoeOrder Mo;
_Pragma("unroll")
                for (int e = 0; e < 9; ++e) Mo.rt0[e] = off[e] >> 8; Mo.npn = 2 * DFFE / 256; Mo.G = F.G; Mo.c = bid; Mo.n_full = Mo.rt0[8] * Mo.npn; Mo.sl = 1; Mo.ktt = D / 128; Mo.ct = GATHER_FUSED ? MOE_CT : 0;
                pg8::Gemm g{HS, (const bf16*)(F.ws + WS_WMGU), MAXSLOT, NE * 2 * DFFE, D / 2};
#if GU_INT8
                pg8::EpiSwiGLUi8 E{(unsigned char*)ACT, DFFE, 2 * DFFE / 256, (const float*)(F.ws + WS_ROUTE + RT_SLOTS), (const float*)(F.ws + WS_WSC) + 6, (const float*)(F.ws + WS_WSC) + 14};
                pg8::gemm_phase<pg8::EpiSwiGLUi8, pg8::MoeOrder, GEMM_ALIGN, GEMM_SP2, 2>(F.lds + RING_OFF, g, Mo, E);
#else
                pg8::EpiSwiGLU8 E{(unsigned char*)ACT, DFFE, 2 * DFFE / 256};
                pg8::gemm_phase<pg8::EpiSwiGLU8, pg8::MoeOrder, true, GEMM_SP2, true>(F.lds + RING_OFF, g, Mo, E);
#endif
            } SEAM(17); PB1(17);
            PB0(18); if (IN(18)) {
                int off[9]; moe_offsets(F, off);
                pg8::MoeOrder Mo;
_Pragma("unroll")
                for (int e = 0; e < 9; ++e) Mo.rt0[e] = off[e] >> 8; Mo.npn = D / 256; Mo.G = F.G; Mo.c = bid; Mo.ktt = DFFE / 128; Mo.ct = GATHER_FUSED ? MOE_CT : 0;
                pg8::moe_slice_plan(Mo.rt0[8] * Mo.npn, F.G, Mo.n_full, Mo.sl);
                pg8::Gemm g{ACT, (const bf16*)(F.ws + WS_WMDN), MAXSLOT, NE * D, DFFE / 2};
                pg8::EpiMoeDown8 E{(float*)(F.ws + WS_OUTM), (const float*)(F.ws + WS_ROUTE + RT_SLOTG), D, D / 256, (float*)(F.ws + WS_OUTP)};
                pg8::gemm_phase<pg8::EpiMoeDown8, pg8::MoeOrder, GEMM_ALIGN, GEMM_SP2, true>(F.lds + RING_OFF, g, Mo, E);
            } SEAM(18); PB1(18);
            PB0(19); if (IN(19)) { combine_phase(F); } PB1(19);
        }
    }
__global__ void __launch_bounds__(NWAVES * 64, 2) trunk_fwd(Args args) {
    extern __shared__ __attribute__((aligned(16))) unsigned char lds[];
    Frame F;
    F.lds = (LAS unsigned char*)lds;
    F.MISC = (volatile LAS unsigned*)(F.lds + MISC_OFF);
    F.tid = threadIdx.x; F.lane = F.tid & 63; F.wave = __builtin_amdgcn_readfirstlane(F.tid >> 6);
    F.G = gridDim.x; { const int bx = blockIdx.x; F.vcu = (F.G % 8 == 0) ? (bx % 8) * (F.G / 8) + bx / 8 : bx; }
    F.ws = args.ws; F.ctl = (gu32*)(args.ws + WS_CTL); F.out = args.out;
    F.a = &args;
    for (int u = F.tid; u < (LDS_TBL_OFF - LDSCTL_OFF) / 4; u += NWAVES * 64) ((LAS unsigned*)(F.lds + LDSCTL_OFF))[u] = 0u;
    __syncthreads();
    const int lo = args.ph_lo, hi = args.ph_hi;
    XcdBarrier bar; bar.bar = (unsigned*)(F.ctl + CW_BAR); bar.x = 0; bar.st = nullptr;
    if (hi - lo > 1) bar = xcd_barrier_post((unsigned*)(F.ctl + CW_BAR), F.MISC + 8);

    PB0(0); if (IN(0)) { p0_prologue(F); } SEAM(0); PB1(0);

    layer_phases<0>(F, lo, hi, bar);
    layer_phases<1>(F, lo, hi, bar);
#ifdef PROBE_ATTBAR
    { __syncthreads(); if (blockIdx.x == 1) { const unsigned long long d_ = ((unsigned long long)F.MISC[28] << 4) * PROBE_ATTBAR, t0_ = __builtin_readcyclecounter(); while (__builtin_readcyclecounter() - t0_ < d_) __builtin_amdgcn_s_sleep(8); } }
#endif
#if defined(PROBE_PH) || defined(PROBE_ATT)
    { __syncthreads(); const unsigned long long d_ = (((unsigned long long)F.MISC[27] << 32) | F.MISC[26]) * PROBE_MULT, t0_ = __builtin_amdgcn_s_memrealtime();
      while (__builtin_amdgcn_s_memrealtime() - t0_ < d_) __builtin_amdgcn_s_sleep(8); }
#endif
#undef IN
#undef SEAM
}

extern "C" void kernel_launch(void* const* d_in, const int* in_sizes, int n_in, void* d_out, int out_size, void* d_ws, size_t ws_size, hipStream_t stream) {
    static int grid = 0;
    if (grid == 0) {
        if (n_in != 24 || in_sizes[0] != S * D || out_size != S * D || ws_size < WS_END) { fprintf(stderr, "kernel_launch: unexpected shapes (n_in %d, x %d, out %d, ws %zu < %zu); nothing launched\n", n_in, n_in > 0 ? in_sizes[0] : -1, out_size, ws_size, (size_t)WS_END); grid = -1; return; }
        int dev = 0, cus = 0, per_cu = 0;
        if (hipGetDevice(&dev) != hipSuccess || hipDeviceGetAttribute(&cus, hipDeviceAttributeMultiprocessorCount, dev) != hipSuccess) { grid = -1; return; }
        if (hipFuncSetAttribute((const void*)trunk_fwd, hipFuncAttributeMaxDynamicSharedMemorySize, LDS_BYTES) != hipSuccess) { fprintf(stderr, "kernel_launch: hipFuncSetAttribute failed\n"); grid = -1; return; }
        if (hipOccupancyMaxActiveBlocksPerMultiprocessor(&per_cu, (const void*)trunk_fwd, NWAVES * 64, LDS_BYTES) != hipSuccess || per_cu < 1) { fprintf(stderr, "kernel_launch: occupancy query says %d blocks per CU\n", per_cu); (void)hipGetLastError(); per_cu = 1; }
        grid = cus;
        if (grid > 256) grid = 256;
    }
    if (grid < 0) return;
    if (hipMemsetAsync((char*)d_ws + WS_CTL, 0, CTL_ZERO_BYTES, stream) != hipSuccess) return;
    Args a{};
    for (int i = 0; i < 24; ++i) a.in[i] = (const float*)d_in[i];
    a.out = (float*)d_out; a.ws = (unsigned char*)d_ws;
#if MK_PER_PHASE
    for (int k = 0; k < NPH; ++k) { a.ph_lo = k; a.ph_hi = k + 1; hipLaunchKernelGGL(trunk_fwd, dim3(grid), dim3(NWAVES * 64), LDS_BYTES, stream, a);
#ifdef DBG_CHECKS
        if (k == 3) hipLaunchKernelGGL(dbg_check_indexer, dim3(S / 4), dim3(256), 0, stream, (unsigned char*)d_ws);
        if (k == 4) hipLaunchKernelGGL(dbg_check_attnA, dim3(64), dim3(256), 0, stream, (unsigned char*)d_ws);
        if (k == NPH - 1) hipLaunchKernelGGL(dbg_plant, dim3(1), dim3(64), 0, stream, (unsigned char*)d_ws, (float*)d_out);
#endif
    }
#else
    a.ph_lo = 0; a.ph_hi = NPH;
    hipLaunchKernelGGL(trunk_fwd, dim3(grid), dim3(NWAVES * 64), LDS_BYTES, stream, a);
#endif
    const hipError_t le = hipPeekAtLastError();
    if (le != hipSuccess) fprintf(stderr, "kernel_launch: launch failed: %s\n", hipGetErrorName(le));
}
```
